# Optimizing an MI355X kernel written in HIP

```python
import jax, jax.numpy as jnp
from jax import lax
import numpy as np

D_MODEL = 1024
BATCH = 2
SEQ = 16384
DEPTH = 2

CHUNK = 64
EPS = 1e-6
ROPE_BASE = 10000.0
RET_HEADS = 4
RET_DK = 128
RET_DV = 128
RET_WIDTH = RET_HEADS * RET_DV
CONV_CH = 512
CONV_GROUPS = 8
CONV_K = 31
SG_CH = 512
SG_GROUPS = 4
SG_BLOCK = 128
SC_CH = 512
SC_GROUPS = 8
SC_K = 3
D_FF = 2816
N_EXPERTS = 8
TOP_K = 2
D_EXPERT = 3584
MOE_BLOCK = 256
EVEN_IN = 2 * RET_HEADS * RET_DK + 2 * RET_WIDTH + 2 * CONV_CH
ODD_IN = 2 * SG_CH + 3 * SC_CH
N_EVEN = (DEPTH + 1) // 2
N_ODD = DEPTH // 2

kernel_name = 'hybrid_retention_conformer_gmlp_shortconv_moe'


def rmsnorm(x, g):
    x32 = x.astype(jnp.float32)
    y = x32 * lax.rsqrt(jnp.mean(x32 * x32, axis=-1, keepdims=True) + EPS)
    return y.astype(x.dtype) * g


def layernorm(x, g, b):
    x32 = x.astype(jnp.float32)
    mu = jnp.mean(x32, axis=-1, keepdims=True)
    var = jnp.mean(jnp.square(x32 - mu), axis=-1, keepdims=True)
    y = (x32 - mu) * lax.rsqrt(var + EPS)
    return y.astype(x.dtype) * g + b


def rotary(x, pos):
    half = x.shape[-1] // 2
    freqs = ROPE_BASE ** (-jnp.arange(half, dtype=jnp.float32) / half)
    ang = pos[:, None] * freqs[None, :]
    cos = jnp.cos(ang)[None, :, None, :]
    sin = jnp.sin(ang)[None, :, None, :]
    x32 = x.astype(jnp.float32)
    x1, x2 = x32[..., :half], x32[..., half:]
    return jnp.concatenate([x1 * cos - x2 * sin, x2 * cos + x1 * sin], axis=-1)


def causal_depthwise_conv(x, w):
    k = w.shape[0]
    return lax.conv_general_dilated(
        x, w[:, None, :].astype(x.dtype), window_strides=(1,), padding=[(k - 1, 0)],
        dimension_numbers=('NWC', 'WIO', 'NWC'), feature_group_count=x.shape[-1])


def chunk_retention(q, k, v):
    bn, s, h, dk = q.shape
    dv = v.shape[-1]
    n_chunks = s // CHUNK

    def to_chunks(t):
        return t.reshape(bn, n_chunks, CHUNK, h, t.shape[-1]).transpose(1, 0, 3, 2, 4)

    log_g = jnp.log1p(-jnp.power(2.0, -5.0 - jnp.arange(h, dtype=jnp.float32)))
    idx = jnp.arange(CHUNK, dtype=jnp.float32)
    intra = jnp.exp(log_g[:, None, None] * jnp.abs(idx[:, None] - idx[None, :]))
    q_dec = jnp.exp(log_g[:, None] * (idx + 1.0))[:, :, None]
    k_dec = jnp.exp(log_g[:, None] * (CHUNK - 1.0 - idx))[:, :, None]
    c_dec = jnp.exp(log_g * CHUNK)[:, None, None]

    def step(state, inp):
        qc, kc, vc = inp
        scores = jnp.einsum('bhcd,bhld->bhcl', qc, kc) * intra
        out = (jnp.einsum('bhcl,bhle->bhce', scores, vc)
               + jnp.einsum('bhcd,bhde->bhce', qc * q_dec, state))
        state = c_dec * state + jnp.einsum('bhld,bhle->bhde', kc * k_dec, vc)
        return state, out

    init = jnp.zeros((bn, h, dk, dv), jnp.float32)
    _, o = lax.scan(step, init, (to_chunks(q), to_chunks(k), to_chunks(v)))
    return o.transpose(1, 0, 3, 2, 4).reshape(bn, s, h, dv)


def even_mixer(hn, w_in, ret_gn, dw_w, dw_b, cv_ln_g, cv_ln_b, w_out, pos):
    bn, s, _ = hn.shape
    nq = RET_HEADS * RET_DK
    z = hn @ w_in
    q, k, v, g, a, b = jnp.split(
        z, [nq, 2 * nq, 2 * nq + RET_WIDTH, 2 * nq + 2 * RET_WIDTH,
            2 * nq + 2 * RET_WIDTH + CONV_CH], axis=-1)
    q = rotary(q.reshape(bn, s, RET_HEADS, RET_DK), pos) * (RET_DK ** -0.5)
    k = rotary(k.reshape(bn, s, RET_HEADS, RET_DK), pos)
    v = v.reshape(bn, s, RET_HEADS, RET_DV).astype(jnp.float32)
    r = chunk_retention(q, k, v)
    mu = jnp.mean(r, axis=-1, keepdims=True)
    var = jnp.mean(jnp.square(r - mu), axis=-1, keepdims=True)
    r = ((r - mu) * lax.rsqrt(var + EPS)).reshape(bn, s, RET_WIDTH).astype(hn.dtype) * ret_gn
    y_ret = jax.nn.silu(g) * r
    c = a * jax.nn.sigmoid(b)
    c = causal_depthwise_conv(c, dw_w) + dw_b
    y_cv = jax.nn.silu(layernorm(c, cv_ln_g, cv_ln_b))
    return jnp.concatenate([y_ret, y_cv], axis=-1) @ w_out


def odd_mixer(hn, w_in, sg_ln_g, sg_ln_b, sg_w, sg_b, sc_w, w_out):
    bn, s, _ = hn.shape
    z = hn @ w_in
    zs, bg, cg, hv = jnp.split(z, [2 * SG_CH, 2 * SG_CH + SC_CH, 2 * SG_CH + 2 * SC_CH], axis=-1)
    zs = jax.nn.gelu(zs)
    u, v = jnp.split(zs, 2, axis=-1)
    v = layernorm(v, sg_ln_g, sg_ln_b)
    n_blk = s // SG_BLOCK
    vb = v.reshape(bn, n_blk, SG_BLOCK, SG_GROUPS, SG_CH // SG_GROUPS)
    pchunk = jnp.arange(SG_BLOCK) // CHUNK
    mask = (pchunk[:, None] >= pchunk[None, :]).astype(sg_w.dtype)
    w_s = sg_w * mask[None]
    sp = jnp.einsum('gpq,bmqgc->bmpgc', w_s, vb) + sg_b.T[None, None, :, :, None]
    y_sg = u * sp.reshape(bn, s, SG_CH)
    y_sc = bg * causal_depthwise_conv(cg * hv, sc_w)
    return jnp.concatenate([y_sg, y_sc], axis=-1) @ w_out


def swiglu(hn, w_gate, w_up, w_down):
    return (jax.nn.silu(hn @ w_gate) * (hn @ w_up)) @ w_down


def moe_swiglu(hn, router, e_gate, e_up, e_down):
    bn, s, d = hn.shape
    t = bn * s
    a = t * TOP_K
    xt = hn.reshape(t, d)
    logits = (xt @ router).astype(jnp.float32)
    top_v, top_i = lax.top_k(logits, TOP_K)
    gates = jax.nn.softmax(top_v, axis=-1)
    e_flat = top_i.reshape(-1)
    tok_flat = jnp.repeat(jnp.arange(t, dtype=jnp.int32), TOP_K)
    w_flat = gates.reshape(-1)
    order = jnp.argsort(e_flat)
    se, stok, sw = e_flat[order], tok_flat[order], w_flat[order]
    counts = jnp.bincount(e_flat, length=N_EXPERTS)
    start = jnp.cumsum(counts) - counts
    pcounts = (counts + MOE_BLOCK - 1) // MOE_BLOCK * MOE_BLOCK
    pend = jnp.cumsum(pcounts)
    pstart = pend - pcounts
    dest = pstart[se] + jnp.arange(a) - start[se]
    rows = ((a + MOE_BLOCK - 1) // MOE_BLOCK) * MOE_BLOCK + N_EXPERTS * MOE_BLOCK
    n_blocks = rows // MOE_BLOCK
    row_tok = jnp.zeros((rows,), jnp.int32).at[dest].set(stok)
    row_w = jnp.zeros((rows,), jnp.float32).at[dest].set(sw)
    blk_e = jnp.minimum(jnp.searchsorted(pend, jnp.arange(n_blocks) * MOE_BLOCK, side='right'),
                        N_EXPERTS - 1)
    xg = xt[row_tok].reshape(n_blocks, MOE_BLOCK, d)

    def expert_block(args):
        xb, e = args
        hb = jax.nn.silu(xb @ e_gate[e]) * (xb @ e_up[e])
        return hb @ e_down[e]

    yb = lax.map(expert_block, (xg, blk_e)).reshape(rows, d)
    yb = yb * row_w[:, None].astype(hn.dtype)
    out = jnp.zeros((t, d), hn.dtype).at[row_tok].add(yb)
    return out.reshape(bn, s, d)


def setup_inputs(seed: int = 0) -> dict:
    key = jax.random.key(seed)
    ks = iter(jax.random.split(key, 40))

    def dense(shape, fan_in, scale=1.0):
        return jax.random.normal(next(ks), shape, jnp.float32) * (scale * fan_in ** -0.5)

    def gain(shape):
        return 1.0 + 0.02 * jax.random.normal(next(ks), shape, jnp.float32)

    def bias(shape, scale=0.02):
        return scale * jax.random.normal(next(ks), shape, jnp.float32)

    ne, no = N_EVEN, N_ODD
    return {
        'x': jax.random.normal(next(ks), (BATCH, SEQ, D_MODEL), jnp.float32),
        'e_norm_mix': gain((ne, D_MODEL)),
        'e_w_in': dense((ne, D_MODEL, EVEN_IN), D_MODEL),
        'e_ret_gn': gain((ne, RET_WIDTH)),
        'e_dw_w': dense((ne, CONV_K, CONV_CH), CONV_K),
        'e_dw_b': bias((ne, CONV_CH)),
        'e_cv_ln_g': gain((ne, CONV_CH)),
        'e_cv_ln_b': bias((ne, CONV_CH)),
        'e_w_out': dense((ne, RET_WIDTH + CONV_CH, D_MODEL), RET_WIDTH + CONV_CH),
        'e_norm_ffn': gain((ne, D_MODEL)),
        'e_ffn_gate': dense((ne, D_MODEL, D_FF), D_MODEL),
        'e_ffn_up': dense((ne, D_MODEL, D_FF), D_MODEL),
        'e_ffn_down': dense((ne, D_FF, D_MODEL), D_FF),
        'o_norm_mix': gain((no, D_MODEL)),
        'o_w_in': dense((no, D_MODEL, ODD_IN), D_MODEL),
        'o_sg_ln_g': gain((no, SG_CH)),
        'o_sg_ln_b': bias((no, SG_CH)),
        'o_sg_w': dense((no, SG_GROUPS, SG_BLOCK, SG_BLOCK), SG_BLOCK, 0.5),
        'o_sg_b': 1.0 + bias((no, SG_GROUPS, SG_BLOCK), 0.1),
        'o_sc_w': dense((no, SC_K, SC_CH), SC_K),
        'o_w_out': dense((no, SG_CH + SC_CH, D_MODEL), SG_CH + SC_CH),
        'o_norm_ffn': gain((no, D_MODEL)),
        'o_router': dense((no, D_MODEL, N_EXPERTS), D_MODEL),
        'o_exp_gate': dense((no, N_EXPERTS, D_MODEL, D_EXPERT), D_MODEL),
        'o_exp_up': dense((no, N_EXPERTS, D_MODEL, D_EXPERT), D_MODEL),
        'o_exp_down': dense((no, N_EXPERTS, D_EXPERT, D_MODEL), D_EXPERT),
        'final_norm': gain((D_MODEL,)),
    }


def reference(x, e_norm_mix, e_w_in, e_ret_gn, e_dw_w, e_dw_b, e_cv_ln_g, e_cv_ln_b, e_w_out,
              e_norm_ffn, e_ffn_gate, e_ffn_up, e_ffn_down,
              o_norm_mix, o_w_in, o_sg_ln_g, o_sg_ln_b, o_sg_w, o_sg_b, o_sc_w, o_w_out,
              o_norm_ffn, o_router, o_exp_gate, o_exp_up, o_exp_down, final_norm):
    pos = jnp.arange(x.shape[1], dtype=jnp.float32)
    h = x
    for i in range(DEPTH):
        l = i // 2
        if i % 2 == 0:
            h = h + even_mixer(rmsnorm(h, e_norm_mix[l]), e_w_in[l], e_ret_gn[l], e_dw_w[l],
                               e_dw_b[l], e_cv_ln_g[l], e_cv_ln_b[l], e_w_out[l], pos)
            h = h + swiglu(rmsnorm(h, e_norm_ffn[l]), e_ffn_gate[l], e_ffn_up[l], e_ffn_down[l])
        else:
            h = h + odd_mixer(rmsnorm(h, o_norm_mix[l]), o_w_in[l], o_sg_ln_g[l], o_sg_ln_b[l],
                              o_sg_w[l], o_sg_b[l], o_sc_w[l], o_w_out[l])
            h = h + moe_swiglu(rmsnorm(h, o_norm_ffn[l]), o_router[l], o_exp_gate[l],
                               o_exp_up[l], o_exp_down[l])
    return rmsnorm(h, final_norm)
```

```cpp
#include <hip/hip_runtime.h>
#include <cstdio>

#define GAS __attribute__((address_space(1)))
#define LAS __attribute__((address_space(3)))
typedef unsigned short bf16;
typedef short bf16x8 __attribute__((ext_vector_type(8)));
typedef short s16x4 __attribute__((ext_vector_type(4)));
typedef float f32x4 __attribute__((ext_vector_type(4)));
typedef float f32x2 __attribute__((ext_vector_type(2)));
typedef unsigned u32x4 __attribute__((ext_vector_type(4)));
typedef unsigned u32x2 __attribute__((ext_vector_type(2)));
typedef int i32x4 __attribute__((ext_vector_type(4)));
typedef int i32x8 __attribute__((ext_vector_type(8)));

constexpr int BATCH = 2, SEQ = 16384, T = BATCH * SEQ, D = 1024;
constexpr int EVEN_IN = 3072, ODD_IN = 2560, DFF = 2816, NEXP = 8, DEXP = 3584;
constexpr float EPS = 1e-6f;
constexpr int NWAVES = 8, NTHR = 512;

constexpr size_t MiB = 1u << 20;
constexpr size_t WS_CTL = 0, CTL_ZERO_BYTES = 64 * 1024;
constexpr size_t WS_ROWTOK = 1 * MiB;
constexpr size_t WS_TOKINFO = 2 * MiB;
constexpr size_t WS_SSP = 2 * MiB + 512 * 1024;
constexpr size_t WS_WGU8 = 3 * MiB;
constexpr size_t WS_WDN8 = 59 * MiB;
constexpr size_t WS_XN = 87 * MiB;
constexpr size_t WS_Y = 151 * MiB;
constexpr size_t WS_YMOE = 87 * MiB;
constexpr size_t WS_Z = 219 * MiB;
constexpr size_t WS_HFFN = 219 * MiB;
constexpr size_t WS_HMOE8 = 219 * MiB;
constexpr size_t WS_RETL = 411 * MiB;
constexpr size_t WS_RETS = 427 * MiB;
constexpr size_t WS_W_EIN = 443 * MiB;
constexpr size_t WS_W_EOUT = 449 * MiB;
constexpr size_t WS_W_FGU = 451 * MiB;
constexpr size_t WS_W_FDN = 462 * MiB;
constexpr size_t WS_W_OIN = 468 * MiB;
constexpr size_t WS_W_OOUT = 473 * MiB;
constexpr size_t WS_ROPE = 475 * MiB;
constexpr size_t WS_SGW = 483 * MiB;
constexpr size_t WS_XN8 = 450 * MiB;
constexpr size_t WS_SLAB = 482 * MiB;
constexpr size_t WS_END = 510 * MiB;
constexpr size_t EXP_GU_BYTES = (size_t)2 * DEXP * D, EXP_DN_BYTES = (size_t)D * DEXP;
constexpr float W8_SCALE = 64.0f, W8_INV = 1.0f / 64.0f;
constexpr int CW_BAR = 4096, CW_CNT = 8192;

constexpr int LDS_BYTES = 159744;
constexpr int ROWOFF_OFF = 131072;
constexpr int MISC_OFF = LDS_BYTES - 1024;

#define RLX_AGENT __ATOMIC_RELAXED, __HIP_MEMORY_SCOPE_AGENT
#define LDS_WAIT() asm volatile("s_waitcnt lgkmcnt(0)" ::: "memory")
#define VM_WAIT() asm volatile("s_waitcnt vmcnt(0)" ::: "memory")
#define WG_SYNC() do { asm volatile("s_waitcnt lgkmcnt(0)" ::: "memory"); __builtin_amdgcn_s_barrier(); asm volatile("" ::: "memory"); } while (0)

__device__ __forceinline__ float bf2f(unsigned b) { return __uint_as_float(b << 16); }
typedef __bf16 bf16x2_t __attribute__((ext_vector_type(2)));
__device__ __forceinline__ unsigned pk2(float lo, float hi) { const bf16x2_t v = __builtin_convertvector((f32x2){lo, hi}, bf16x2_t); return __builtin_bit_cast(unsigned, v); }
__device__ __forceinline__ unsigned f2bf(float f) { return pk2(f, 0.f) & 0xffffu; }
__device__ __forceinline__ unsigned pk4_fp8(float a, float b, float c, float d) { int r = __builtin_amdgcn_cvt_pk_fp8_f32(a, b, 0, false); r = __builtin_amdgcn_cvt_pk_fp8_f32(c, d, r, true); return (unsigned)r; }
__device__ __forceinline__ float clamp8(float x) { return __builtin_fminf(__builtin_fmaxf(x, -448.0f), 448.0f); }
template <int CTRL, int RMASK> __device__ __forceinline__ float dpp_take(float v) {
    return __builtin_bit_cast(float, __builtin_amdgcn_update_dpp(0, __builtin_bit_cast(int, v), CTRL, RMASK, 0xf, true)); }
__device__ __forceinline__ float wave_sum(float v) {
    v += dpp_take<0x111, 0xf>(v); v += dpp_take<0x112, 0xf>(v); v += dpp_take<0x114, 0xf>(v); v += dpp_take<0x118, 0xf>(v);
    v += dpp_take<0x142, 0xa>(v); v += dpp_take<0x143, 0xc>(v);
    return __builtin_bit_cast(float, __builtin_amdgcn_readlane(__builtin_bit_cast(int, v), 63));
}
template <int CTRL> __device__ __forceinline__ float dpp_all(float v) { return __builtin_bit_cast(float, __builtin_amdgcn_update_dpp(0, __builtin_bit_cast(int, v), CTRL, 0xf, 0xf, false)); }
__device__ __forceinline__ float sum8(float v) { v += dpp_all<0xB1>(v); v += dpp_all<0x4E>(v); v += dpp_all<0x141>(v); return v; }
__device__ __forceinline__ float fast_sigmoid(float x) { return __builtin_amdgcn_rcpf(1.0f + __builtin_amdgcn_exp2f(-1.4426950408889634f * x)); }
__device__ __forceinline__ float silu_f(float x) { return x * fast_sigmoid(x); }
__device__ __forceinline__ f32x2 swiglu2(f32x2 g, f32x2 u) {
    f32x2 e; e.x = __builtin_amdgcn_exp2f(g.x); e.y = __builtin_amdgcn_exp2f(g.y);
    const f32x2 d = e + 1.0f; f32x2 r; r.x = __builtin_amdgcn_rcpf(d.x); r.y = __builtin_amdgcn_rcpf(d.y);
    return (g * u) * r; }
__device__ __forceinline__ float gelu_tanh(float x) {
    const float u = 0.7978845608028654f * (x + 0.044715f * x * x * x);
    return x * fast_sigmoid(2.0f * u);
}

namespace pg8 {
constexpr int BM = 256, BK = 64, HALF = 128, HTB = HALF * BK * 2, STAGE_BYTES = 8 * HTB, NXCD = 8, WGM = 8;
__device__ __forceinline__ int lds_byte(int r, int c) { const int st = (r >> 4) * 2 + (c >> 5), rr = r & 15, cc = c & 31, ob = rr * 64 + cc * 2; return st * 1024 + (ob ^ (((ob >> 9) & 1) << 5)); }
__device__ __forceinline__ void stage_rc(int b, int& R, int& C) { const int st = b / 1024, sb = b % 1024, swz = sb ^ (((sb >> 9) & 1) << 5); R = (st >> 1) * 16 + swz / 64; C = (st & 1) * 32 + (swz % 64) / 2; }
__device__ __forceinline__ int perm32(int rho) { const int n = rho >> 4, i = rho & 15; return 8 * (i >> 2) + 4 * n + (i & 3); }

struct Unit { int pm, pn, orow; unsigned ao, bo; };
struct TileOrder {
    int nM, nN, nwg, G, c;
    __device__ __forceinline__ void init(int nM_, int nN_, int G_, int c_) { nM = nM_; nN = nN_; nwg = nM * nN; G = G_; c = c_; }
    __device__ __forceinline__ bool next(int i, int& pm, int& pn) const {
        const long L = (long)i * G + c; if (L >= nwg) return false;
        int wgid = (int)L; { const int q = nwg / NXCD, r = nwg % NXCD, xcd = wgid % NXCD, off = wgid / NXCD; wgid = (xcd < r ? xcd * (q + 1) : r * (q + 1) + (xcd - r) * q) + off; }
        if (nM == 16 * NXCD && (nN & 1) == 0) {
            const int q = nwg / NXCD, x = wgid / q, p = wgid - x * q, nfull = nN >> 2;
            if (p < nfull * 64) { const int rr = p >> 5, slot = p & 31; pm = x * 16 + (rr & 1) * 8 + (slot & 7); pn = (rr >> 1) * 4 + (slot >> 3); }
            else { const int p2 = p - nfull * 64; pm = x * 16 + (p2 & 15); pn = nfull * 4 + (p2 >> 4); }
            return true; }
        const int nig = WGM * nN, gid = wgid / nig, fm = gid * WGM, gsz = (nM - fm) < WGM ? (nM - fm) : WGM;
        pm = fm + ((wgid % nig) % gsz); pn = (wgid % nig) / gsz; return true;
    }
};
struct PlainSched {
    TileOrder o; const char* Abase; const char* Bbase; unsigned tstep, tstepA;
    __device__ __forceinline__ bool next(int i, Unit& u) const { int pm, pn; if (!o.next(i, pm, pn)) return false; u.pm = pm; u.pn = pn; u.orow = pm; u.ao = (unsigned)pm * (tstepA ? tstepA : tstep); u.bo = (unsigned)pn * tstep; return true; }
};
__device__ __forceinline__ int expert_of(const LAS int* bstart, int rb) { int e = 0;
#pragma unroll
    for (int j = 1; j < 8; ++j) e += (rb >= bstart[j]) ? 1 : 0;
    return e; }
struct MoeGuSched {
    TileOrder o; int rb0; const LAS int* bstart; const char* Abase; const char* Bbase;
    __device__ __forceinline__ bool next(int i, Unit& u) const { int pm, pn; if (!o.next(i, pm, pn)) return false; const int rb = rb0 + pm, e = expert_of(bstart, rb);
        u.pm = rb; u.pn = pn; u.orow = rb; u.ao = 0u; u.bo = (unsigned)e * (unsigned)EXP_GU_BYTES + (unsigned)pn * (unsigned)(256 * D); return true; }
};
struct MoeDnSched {
    TileOrder o; int rb0; const LAS int* bstart; const char* Abase; const char* Bbase;
    __device__ __forceinline__ bool next(int i, Unit& u) const { int pm, pn; if (!o.next(i, pm, pn)) return false; const int rb = rb0 + pm, e = expert_of(bstart, rb);
        u.pm = rb; u.pn = pn; u.orow = rb; u.ao = (unsigned)rb * (unsigned)(256 * DEXP); u.bo = (unsigned)e * (unsigned)EXP_DN_BYTES + (unsigned)pn * (unsigned)(256 * DEXP); return true; }
};
struct MoeDnSplitSched {
    int n, G, c; const LAS int* bstart; const char* Abase; const char* Bbase;
    __device__ __forceinline__ bool next(int i, Unit& u) const { const int L = i * G + c; if (L >= n) return false; const int ks = L % 7, t = L / 7, pn = t & 3, pm = t >> 2, rb = 256 + pm, e = expert_of(bstart, rb);
        u.pm = rb; u.pn = pn; u.orow = ks * 8 + pm; u.ao = (unsigned)rb * (unsigned)(256 * DEXP) + ks * 512u; u.bo = (unsigned)e * (unsigned)EXP_DN_BYTES + (unsigned)pn * (unsigned)(256 * DEXP) + ks * 512u; return true; }
};

__device__ __forceinline__ float row_rstd(const float* ssp, int row) { const f32x4 p = *(const f32x4*)(ssp + (size_t)row * 4); return 1.0f / sqrtf(((p[0] + p[1]) + (p[2] + p[3])) * (1.0f / D) + EPS); }
__device__ __forceinline__ void row_rstd8(const float* ssp, int row0, float (&rs)[2][4]) {
    f32x4 p[2][4];
#pragma unroll
    for (int ai = 0; ai < 2; ++ai)
#pragma unroll
        for (int m = 0; m < 4; ++m) p[ai][m] = *(const f32x4*)(ssp + (size_t)(row0 + ai * 128 + m * 16) * 4);
#pragma unroll
    for (int ai = 0; ai < 2; ++ai)
#pragma unroll
        for (int m = 0; m < 4; ++m) rs[ai][m] = 1.0f / sqrtf(((p[ai][m][0] + p[ai][m][1]) + (p[ai][m][2] + p[ai][m][3])) * (1.0f / D) + EPS);
}
struct StoreMap { int src4, srow, sgrp; };
__device__ __forceinline__ StoreMap store_map(int fr, int fq) { StoreMap sm; sm.src4 = ((((fr & 3) << 4) | (fq << 2) | (fr >> 2)) << 2); sm.srow = (fq << 2) | (fr >> 2); sm.sgrp = fr & 3; return sm; }
__device__ __forceinline__ u32x4 perm_q(const StoreMap& sm, u32x4 w) { u32x4 r;
    r.x = (unsigned)__builtin_amdgcn_ds_bpermute(sm.src4, (int)w.x); r.y = (unsigned)__builtin_amdgcn_ds_bpermute(sm.src4, (int)w.y);
    r.z = (unsigned)__builtin_amdgcn_ds_bpermute(sm.src4, (int)w.z); r.w = (unsigned)__builtin_amdgcn_ds_bpermute(sm.src4, (int)w.w); return r; }
__device__ __forceinline__ u32x2 perm_q(const StoreMap& sm, u32x2 w) { u32x2 r;
    r.x = (unsigned)__builtin_amdgcn_ds_bpermute(sm.src4, (int)w.x); r.y = (unsigned)__builtin_amdgcn_ds_bpermute(sm.src4, (int)w.y); return r; }
struct EpiBf16 {
    static constexpr bool PERM = true;
    bf16* O; int ldc; const float* ssp;
    __device__ __forceinline__ void operator()(const f32x4 (&acc)[2][2][4][2], const Unit& u, int wr, int wc, int fr, int fq) const {
        const int row0 = u.orow * BM + wr * 64 + fr; const StoreMap sm = store_map(fr, fq);
        bf16* const Os = O + (size_t)(u.orow * BM + wr * 64 + sm.srow) * ldc + u.pn * BM + wc * 32 + 8 * sm.sgrp;
        float rsv[2][4]; row_rstd8(ssp, row0, rsv);
#pragma unroll
        for (int ai = 0; ai < 2; ++ai)
#pragma unroll
            for (int m = 0; m < 4; ++m) { bf16* rowp = Os + (size_t)(ai * HALF + m * 16) * ldc;
                const float rs = rsv[ai][m];
#pragma unroll
                for (int bj = 0; bj < 2; ++bj) { const f32x4 v0 = acc[ai][bj][m][0] * rs, v1 = acc[ai][bj][m][1] * rs;
                    u32x4 w; w.x = pk2(v0[0], v0[1]); w.y = pk2(v0[2], v0[3]); w.z = pk2(v1[0], v1[1]); w.w = pk2(v1[2], v1[3]);
                    *(u32x4*)(rowp + bj * HALF) = perm_q(sm, w); } }
    }
};
struct EpiZ0 {
    static constexpr bool PERM = true;
    bf16* O; const float* ropeC; const float* ropeS;
    __device__ __forceinline__ void operator()(const f32x4 (&acc)[2][2][4][2], const Unit& u, int wr, int wc, int fr, int fq) const {
        const int row0 = u.orow * BM + wr * 64 + fr, col0 = u.pn * BM + wc * 32 + 8 * fq;
        const bool rot = u.pn < 4; const float qs = (u.pn < 2) ? 0.08838834764831845f : 1.0f;
        const int i0 = 16 * wc + 4 * fq; const StoreMap sm = store_map(fr, fq);
        bf16* const Os = O + (size_t)(u.orow * BM + wr * 64 + sm.srow) * EVEN_IN + u.pn * BM + wc * 32 + 8 * sm.sgrp;
        f32x4 csv[2][4], snv[2][4];
        if (rot) {
#pragma unroll
            for (int ai = 0; ai < 2; ++ai)
#pragma unroll
                for (int m = 0; m < 4; ++m) { const int pos = (row0 + ai * HALF + m * 16) & (SEQ - 1); csv[ai][m] = *(const f32x4*)(ropeC + (size_t)pos * 64 + i0); snv[ai][m] = *(const f32x4*)(ropeS + (size_t)pos * 64 + i0); } }
#pragma unroll
        for (int ai = 0; ai < 2; ++ai)
#pragma unroll
            for (int m = 0; m < 4; ++m) { bf16* rowp = Os + (size_t)(ai * HALF + m * 16) * EVEN_IN;
                f32x4 cs = {1.f, 1.f, 1.f, 1.f}, sn = {0.f, 0.f, 0.f, 0.f};
                if (rot) { cs = csv[ai][m]; sn = snv[ai][m]; }
#pragma unroll
                for (int bj = 0; bj < 2; ++bj) { f32x4 v0 = acc[ai][bj][m][0], v1 = acc[ai][bj][m][1];
                    if (rot) { f32x4 r0, r1;
                        r0[0] = (v0[0] * cs[0] - v0[1] * sn[0]) * qs; r0[1] = (v0[1] * cs[0] + v0[0] * sn[0]) * qs;
                        r0[2] = (v0[2] * cs[1] - v0[3] * sn[1]) * qs; r0[3] = (v0[3] * cs[1] + v0[2] * sn[1]) * qs;
                        r1[0] = (v1[0] * cs[2] - v1[1] * sn[2]) * qs; r1[1] = (v1[1] * cs[2] + v1[0] * sn[2]) * qs;
                        r1[2] = (v1[2] * cs[3] - v1[3] * sn[3]) * qs; r1[3] = (v1[3] * cs[3] + v1[2] * sn[3]) * qs;
                        v0 = r0; v1 = r1; }
                    u32x4 w; w.x = pk2(v0[0], v0[1]); w.y = pk2(v0[2], v0[3]); w.z = pk2(v1[0], v1[1]); w.w = pk2(v1[2], v1[3]);
                    *(u32x4*)(rowp + bj * HALF) = perm_q(sm, w); } }
    }
};
struct EpiSwiGLU {
    static constexpr bool PERM = true;
    bf16* O; int ldc; const float* ssp;
    __device__ __forceinline__ void operator()(const f32x4 (&acc)[2][2][4][2], const Unit& u, int wr, int wc, int fr, int fq) const {
        const int row0 = u.orow * BM + wr * 64 + fr; const StoreMap sm = store_map(fr, fq);
        bf16* const Os = O + (size_t)(u.orow * BM + wr * 64 + sm.srow) * ldc + u.pn * HALF + wc * 32 + 8 * sm.sgrp;
        float rsv[2][4]; row_rstd8(ssp, row0, rsv);
        u32x4 pprev = {0u, 0u, 0u, 0u}; bf16* rprev = Os;
#pragma unroll
        for (int ai = 0; ai < 2; ++ai)
#pragma unroll
            for (int m = 0; m < 4; ++m) { bf16* rowp = Os + (size_t)(ai * HALF + m * 16) * ldc;
                const float rs = rsv[ai][m];
                const f32x4 g0 = acc[ai][0][m][0] * rs, g1 = acc[ai][0][m][1] * rs, u0 = acc[ai][1][m][0] * rs, u1 = acc[ai][1][m][1] * rs;
                const f32x2 y0 = swiglu2((f32x2){g0[0], g0[1]}, (f32x2){u0[0], u0[1]}), y1 = swiglu2((f32x2){g0[2], g0[3]}, (f32x2){u0[2], u0[3]});
                const f32x2 y2 = swiglu2((f32x2){g1[0], g1[1]}, (f32x2){u1[0], u1[1]}), y3 = swiglu2((f32x2){g1[2], g1[3]}, (f32x2){u1[2], u1[3]});
                u32x4 w; w.x = pk2(y0.x, y0.y); w.y = pk2(y1.x, y1.y); w.z = pk2(y2.x, y2.y); w.w = pk2(y3.x, y3.y);
                const u32x4 pw = perm_q(sm, w);
                if (ai + m > 0) *(u32x4*)rprev = pprev;
                pprev = pw; rprev = rowp; }
        *(u32x4*)rprev = pprev;
    }
};
struct EpiSwiGLU8 {
    static constexpr bool PERM = true;
    unsigned char* O; int ldc;
    __device__ __forceinline__ void operator()(const f32x4 (&acc)[2][2][4][2], const Unit& u, int wr, int wc, int fr, int fq) const {
        const StoreMap sm = store_map(fr, fq);
        unsigned char* const Os = O + (size_t)(u.orow * BM + wr * 64 + sm.srow) * ldc + u.pn * HALF + wc * 32 + 8 * sm.sgrp;
        u32x2 pprev = {0u, 0u}; unsigned char* rprev = Os;
#pragma unroll
        for (int ai = 0; ai < 2; ++ai)
#pragma unroll
            for (int m = 0; m < 4; ++m) { unsigned char* rowp = Os + (size_t)(ai * HALF + m * 16) * ldc;
                const f32x4 g0 = acc[ai][0][m][0] * W8_INV, g1 = acc[ai][0][m][1] * W8_INV, u0 = acc[ai][1][m][0] * W8_INV, u1 = acc[ai][1][m][1] * W8_INV;
                const f32x2 y0 = swiglu2((f32x2){g0[0], g0[1]}, (f32x2){u0[0], u0[1]}), y1 = swiglu2((f32x2){g0[2], g0[3]}, (f32x2){u0[2], u0[3]});
                const f32x2 y2 = swiglu2((f32x2){g1[0], g1[1]}, (f32x2){u1[0], u1[1]}), y3 = swiglu2((f32x2){g1[2], g1[3]}, (f32x2){u1[2], u1[3]});
                u32x2 w; w.x = pk4_fp8(y0.x, y0.y, y1.x, y1.y); w.y = pk4_fp8(y2.x, y2.y, y3.x, y3.y);
                const u32x2 pw = perm_q(sm, w);
                if (ai + m > 0) *(u32x2*)rprev = pprev;
                pprev = pw; rprev = rowp; }
        *(u32x2*)rprev = pprev;
    }
};
struct EpiBf16S {
    static constexpr bool PERM = true;
    bf16* O; int ldc; float scale;
    __device__ __forceinline__ void operator()(const f32x4 (&acc)[2][2][4][2], const Unit& u, int wr, int wc, int fr, int fq) const {
        const StoreMap sm = store_map(fr, fq);
        bf16* const Os = O + (size_t)(u.orow * BM + wr * 64 + sm.srow) * ldc + u.pn * BM + wc * 32 + 8 * sm.sgrp;
#pragma unroll
        for (int ai = 0; ai < 2; ++ai)
#pragma unroll
            for (int m = 0; m < 4; ++m) { bf16* rowp = Os + (size_t)(ai * HALF + m * 16) * ldc;
#pragma unroll
                for (int bj = 0; bj < 2; ++bj) { const f32x4 v0 = acc[ai][bj][m][0] * scale, v1 = acc[ai][bj][m][1] * scale;
                    u32x4 w; w.x = pk2(v0[0], v0[1]); w.y = pk2(v0[2], v0[3]); w.z = pk2(v1[0], v1[1]); w.w = pk2(v1[2], v1[3]);
                    *(u32x4*)(rowp + bj * HALF) = perm_q(sm, w); } }
    }
};
struct EpiRes {
    static constexpr bool PERM = false;
    const float* base; float* out;
    __device__ __forceinline__ void operator()(const f32x4 (&acc)[2][2][4][2], const Unit& u, int wr, int wc, int fr, int fq) const {
        const int row0 = u.orow * BM + wr * 64 + fr, col0 = u.pn * BM + wc * 32 + 4 * fq;
#pragma unroll
        for (int ai = 0; ai < 2; ++ai)
#pragma unroll
            for (int m = 0; m < 4; ++m) { const size_t off = (size_t)(row0 + ai * HALF + m * 16) * D + col0;
#pragma unroll
                for (int bj = 0; bj < 2; ++bj)
#pragma unroll
                    for (int n = 0; n < 2; ++n) { const f32x4 bs = *(const f32x4*)(base + off + bj * HALF + n * 16); *(f32x4*)(out + off + bj * HALF + n * 16) = bs + acc[ai][bj][m][n]; } }
    }
};
template <int MODE> struct EpiResB {
    static constexpr bool PERM = true;
    const float* base; const bf16* xi; int ldi; bf16* xo; int ldo; float* ssp; LAS float* P;
    __device__ __forceinline__ void load_half(int ai, int row0, int col0, f32x4 (&xf)[4][2][2], u32x4 (&xb)[4][2]) const {
#pragma unroll
        for (int m = 0; m < 4; ++m) { const int row = row0 + ai * HALF + m * 16;
#pragma unroll
            for (int bj = 0; bj < 2; ++bj) {
                if (MODE == 0) { const float* p = base + (size_t)row * D + col0 + bj * HALF; xf[m][bj][0] = *(const f32x4*)p; xf[m][bj][1] = *(const f32x4*)(p + 4); }
                else xb[m][bj] = *(const u32x4*)(xi + (size_t)row * ldi + col0 + bj * HALF); } }
    }
    __device__ __forceinline__ void make_half(const f32x4 (&acc)[2][2][4][2], int ai, const f32x4 (&xf)[4][2][2], const u32x4 (&xb)[4][2], u32x4 (&w)[4][2], float (&sq)[4]) const {
#pragma unroll
        for (int m = 0; m < 4; ++m) { float q = 0.f;
#pragma unroll
            for (int bj = 0; bj < 2; ++bj) { f32x4 h0, h1;
                if (MODE == 0) { h0 = xf[m][bj][0]; h1 = xf[m][bj][1]; }
                else { const u32x4 b = xb[m][bj]; h0 = (f32x4){bf2f(b.x & 0xffffu), bf2f(b.x >> 16), bf2f(b.y & 0xffffu), bf2f(b.y >> 16)}; h1 = (f32x4){bf2f(b.z & 0xffffu), bf2f(b.z >> 16), bf2f(b.w & 0xffffu), bf2f(b.w >> 16)}; }
                h0 = h0 + acc[ai][bj][m][0]; h1 = h1 + acc[ai][bj][m][1];
                u32x4 v; v.x = pk2(h0[0], h0[1]); v.y = pk2(h0[2], h0[3]); v.z = pk2(h1[0], h1[1]); v.w = pk2(h1[2], h1[3]); w[m][bj] = v;
                const float r0 = bf2f(v.x & 0xffffu), r1 = bf2f(v.x >> 16), r2 = bf2f(v.y & 0xffffu), r3 = bf2f(v.y >> 16), r4 = bf2f(v.z & 0xffffu), r5 = bf2f(v.z >> 16), r6 = bf2f(v.w & 0xffffu), r7 = bf2f(v.w >> 16);
                q += ((r0 * r0 + r1 * r1) + (r2 * r2 + r3 * r3)) + ((r4 * r4 + r5 * r5) + (r6 * r6 + r7 * r7)); }
            q += __shfl_xor(q, 16); q += __shfl_xor(q, 32); sq[m] = q; }
    }
    __device__ __forceinline__ void store_half(int ai, int row0, int col0, int wr, int wc, int fr, int fq, const u32x4 (&w)[4][2], const float (&sq)[4]) const {
        const StoreMap sm = store_map(fr, fq); const int srow0 = row0 - fr + sm.srow, scol0 = col0 - 8 * fq + 8 * sm.sgrp;
#pragma unroll
        for (int m = 0; m < 4; ++m) { const int row = srow0 + ai * HALF + m * 16;
#pragma unroll
            for (int bj = 0; bj < 2; ++bj) *(u32x4*)(xo + (size_t)row * ldo + scol0 + bj * HALF) = perm_q(sm, w[m][bj]);
            if (fq == 0) P[(ai * HALF + wr * 64 + m * 16 + fr) * 4 + wc] = sq[m]; }
    }
    __device__ __forceinline__ void operator()(const f32x4 (&acc)[2][2][4][2], const Unit& u, int wr, int wc, int fr, int fq) const {
        const int row0 = u.orow * BM + wr * 64 + fr, col0 = u.pn * BM + wc * 32 + 8 * fq;
        f32x4 xf[4][2][2]; u32x4 xb0[4][2], xb1[4][2], w[4][2]; float sq[4];
        if (MODE == 1) { load_half(0, row0, col0, xf, xb0); load_half(1, row0, col0, xf, xb1);
            make_half(acc, 0, xf, xb0, w, sq); store_half(0, row0, col0, wr, wc, fr, fq, w, sq);
            make_half(acc, 1, xf, xb1, w, sq); store_half(1, row0, col0, wr, wc, fr, fq, w, sq); }
        else { u32x4 w1[4][2]; float sq1[4];
            load_half(0, row0, col0, xf, xb0); make_half(acc, 0, xf, xb0, w, sq);
            load_half(1, row0, col0, xf, xb0); store_half(0, row0, col0, wr, wc, fr, fq, w, sq);
            make_half(acc, 1, xf, xb0, w1, sq1); store_half(1, row0, col0, wr, wc, fr, fq, w1, sq1); }
        asm volatile("s_waitcnt lgkmcnt(0)" ::: "memory"); __builtin_amdgcn_s_barrier(); asm volatile("" ::: "memory");
        if (wr == 0) { const int r = wc * 64 + fq * 16 + fr; const f32x4 p = *(const LAS f32x4*)(P + r * 4); ssp[(size_t)(u.orow * BM + r) * 4 + u.pn] = (p[0] + p[1]) + (p[2] + p[3]); }
    }
};

template <class Epi, class Sched, bool GATHER, bool ALIGN_EPI, bool SP2, bool FP8 = false>
__device__ __forceinline__ void gemm_phase(LAS unsigned char* lds, const LAS unsigned short* rowtok, const int K, const Sched& S, const Epi& E, const int nt_unit = 0, const int lda = 0) {
    int tid = threadIdx.x; asm volatile("" : "+v"(tid));
    const int wid = __builtin_amdgcn_readfirstlane(tid >> 6), lane = tid & 63, wr = wid >> 2, wc = wid & 3, fr = lane & 15, fq = lane >> 4;
    const int KB = FP8 ? K : 2 * K;
    const int nt = nt_unit ? nt_unit : KB / (BK * 2);
    unsigned voffA[2], voffB[2]; int gR[2], gC[2];
#pragma unroll
    for (int i = 0; i < 2; ++i) { int R, C; stage_rc(tid * 16 + i * 8192, R, C); const int Rb = Epi::PERM ? ((R & ~31) + perm32(R & 31)) : R;
        voffA[i] = (unsigned)(R * (lda ? lda : KB) + C * 2); voffB[i] = (unsigned)(Rb * KB + C * 2); gR[i] = R; gC[i] = C * 2; }
    const unsigned kstep = (unsigned)(BK * 2);
    const unsigned hstep = (unsigned)(HALF * KB), hstepA = (unsigned)(HALF * (lda ? lda : KB));
    const __amdgpu_buffer_rsrc_t rA = __builtin_amdgcn_make_buffer_rsrc((void*)S.Abase, 0, 0xFFFFFFF0u, 0x00020000), rB = __builtin_amdgcn_make_buffer_rsrc((void*)S.Bbase, 0, 0xFFFFFFF0u, 0x00020000);
    const unsigned ldsw = (unsigned)wid * 1024u;
    const int aoff = lds_byte(wr * 64 + fr, fq * 8), boff = lds_byte(wc * 32 + fr, fq * 8);
    unsigned gcur[2][2], gnxt[2][2];
#define PG8_SA(b, h) (((b) * 2 + (h)) * HTB)
#define PG8_SB(b, h) ((4 + (b) * 2 + (h)) * HTB)
#define PG8_STAGE(bufoff, soff, voff) do { _Pragma("unroll") for (int _i = 0; _i < 2; ++_i) \
        __builtin_amdgcn_raw_ptr_buffer_load_lds(rB, (LAS void*)(lds + (bufoff) + ldsw + _i * 8192), 16, (voff)[_i], (soff), 0, 0); } while (0)
#define PG8_STAGE_A(bufoff, soff, h, GV) do { _Pragma("unroll") for (int _i = 0; _i < 2; ++_i) { \
        if constexpr (GATHER) __builtin_amdgcn_raw_ptr_buffer_load_lds(rA, (LAS void*)(lds + (bufoff) + ldsw + _i * 8192), 16, (GV)[h][_i], (soff), 0, 0); \
        else __builtin_amdgcn_raw_ptr_buffer_load_lds(rA, (LAS void*)(lds + (bufoff) + ldsw + _i * 8192), 16, voffA[_i], (soff) + (h) * hstepA, 0, 0); } } while (0)
#define PG8_LDA(dst, b, h) do { _Pragma("unroll") for (int m = 0; m < 4; ++m) { if constexpr (FP8) { const LAS unsigned char* _p = lds + PG8_SA(b, h) + aoff + m * 2048; \
            dst##8[m] = __builtin_shufflevector(*(const LAS i32x4*)_p, *(const LAS i32x4*)(_p + 1024), 0, 1, 2, 3, 4, 5, 6, 7); } \
        else { _Pragma("unroll") for (int k = 0; k < 2; ++k) dst[m][k] = *(const LAS bf16x8*)(lds + PG8_SA(b, h) + aoff + m * 2048 + k * 1024); } } } while (0)
#define PG8_LDB(dst, b, h) do { _Pragma("unroll") for (int n = 0; n < 2; ++n) { if constexpr (FP8) { const LAS unsigned char* _p = lds + PG8_SB(b, h) + boff + n * 2048; \
            dst##8[n] = __builtin_shufflevector(*(const LAS i32x4*)_p, *(const LAS i32x4*)(_p + 1024), 0, 1, 2, 3, 4, 5, 6, 7); } \
        else { _Pragma("unroll") for (int k = 0; k < 2; ++k) dst[n][k] = *(const LAS bf16x8*)(lds + PG8_SB(b, h) + boff + n * 2048 + k * 1024); } } } while (0)
#define PG8_MMA(ai, bj, At, Bt) do { __builtin_amdgcn_s_setprio(1); _Pragma("unroll") for (int m = 0; m < 4; ++m) _Pragma("unroll") for (int n = 0; n < 2; ++n) { \
        if constexpr (FP8) { asm volatile("v_mfma_f32_16x16x128_f8f6f4 %0, %1, %2, %0" : "+v"(acc[ai][bj][m][n]) : "v"(Bt##8[n]), "v"(At##8[m])); }        \
        else { _Pragma("unroll") for (int k = 0; k < 2; ++k) acc[ai][bj][m][n] = __builtin_amdgcn_mfma_f32_16x16x32_bf16(Bt[n][k], At[m][k], acc[ai][bj][m][n], 0, 0, 0); } } \
        __builtin_amdgcn_s_setprio(0); } while (0)
#define PG8_WAIT_V(n) asm volatile("s_waitcnt vmcnt(" #n ")" ::: "memory")
#define PG8_WAIT_L(n) asm volatile("s_waitcnt lgkmcnt(" #n ")" ::: "memory")
#define PG8_BAR __builtin_amdgcn_s_barrier()
#define PG8_SCHED __builtin_amdgcn_sched_barrier(0)
#define PG8_GLOAD(G, ord) do { if constexpr (GATHER) { _Pragma("unroll") for (int _h = 0; _h < 2; ++_h) _Pragma("unroll") for (int _i = 0; _i < 2; ++_i) \
        G[_h][_i] = (unsigned)rowtok[(ord) * 256 + _h * HALF + gR[_i]] * (unsigned)KB + (unsigned)gC[_i]; } } while (0)
    LAS int* const ucache = (LAS int*)(lds + 147456);
    if (tid < 32) { Unit u; u.pm = 0; u.pn = 0; u.orow = 0; u.ao = 0u; u.bo = 0u; const bool ok = S.next(tid, u);
        *(LAS i32x4*)(ucache + 8 * tid) = (i32x4){ok ? 1 : 0, u.pm, u.pn, u.orow}; *(LAS i32x4*)(ucache + 8 * tid + 4) = (i32x4){(int)u.ao, (int)u.bo, 0, 0}; }
    asm volatile("s_waitcnt lgkmcnt(0)" ::: "memory"); __builtin_amdgcn_s_barrier(); asm volatile("" ::: "memory");
#define PG8_NEXT(k, U) ([&]() -> bool { if ((k) >= 32) return false; const i32x4 _a = *(const LAS i32x4*)(ucache + 8 * (k)), _b = *(const LAS i32x4*)(ucache + 8 * (k) + 4); \
        (U).pm = __builtin_amdgcn_readfirstlane(_a[1]); (U).pn = __builtin_amdgcn_readfirstlane(_a[2]); (U).orow = __builtin_amdgcn_readfirstlane(_a[3]); \
        (U).ao = (unsigned)__builtin_amdgcn_readfirstlane(_b[0]); (U).bo = (unsigned)__builtin_amdgcn_readfirstlane(_b[1]); return __builtin_amdgcn_readfirstlane(_a[0]) != 0; }())
    Unit cur, nxt; int ui = 0;
    if (!PG8_NEXT(0, cur)) return;
    f32x4 acc[2][2][4][2];
#pragma unroll
    for (int a = 0; a < 2; ++a)
#pragma unroll
        for (int b = 0; b < 2; ++b)
#pragma unroll
            for (int m = 0; m < 4; ++m)
#pragma unroll
                for (int n = 0; n < 2; ++n) { acc[a][b][m][n] = (f32x4){0.f, 0.f, 0.f, 0.f}; if constexpr (FP8) asm volatile("" : "+v"(acc[a][b][m][n])); }
    bf16x8 At[4][2], B0[2][2], B1[2][2]; i32x8 At8[4], B08[2], B18[2];
    int sc1 = 0x7f7f7f7f, scw = 0x79797979; asm volatile("" : "+v"(sc1), "+v"(scw));
    unsigned cA = cur.ao, cB = cur.bo;
#pragma unroll
    for (int h = 0; h < 2; ++h)
#pragma unroll
        for (int i = 0; i < 2; ++i) { gcur[h][i] = 0u; gnxt[h][i] = 0u; }
    PG8_GLOAD(gcur, 0);
    if constexpr (SP2) {
        PG8_STAGE(PG8_SB(0, 0), cB, voffB); PG8_STAGE(PG8_SB(0, 1), cB + hstep, voffB); PG8_STAGE_A(PG8_SA(0, 0), cA, 0, gcur); PG8_STAGE_A(PG8_SA(0, 1), cA, 1, gcur);
        if (wr == 1) PG8_BAR;
        PG8_WAIT_V(2); PG8_BAR;
        PG8_STAGE(PG8_SB(1, 0), cB + kstep, voffB); PG8_STAGE_A(PG8_SA(1, 0), cA + kstep, 0, gcur); PG8_STAGE(PG8_SB(1, 1), cB + hstep + kstep, voffB);
        PG8_WAIT_V(6); PG8_BAR;
    } else {
        PG8_STAGE(PG8_SB(0, 0), cB, voffB); PG8_STAGE_A(PG8_SA(0, 0), cA, 0, gcur); PG8_STAGE(PG8_SB(0, 1), cB + hstep, voffB); PG8_STAGE_A(PG8_SA(0, 1), cA, 1, gcur);
        if (wr == 1) PG8_BAR;
        PG8_WAIT_V(4); PG8_BAR;
        PG8_STAGE(PG8_SB(1, 0), cB + kstep, voffB); PG8_STAGE_A(PG8_SA(1, 0), cA + kstep, 0, gcur); PG8_STAGE(PG8_SB(1, 1), cB + hstep + kstep, voffB);
        PG8_WAIT_V(6); PG8_BAR;
    }
    for (;;) {
        const bool has_next = PG8_NEXT(ui + 1, nxt);
        const unsigned nA = has_next ? nxt.ao : cA, nB = has_next ? nxt.bo : cB;
#pragma nounroll
        for (int t = 0; t < nt; t += 2) {
            const bool last = (t == nt - 2);
            const unsigned a1 = cA + (unsigned)(t + 1) * kstep;
            const unsigned a2 = last ? nA : cA + (unsigned)(t + 2) * kstep, b2 = last ? nB : cB + (unsigned)(t + 2) * kstep;
            const unsigned a3 = a2 + kstep, b3 = b2 + kstep;
            unsigned g2[2][2];
            if constexpr (GATHER) {
                if (last && has_next) { PG8_GLOAD(gnxt, ui + 1); }
#pragma unroll
                for (int h = 0; h < 2; ++h)
#pragma unroll
                    for (int i = 0; i < 2; ++i) g2[h][i] = (last && has_next) ? gnxt[h][i] : gcur[h][i];
            }
            if constexpr (SP2) {
            PG8_LDB(B0, 0, 0); PG8_LDB(B1, 0, 1); PG8_SCHED; PG8_LDA(At, 0, 0); PG8_STAGE_A(PG8_SA(1, 1), a1, 1, gcur);
            PG8_BAR; PG8_MMA(0, 0, At, B0); PG8_MMA(0, 1, At, B1); PG8_WAIT_V(8); PG8_BAR; PG8_SCHED;
            PG8_LDA(At, 0, 1); PG8_STAGE(PG8_SB(0, 0), b2, voffB); PG8_STAGE(PG8_SB(0, 1), b2 + hstep, voffB); PG8_STAGE_A(PG8_SA(0, 0), a2, 0, g2);
            PG8_BAR; PG8_MMA(1, 0, At, B0); PG8_MMA(1, 1, At, B1); PG8_WAIT_V(8); PG8_BAR; PG8_SCHED;
            PG8_LDB(B0, 1, 0); PG8_LDB(B1, 1, 1); PG8_SCHED; PG8_LDA(At, 1, 0); PG8_STAGE_A(PG8_SA(0, 1), a2, 1, g2);
            PG8_BAR; PG8_MMA(0, 0, At, B0); PG8_MMA(0, 1, At, B1); PG8_WAIT_V(8); PG8_BAR; PG8_SCHED;
            PG8_LDA(At, 1, 1); PG8_STAGE(PG8_SB(1, 0), b3, voffB); PG8_STAGE(PG8_SB(1, 1), b3 + hstep, voffB); PG8_STAGE_A(PG8_SA(1, 0), a3, 0, g2);
            PG8_BAR; PG8_MMA(1, 0, At, B0); PG8_MMA(1, 1, At, B1); PG8_WAIT_V(8); PG8_BAR; PG8_SCHED;
            } else {
            PG8_LDB(B0, 0, 0); PG8_SCHED; PG8_LDA(At, 0, 0); PG8_STAGE_A(PG8_SA(1, 1), a1, 1, gcur);
            PG8_WAIT_L(8); PG8_BAR; PG8_WAIT_L(0); PG8_MMA(0, 0, At, B0); PG8_BAR; PG8_SCHED;
            PG8_LDB(B1, 0, 1); PG8_STAGE(PG8_SB(0, 0), b2, voffB);
            PG8_BAR; PG8_WAIT_L(0); PG8_MMA(0, 1, At, B1); PG8_BAR;
            PG8_LDA(At, 0, 1); PG8_STAGE_A(PG8_SA(0, 0), a2, 0, g2);
            PG8_BAR; PG8_WAIT_L(0); PG8_MMA(1, 0, At, B0); PG8_BAR; PG8_SCHED;
            PG8_STAGE(PG8_SB(0, 1), b2 + hstep, voffB);
            PG8_WAIT_V(6); PG8_BAR; PG8_MMA(1, 1, At, B1); PG8_BAR;
            PG8_LDB(B0, 1, 0); PG8_SCHED; PG8_LDA(At, 1, 0); PG8_STAGE_A(PG8_SA(0, 1), a2, 1, g2);
            PG8_WAIT_L(8); PG8_BAR; PG8_WAIT_L(0); PG8_MMA(0, 0, At, B0); PG8_BAR; PG8_SCHED;
            PG8_LDB(B1, 1, 1); PG8_STAGE(PG8_SB(1, 0), b3, voffB);
            PG8_BAR; PG8_WAIT_L(0); PG8_MMA(0, 1, At, B1); PG8_BAR;
            PG8_LDA(At, 1, 1); PG8_STAGE_A(PG8_SA(1, 0), a3, 0, g2);
            PG8_BAR; PG8_WAIT_L(0); PG8_MMA(1, 0, At, B0); PG8_BAR; PG8_SCHED;
            PG8_STAGE(PG8_SB(1, 1), b3 + hstep, voffB);
            PG8_WAIT_V(6); PG8_BAR; PG8_MMA(1, 1, At, B1); PG8_BAR;
            }
        }
        if constexpr (ALIGN_EPI) { if (wr == 0) PG8_BAR; }
        if constexpr (FP8) asm volatile("s_nop 15\n\ts_nop 15" ::: "memory");
        E(acc, cur, wr, wc, fr, fq);
        if (!has_next) break;
#pragma unroll
        for (int a = 0; a < 2; ++a)
#pragma unroll
            for (int b = 0; b < 2; ++b)
#pragma unroll
                for (int m = 0; m < 4; ++m)
#pragma unroll
                    for (int n = 0; n < 2; ++n) { acc[a][b][m][n] = (f32x4){0.f, 0.f, 0.f, 0.f}; if constexpr (FP8) asm volatile("" : "+v"(acc[a][b][m][n])); }
        cur = nxt; cA = nA; cB = nB; ++ui;
        if constexpr (GATHER) {
#pragma unroll
            for (int h = 0; h < 2; ++h)
#pragma unroll
                for (int i = 0; i < 2; ++i) gcur[h][i] = gnxt[h][i];
        }
        if constexpr (ALIGN_EPI) { if (wr == 1) PG8_BAR; }
    }
    PG8_WAIT_V(0);
    if constexpr (!ALIGN_EPI) { if (wr == 0) PG8_BAR; }
    PG8_BAR;
#undef PG8_SA
#undef PG8_SB
#undef PG8_STAGE
#undef PG8_STAGE_A
#undef PG8_LDA
#undef PG8_LDB
#undef PG8_MMA
#undef PG8_WAIT_V
#undef PG8_WAIT_L
#undef PG8_BAR
#undef PG8_SCHED
#undef PG8_GLOAD
#undef PG8_NEXT
}
}

#define XB_TMO      128
#define XB_XCNT(j)  (256  + 64 * (j))
#define XB_XSUB(j)  (1280 + 64 * (j))
#define XB_XGEN(j)  (2304 + 64 * (j))
#define XB_TOP      3328
#define XB_TOPGEN   3392
#define XCD_BAR_WORDS 3456
#define XB_SPIN_CAP (1u << 22)

__device__ __forceinline__ unsigned xb_ld(unsigned* p)              { return __hip_atomic_load(p, __ATOMIC_RELAXED, __HIP_MEMORY_SCOPE_AGENT); }
__device__ __forceinline__ unsigned xb_add(unsigned* p, unsigned v) { return __hip_atomic_fetch_add(p, v, __ATOMIC_RELAXED, __HIP_MEMORY_SCOPE_AGENT); }
__device__ __forceinline__ unsigned xb_xcc_id() { return (unsigned)__builtin_amdgcn_s_getreg((3 << 11) | 20) & 0xFu; }
#define XB_SPIN(cond, bar) do { unsigned _sp = 0; while (cond) { __builtin_amdgcn_s_sleep(1); \
    if ((++_sp & 255u) == 0u) { if (xb_ld(&(bar)[XB_TMO])) break; if (_sp > XB_SPIN_CAP) { atomicAdd(&(bar)[XB_TMO], 1u); break; } } } } while (0)

struct XcdBarrier { unsigned* bar; unsigned x; volatile LAS unsigned* st; };

__device__ __forceinline__ XcdBarrier xcd_barrier_post(unsigned* bar, volatile LAS unsigned* st) {
    XcdBarrier b; b.bar = bar; b.x = xb_xcc_id(); b.st = st;
    if (threadIdx.x == 0) (void)xb_add(&bar[XB_XCNT(b.x)], 1u);
    return b;
}
__device__ __forceinline__ void xcd_barrier_complete(unsigned* bar, unsigned x, unsigned& nloc, unsigned& nx) {
    const unsigned G = gridDim.x * gridDim.y * gridDim.z;
    unsigned sum, cnt, mine, sp = 0u;
    for (;;) {
        sum = 0u; cnt = 0u; mine = 0u;
#pragma unroll
        for (unsigned j = 0; j < 16; ++j) { const unsigned c = xb_ld(&bar[XB_XCNT(j)]); sum += c; cnt += (c > 0u) ? 1u : 0u; mine = (j == x) ? c : mine; }
        if (sum == G) break;
        __builtin_amdgcn_s_sleep(1);
        if ((++sp & 255u) == 0u) { if (xb_ld(&bar[XB_TMO])) break; if (sp > XB_SPIN_CAP) { atomicAdd(&bar[XB_TMO], 1u); break; } }
    }
    nloc = mine > 0u ? mine : 1u; nx = cnt > 0u ? cnt : 1u;
}
__device__ __forceinline__ void xcd_barrier(const XcdBarrier& b) {
    asm volatile("s_waitcnt vmcnt(0)" ::: "memory");
    __syncthreads();
    if (threadIdx.x == 0) {
        unsigned* bar = b.bar;
        __builtin_amdgcn_s_waitcnt(0);
        unsigned nloc = b.st[0], nx = b.st[1];
        if (nloc == 0u) { xcd_barrier_complete(bar, b.x, nloc, nx); b.st[0] = nloc; b.st[1] = nx; }
        const unsigned old = xb_add(&bar[XB_XSUB(b.x)], 1u);
        const unsigned gen = old / nloc;
        if (old + 1u == (gen + 1u) * nloc) {
            __builtin_amdgcn_fence(__ATOMIC_RELEASE, "agent");
            asm volatile("s_waitcnt vmcnt(0)" ::: "memory");
            (void)xb_add(&bar[XB_TOP], 1u);
            XB_SPIN(xb_ld(&bar[XB_TOP]) < (gen + 1u) * nx, bar);
            __builtin_amdgcn_fence(__ATOMIC_ACQUIRE, "agent");
            asm volatile("s_waitcnt vmcnt(0)" ::: "memory");
        } else {
            XB_SPIN(xb_ld(&bar[XB_TOP]) < (gen + 1u) * nx, bar);
            __builtin_amdgcn_fence(__ATOMIC_ACQUIRE, "agent");
            asm volatile("s_waitcnt vmcnt(0)" ::: "memory");
        }
    }
    __syncthreads();
}

struct Args { const float* in[27]; float* out; unsigned char* ws; };
enum { I_X = 0, I_E_NORM_MIX, I_E_W_IN, I_E_RET_GN, I_E_DW_W, I_E_DW_B, I_E_CV_LN_G, I_E_CV_LN_B, I_E_W_OUT, I_E_NORM_FFN, I_E_FFN_GATE, I_E_FFN_UP, I_E_FFN_DOWN,
       I_O_NORM_MIX, I_O_W_IN, I_O_SG_LN_G, I_O_SG_LN_B, I_O_SG_W, I_O_SG_B, I_O_SC_W, I_O_W_OUT, I_O_NORM_FFN, I_O_ROUTER, I_O_EXP_GATE, I_O_EXP_UP, I_O_EXP_DOWN, I_FINAL_NORM };

struct Frame {
    LAS unsigned char* lds;
    int tid, lane, wave, vcu, G;
};
__device__ __forceinline__ void refresh(Frame& F) { int t = threadIdx.x; asm volatile("" : "+v"(t)); F.tid = t; F.lane = t & 63; F.wave = __builtin_amdgcn_readfirstlane(t >> 6); }
struct PT {
    volatile LAS unsigned* tab;
    __device__ __forceinline__ const void* p(int i) const { const unsigned lo = __builtin_amdgcn_readfirstlane(tab[2 * i]), hi = __builtin_amdgcn_readfirstlane(tab[2 * i + 1]); return (const void*)(const GAS char*)(((unsigned long long)hi << 32) | lo); }
    __device__ __forceinline__ const float* in(int i) const { return (const float*)p(i); }
};

struct CvtItem { const float* src; int N; unsigned char* dst; int Kb; int f8; int perm; int goff; float scale; };
__device__ __forceinline__ void cvt_make(CvtItem& d, const float* W, const float* W2, int K, int N, int mode, unsigned char* WT, int f8, int item, int gsel = -1) {
    const int nout = (mode == 2) ? 2 * N : N, KT = 128;
    const int nblk = nout / 128, kb = item / nblk, nb = item % nblk, k0 = KT * kb, n0 = 128 * nb;
    const float* src = W; int col0 = n0;
    d.scale = 1.0f;
    if (mode == 2) { src = (nb & 1) ? W2 : W; col0 = 128 * (nb >> 1); d.scale = (nb & 1) ? -0.6931471805599453f : -1.4426950408889634f; }
    d.src = src + (size_t)k0 * N + col0; d.N = N; d.f8 = f8; d.Kb = f8 ? K : 2 * K; d.perm = (mode == 1 && n0 < 1024) ? 1 : 0;
    d.dst = WT + (size_t)n0 * d.Kb + (size_t)k0 * (f8 ? 1 : 2); d.goff = gsel >= 0 ? gsel * 1024 + k0 : -1;
}
struct CvtPtrs { const float *ein, *eout, *fg, *fu, *fd, *oin, *oout, *xg, *xu, *xd, *g_ffn, *g_omix; };
constexpr int CV_I0 = (D / 128) * (EVEN_IN / 128), CV_I1 = (D / 128) * (D / 128), CV_I2 = (D / 128) * (2 * DFF / 128), CV_I3 = (DFF / 128) * (D / 128), CV_I4 = (D / 128) * (ODD_IN / 128), CV_I5 = CV_I1;
constexpr int CV_SMALL = CV_I0 + CV_I1 + CV_I2 + CV_I3 + CV_I4 + CV_I5;
constexpr int CV_IG = (D / 128) * (2 * DEXP / 128), CV_ID = (DEXP / 128) * (D / 128), CV_IE = CV_IG + CV_ID;
constexpr int CV_TOTAL = CV_SMALL + NEXP * CV_IE;
__device__ __forceinline__ void cvt_decode(CvtItem& d, const CvtPtrs& P, unsigned char* ws, int it) {
    int r = it;
    if (r < NEXP * CV_IE) {
        const int e = r / CV_IE; r -= e * CV_IE;
        if (r < CV_IG) cvt_make(d, P.xg + (size_t)e * D * DEXP, P.xu + (size_t)e * D * DEXP, D, DEXP, 2, ws + WS_WGU8 + (size_t)e * EXP_GU_BYTES, 1, r);
        else cvt_make(d, P.xd + (size_t)e * DEXP * D, nullptr, DEXP, D, 0, ws + WS_WDN8 + (size_t)e * EXP_DN_BYTES, 1, r - CV_IG);
        return; }
    r -= NEXP * CV_IE;
    if (r < CV_I0) { cvt_make(d, P.ein, nullptr, D, EVEN_IN, 1, ws + WS_W_EIN, 0, r); return; } r -= CV_I0;
    if (r < CV_I1) { cvt_make(d, P.eout, nullptr, D, D, 0, ws + WS_W_EOUT, 0, r); return; } r -= CV_I1;
    if (r < CV_I2) { cvt_make(d, P.fg, P.fu, D, DFF, 2, ws + WS_W_FGU, 0, r, 0); return; } r -= CV_I2;
    if (r < CV_I3) { cvt_make(d, P.fd, nullptr, DFF, D, 0, ws + WS_W_FDN, 0, r); return; } r -= CV_I3;
    if (r < CV_I4) { cvt_make(d, P.oin, nullptr, D, ODD_IN, 0, ws + WS_W_OIN, 0, r, 1); return; } r -= CV_I4;
    cvt_make(d, P.oout, nullptr, D, D, 0, ws + WS_W_OOUT, 0, r);
}
constexpr int CV_LD = 132;
constexpr int CV_GT = 69632;
__device__ __forceinline__ void cvt_load(const CvtItem& d, f32x4 (&v)[8], int tid) {
    const int c4 = tid & 31, kr = tid >> 5;
#pragma unroll
    for (int i = 0; i < 8; ++i) v[i] = __builtin_nontemporal_load((const f32x4*)(d.src + (size_t)(kr + 16 * i) * d.N + 4 * c4));
}
__device__ __forceinline__ void cvt_store(const CvtItem& d, const f32x4 (&v)[8], LAS float* tile, const LAS float* gt, int tid) {
    const int c4 = tid & 31, kr = tid >> 5;
#pragma unroll
    for (int i = 0; i < 8; ++i) { const float g = (d.goff >= 0 ? gt[d.goff + kr + 16 * i] : 1.0f) * d.scale; *(LAS f32x4*)(tile + (kr + 16 * i) * CV_LD + 4 * c4) = v[i] * g; }
    WG_SYNC();
    const int nl = tid & 127, q = tid >> 7; const int c = d.perm ? ((nl >> 1) + 64 * (nl & 1)) : nl;
    if (d.f8) { const LAS float* s = tile + (32 * q) * CV_LD + c; u32x4 o0, o1;
#pragma unroll
        for (int j = 0; j < 4; ++j) { o0[j] = pk4_fp8(s[(4 * j) * CV_LD] * W8_SCALE, s[(4 * j + 1) * CV_LD] * W8_SCALE, s[(4 * j + 2) * CV_LD] * W8_SCALE, s[(4 * j + 3) * CV_LD] * W8_SCALE);
            o1[j] = pk4_fp8(s[(16 + 4 * j) * CV_LD] * W8_SCALE, s[(16 + 4 * j + 1) * CV_LD] * W8_SCALE, s[(16 + 4 * j + 2) * CV_LD] * W8_SCALE, s[(16 + 4 * j + 3) * CV_LD] * W8_SCALE); }
        unsigned char* o = d.dst + (size_t)nl * d.Kb + 32 * q; *(u32x4*)o = o0; *(u32x4*)(o + 16) = o1; }
    else { const LAS float* s = tile + (32 * q) * CV_LD + c; unsigned char* o = d.dst + (size_t)nl * d.Kb + 64 * q;
#pragma unroll
        for (int h = 0; h < 4; ++h) {
            u32x4 w; w.x = pk2(s[(8 * h) * CV_LD], s[(8 * h + 1) * CV_LD]); w.y = pk2(s[(8 * h + 2) * CV_LD], s[(8 * h + 3) * CV_LD]);
            w.z = pk2(s[(8 * h + 4) * CV_LD], s[(8 * h + 5) * CV_LD]); w.w = pk2(s[(8 * h + 6) * CV_LD], s[(8 * h + 7) * CV_LD]);
            *(u32x4*)(o + 16 * h) = w; } }
    WG_SYNC();
}
__device__ __forceinline__ void sincos_d(double a, float& s, float& c) {
    const double k = __builtin_rint(a * 0.63661977236758134308);
    double r = __builtin_fma(-k, 1.57079632679489655800e+00, a); r = __builtin_fma(-k, 6.12323399573676603587e-17, r);
    const double r2 = r * r;
    double sp = 1.0 / 6227020800.0; sp = sp * r2 - 1.0 / 39916800.0; sp = sp * r2 + 1.0 / 362880.0; sp = sp * r2 - 1.0 / 5040.0; sp = sp * r2 + 1.0 / 120.0; sp = sp * r2 - 1.0 / 6.0; sp = sp * r2 + 1.0; sp = sp * r;
    double cp = 1.0 / 87178291200.0; cp = cp * r2 - 1.0 / 479001600.0; cp = cp * r2 + 1.0 / 3628800.0; cp = cp * r2 - 1.0 / 40320.0; cp = cp * r2 + 1.0 / 720.0; cp = cp * r2 - 1.0 / 24.0; cp = cp * r2 + 0.5; cp = 1.0 - cp * r2;
    const int q = (int)((long long)k & 3);
    const double ss = (q == 0) ? sp : (q == 1) ? cp : (q == 2) ? -sp : -cp;
    const double cc = (q == 0) ? cp : (q == 1) ? -sp : (q == 2) ? -cp : sp;
    s = (float)ss; c = (float)cc;
}

struct RopeJob { double f; int gt, NGT, done; };
__device__ __forceinline__ void rope_init(RopeJob& r, const Frame& F) { r.gt = F.vcu * NTHR + F.tid; r.NGT = F.G * NTHR; r.done = 0;
    double f = 1.0; const int i = r.gt & 63; for (int j = 0; j < i; ++j) f *= 0.8659643233600653; r.f = f; }
__device__ __forceinline__ void rope_step(RopeJob& r, unsigned char* ws) {
    const int idx = r.gt + r.done * r.NGT; ++r.done; if (idx >= SEQ * 64) return;
    float* rc = (float*)(ws + WS_ROPE); float* rs = rc + (size_t)SEQ * 64;
    float s, c; sincos_d((double)(idx >> 6) * r.f, s, c); rc[idx] = c; rs[idx] = s; }
__device__ __forceinline__ void misc_tables(Frame& F, const PT& a, unsigned char* ws, RopeJob& rj) {
    const int gt = F.vcu * NTHR + F.tid, NGT = F.G * NTHR;
    while (rj.gt + rj.done * rj.NGT < SEQ * 64) rope_step(rj, ws);
    bf16* sg = (bf16*)(ws + WS_SGW); const float* sw = a.in(I_O_SG_W);
    for (int idx = gt; idx < 4 * 128 * 128; idx += NGT) { const int p = (idx >> 7) & 127, q = idx & 127; sg[idx] = (bf16)f2bf(((p >> 6) >= (q >> 6)) ? sw[idx] : 0.0f); }
}

__device__ __forceinline__ void convert_weights(Frame& F, const PT& a, unsigned char* ws, int it0, int it1, RopeJob& rj) {
    LAS float* tile = (LAS float*)F.lds; LAS float* gt = (LAS float*)(F.lds + CV_GT);
    CvtPtrs P; P.ein = a.in(I_E_W_IN); P.eout = a.in(I_E_W_OUT); P.fg = a.in(I_E_FFN_GATE); P.fu = a.in(I_E_FFN_UP); P.fd = a.in(I_E_FFN_DOWN); P.oin = a.in(I_O_W_IN); P.oout = a.in(I_O_W_OUT);
    P.xg = a.in(I_O_EXP_GATE); P.xu = a.in(I_O_EXP_UP); P.xd = a.in(I_O_EXP_DOWN); P.g_ffn = a.in(I_E_NORM_FFN); P.g_omix = a.in(I_O_NORM_MIX);
    for (int i = F.tid; i < 2048; i += NTHR) gt[i] = (i < 1024) ? P.g_ffn[i] : P.g_omix[i - 1024];
    __syncthreads();
    const int per = (it1 - it0 + F.G - 1) / F.G; const int itb = it0 + F.vcu * per; const int ite = (itb + per < it1) ? itb + per : it1; const int last = ite - 1;
    if (itb >= ite) return;
#define CV_MIN(a, b) ((a) < (b) ? (a) : (b))
    CvtItem dA0, dA1, dB0, dB1; f32x4 vA0[8], vA1[8], vB0[8], vB1[8];
#define CV_LOAD2(d0, d1, v0, v1, k) do { cvt_decode(d0, P, ws, CV_MIN((k), last)); cvt_decode(d1, P, ws, CV_MIN((k) + 1, last)); cvt_load(d0, v0, F.tid); cvt_load(d1, v1, F.tid); } while (0)
#define CV_STORE2(d0, d1, v0, v1, k) do { cvt_store(d0, v0, tile, gt, F.tid); if ((k) + 1 < ite) cvt_store(d1, v1, tile, gt, F.tid); } while (0)
    CV_LOAD2(dA0, dA1, vA0, vA1, itb);
    for (int k = itb;; k += 4) {
        CV_LOAD2(dB0, dB1, vB0, vB1, k + 2);
        rope_step(rj, ws);
        CV_STORE2(dA0, dA1, vA0, vA1, k);
        if (k + 2 >= ite) break;
        CV_LOAD2(dA0, dA1, vA0, vA1, k + 4);
        rope_step(rj, ws);
        CV_STORE2(dB0, dB1, vB0, vB1, k + 2);
        if (k + 4 >= ite) break;
    }
#undef CV_MIN
#undef CV_LOAD2
#undef CV_STORE2
}
__device__ __forceinline__ void rms_row_to_bf16(const float* xrow, const float* gain, bf16* orow, int lane) {
    const f32x4* xr = (const f32x4*)xrow + lane; const f32x4* gr = (const f32x4*)gain + lane;
    f32x4 v[4]; float s = 0.f;
#pragma unroll
    for (int j = 0; j < 4; ++j) { v[j] = xr[64 * j]; s += (v[j][0] * v[j][0] + v[j][1] * v[j][1]) + (v[j][2] * v[j][2] + v[j][3] * v[j][3]); }
    const float r = 1.0f / sqrtf(wave_sum(s) * (1.f / D) + EPS);
    unsigned long long* o8 = (unsigned long long*)orow + lane;
#pragma unroll
    for (int j = 0; j < 4; ++j) { const f32x4 g = gr[64 * j];
        o8[64 * j] = (unsigned long long)pk2(v[j][0] * r * g[0], v[j][1] * r * g[1]) | ((unsigned long long)pk2(v[j][2] * r * g[2], v[j][3] * r * g[3]) << 32); }
}
__device__ __forceinline__ void norm_phase(Frame& F, const float* x, const float* gain, bf16* XN) {
    const int gw = F.vcu * NWAVES + F.wave, NGW = F.G * NWAVES;
    const f32x4* gr = (const f32x4*)gain + F.lane; f32x4 g[4];
#pragma unroll
    for (int j = 0; j < 4; ++j) g[j] = gr[64 * j];
    for (int m0 = gw; m0 < T; m0 += 4 * NGW) {
        f32x4 v[4][4];
#pragma unroll
        for (int k = 0; k < 4; ++k) { const int m = (m0 + k * NGW < T) ? m0 + k * NGW : m0; const f32x4* xr = (const f32x4*)(x + (size_t)m * D) + F.lane;
#pragma unroll
            for (int j = 0; j < 4; ++j) v[k][j] = xr[64 * j]; }
#pragma unroll
        for (int k = 0; k < 4; ++k) { if (m0 + k * NGW >= T) break; float s = 0.f;
#pragma unroll
            for (int j = 0; j < 4; ++j) s += (v[k][j][0] * v[k][j][0] + v[k][j][1] * v[k][j][1]) + (v[k][j][2] * v[k][j][2] + v[k][j][3] * v[k][j][3]);
            const float r = 1.0f / sqrtf(wave_sum(s) * (1.f / D) + EPS);
            unsigned long long* o8 = (unsigned long long*)(XN + (size_t)(m0 + k * NGW) * D) + F.lane;
#pragma unroll
            for (int j = 0; j < 4; ++j) o8[64 * j] = (unsigned long long)pk2(v[k][j][0] * r * g[j][0], v[k][j][1] * r * g[j][1]) | ((unsigned long long)pk2(v[k][j][2] * r * g[j][2], v[k][j][3] * r * g[j][3]) << 32); }
    }
}
__device__ __forceinline__ bf16x8 frag_row(const LAS unsigned char* base, int ldb, int row0, int k0, int lane) {
    return *(const LAS bf16x8*)(base + (row0 + (lane & 15)) * ldb + (k0 + 8 * (lane >> 4)) * 2);
}
__device__ __forceinline__ bf16x8 frag_tr(const LAS unsigned char* base, int ldb, int k0, int n0, int lane) {
    const int g = lane >> 4, q = (lane & 15) >> 2, p = lane & 3;
    const LAS unsigned char* a0 = base + (k0 + 8 * g + q) * ldb + (n0 + 4 * p) * 2;
    const s16x4 lo = __builtin_amdgcn_ds_read_tr16_b64_v4i16((LAS s16x4*)a0);
    const s16x4 hi = __builtin_amdgcn_ds_read_tr16_b64_v4i16((LAS s16x4*)(a0 + 4 * ldb));
    return (bf16x8){lo[0], lo[1], lo[2], lo[3], hi[0], hi[1], hi[2], hi[3]};
}
__device__ __forceinline__ f32x4 mma16(bf16x8 a, bf16x8 b, f32x4 c) { return __builtin_amdgcn_mfma_f32_16x16x32_bf16(a, b, c, 0, 0, 0); }

constexpr int RT_LDQ = 272, RT_LDP = 144, RT_LDO = 528;
constexpr int RT_QS = 0, RT_KS = 17408, RT_KD = 34816, RT_VS = 52224, RT_PS = 69632, RT_SB = 78848, RT_OS = 113664, RT_PW = 147456;
template <bool MAIN>
__device__ __forceinline__ void ret_unit(Frame& F, const PT& a, unsigned char* ws, int unit) {
    const int b = unit >> 7, h = (unit >> 5) & 3, sc = unit & 31;
    const int tid = F.tid, lane = F.lane, w = F.wave;
    const float* p_gn = MAIN ? a.in(I_E_RET_GN) : nullptr;
    const bf16* Z = (const bf16*)(ws + WS_Z);
    LAS unsigned char* L = F.lds;
    LAS float* pw = (LAS float*)(L + RT_PW);
    if (tid <= 64) { const double g = 1.0 - 1.0 / (double)(32 << h); double p = 1.0; for (int j = 0; j < tid; ++j) p *= g; pw[tid] = (float)p; }
    f32x4 st[8];
    if (MAIN) { const f32x4* sp = (const f32x4*)(ws + WS_RETS) + (size_t)unit * 4096;
#pragma unroll
        for (int td = 0; td < 8; ++td) st[td] = sp[(w * 8 + td) * 64 + lane];
    } else {
#pragma unroll
        for (int td = 0; td < 8; ++td) st[td] = (f32x4){0.f, 0.f, 0.f, 0.f};
    }
    WG_SYNC();
    const float c64 = pw[64];
    const int q4 = lane >> 4, r16 = lane & 15;
    if (MAIN) {
#pragma unroll
        for (int td = 0; td < 8; ++td)
#pragma unroll
            for (int jj = 0; jj < 4; ++jj) *(LAS bf16*)(L + RT_SB + (16 * w + 4 * q4 + jj) * RT_LDQ + (16 * td + r16) * 2) = (bf16)f2bf(st[td][jj]);
    }
    const int lrow = tid >> 3, lseg = tid & 7;
    struct RowBuf { u32x4 k0, k1, v0, v1, q0, q1, g0, g1; };
    RowBuf bufA, bufB; bufA.q0 = bufA.q1 = bufA.g0 = bufA.g1 = bufB.q0 = bufB.q1 = bufB.g0 = bufB.g1 = (u32x4){0u, 0u, 0u, 0u};
    f32x4 gnv[4];
    if (MAIN) {
#pragma unroll
        for (int j = 0; j < 4; ++j) gnv[j] = *(const f32x4*)(p_gn + 128 * h + 16 * (tid & 7) + 4 * j); }
#define RT_LOAD(B_, cc_) do { const bf16* _zr = Z + (size_t)(b * SEQ + (sc * 8 + (cc_)) * 64 + lrow) * EVEN_IN + 128 * h + 16 * lseg; \
        (B_).k0 = *(const u32x4*)(_zr + 512); (B_).k1 = *(const u32x4*)(_zr + 512 + 8); (B_).v0 = *(const u32x4*)(_zr + 1024); (B_).v1 = *(const u32x4*)(_zr + 1024 + 8); \
        if (MAIN) { (B_).q0 = *(const u32x4*)_zr; (B_).q1 = *(const u32x4*)(_zr + 8); (B_).g0 = *(const u32x4*)(_zr + 1536); (B_).g1 = *(const u32x4*)(_zr + 1536 + 8); } } while (0)
    RT_LOAD(bufA, 0); RT_LOAD(bufB, 1);
    auto one_chunk = [&](RowBuf& nb, const int cc) __attribute__((always_inline)) {
        const int t0 = b * SEQ + (sc * 8 + cc) * 64;
        const u32x4 gz0 = nb.g0, gz1 = nb.g1;
        { const u32x4 k0 = nb.k0, k1 = nb.k1, v0 = nb.v0, v1 = nb.v1, q0 = nb.q0, q1 = nb.q1;
          RT_LOAD(nb, cc < 6 ? cc + 2 : cc);
          LAS unsigned char* dst = L + lrow * RT_LDQ + 32 * lseg;
          *(LAS u32x4*)(dst + RT_VS) = v0; *(LAS u32x4*)(dst + RT_VS + 16) = v1;
          if (MAIN) { *(LAS u32x4*)(dst + RT_QS) = q0; *(LAS u32x4*)(dst + RT_QS + 16) = q1;
                      *(LAS u32x4*)(dst + RT_KS) = k0; *(LAS u32x4*)(dst + RT_KS + 16) = k1; }
          const float kd = pw[63 - lrow]; u32x4 d0, d1;
#pragma unroll
          for (int j = 0; j < 4; ++j) { d0[j] = pk2(bf2f(k0[j] & 0xffffu) * kd, bf2f(k0[j] >> 16) * kd); d1[j] = pk2(bf2f(k1[j] & 0xffffu) * kd, bf2f(k1[j] >> 16) * kd); }
          *(LAS u32x4*)(dst + RT_KD) = d0; *(LAS u32x4*)(dst + RT_KD + 16) = d1; }
        WG_SYNC();
        f32x4 oacc[4];
        const int ti = w >> 1, te0 = 4 * (w & 1);
        if (MAIN) {
            bf16x8 qa[4], kb[2][4];
#pragma unroll
            for (int ks = 0; ks < 4; ++ks) { qa[ks] = frag_row(L + RT_QS, RT_LDQ, 16 * ti, 32 * ks, lane);
#pragma unroll
                for (int x = 0; x < 2; ++x) kb[x][ks] = frag_row(L + RT_KS, RT_LDQ, 16 * (2 * (w & 1) + x), 32 * ks, lane); }
            __builtin_amdgcn_sched_barrier(0);
#pragma unroll
            for (int x = 0; x < 2; ++x) { const int tj = 2 * (w & 1) + x; f32x4 p = {0.f, 0.f, 0.f, 0.f};
#pragma unroll
                for (int ks = 0; ks < 4; ++ks) p = mma16(qa[ks], kb[x][ks], p);
#pragma unroll
                for (int jj = 0; jj < 4; ++jj) { const int i = 16 * ti + 4 * q4 + jj, j = 16 * tj + r16; const int dd = i > j ? i - j : j - i;
                    *(LAS bf16*)(L + RT_PS + i * RT_LDP + j * 2) = (bf16)f2bf(p[jj] * pw[dd]); } }
#pragma unroll
            for (int x = 0; x < 4; ++x) oacc[x] = (f32x4){0.f, 0.f, 0.f, 0.f};
#pragma unroll
            for (int kh = 0; kh < 2; ++kh) { bf16x8 sbf[2][4];
#pragma unroll
              for (int ks = 0; ks < 2; ++ks)
#pragma unroll
                  for (int x = 0; x < 4; ++x) sbf[ks][x] = frag_row(L + RT_SB, RT_LDQ, 16 * (te0 + x), 32 * (2 * kh + ks), lane);
              __builtin_amdgcn_sched_barrier(0);
#pragma unroll
              for (int ks = 0; ks < 2; ++ks)
#pragma unroll
                  for (int x = 0; x < 4; ++x) oacc[x] = mma16(qa[2 * kh + ks], sbf[ks][x], oacc[x]); }
#pragma unroll
            for (int x = 0; x < 4; ++x)
#pragma unroll
                for (int jj = 0; jj < 4; ++jj) oacc[x][jj] *= pw[16 * ti + 4 * q4 + jj + 1];
            WG_SYNC();
            { bf16x8 pa[2], vb[2][4];
#pragma unroll
              for (int ks = 0; ks < 2; ++ks) { pa[ks] = frag_row(L + RT_PS, RT_LDP, 16 * ti, 32 * ks, lane);
#pragma unroll
                  for (int x = 0; x < 4; ++x) vb[ks][x] = frag_tr(L + RT_VS, RT_LDQ, 32 * ks, 16 * (te0 + x), lane); }
              __builtin_amdgcn_sched_barrier(0);
#pragma unroll
              for (int ks = 0; ks < 2; ++ks)
#pragma unroll
                  for (int x = 0; x < 4; ++x) oacc[x] = mma16(pa[ks], vb[ks][x], oacc[x]); }
#pragma unroll
            for (int x = 0; x < 4; ++x)
#pragma unroll
                for (int jj = 0; jj < 4; ++jj) *(LAS float*)(L + RT_OS + (16 * ti + 4 * q4 + jj) * RT_LDO + (16 * (te0 + x) + r16) * 4) = oacc[x][jj];
        }
#pragma unroll
        for (int td = 0; td < 8; ++td) st[td] = st[td] * c64;
#pragma unroll
        for (int ks = 0; ks < 2; ++ks) { bf16x8 kd[8]; const bf16x8 va = frag_tr(L + RT_VS, RT_LDQ, 32 * ks, 16 * w, lane);
#pragma unroll
          for (int td = 0; td < 8; ++td) kd[td] = frag_tr(L + RT_KD, RT_LDQ, 32 * ks, 16 * td, lane);
          __builtin_amdgcn_sched_barrier(0);
#pragma unroll
          for (int td = 0; td < 8; ++td) st[td] = mma16(va, kd[td], st[td]); }
        WG_SYNC();
        if (MAIN) {
#pragma unroll
            for (int td = 0; td < 8; ++td)
#pragma unroll
                for (int jj = 0; jj < 4; ++jj) *(LAS bf16*)(L + RT_SB + (16 * w + 4 * q4 + jj) * RT_LDQ + (16 * td + r16) * 2) = (bf16)f2bf(st[td][jj]);
            const int i = lrow, e0 = 16 * lseg;
            f32x4 ov[4]; float s = 0.f;
#pragma unroll
            for (int j = 0; j < 4; ++j) { ov[j] = *(const LAS f32x4*)(L + RT_OS + i * RT_LDO + (e0 + 4 * j) * 4); s += (ov[j][0] + ov[j][1]) + (ov[j][2] + ov[j][3]); }
            s = sum8(s);
            const float mu = s * (1.f / 128.f); float q = 0.f;
#pragma unroll
            for (int j = 0; j < 4; ++j) { ov[j] = ov[j] - mu; q += (ov[j][0] * ov[j][0] + ov[j][1] * ov[j][1]) + (ov[j][2] * ov[j][2] + ov[j][3] * ov[j][3]); }
            q = sum8(q);
            const float rstd = 1.0f / sqrtf(q * (1.f / 128.f) + EPS);
            const u32x4 g0 = gz0, g1 = gz1;
            float y[16];
#pragma unroll
            for (int j = 0; j < 4; ++j) { const f32x4 gg = gnv[j];
#pragma unroll
                for (int k = 0; k < 4; ++k) { const int idx = 4 * j + k; const unsigned gw = (idx < 8) ? g0[idx >> 1] : g1[(idx - 8) >> 1]; const float gv = bf2f((idx & 1) ? (gw >> 16) : (gw & 0xffffu));
                    y[idx] = silu_f(gv) * (ov[j][k] * rstd * gg[k]); } }
            u32x4 o0, o1;
#pragma unroll
            for (int j = 0; j < 4; ++j) { o0[j] = pk2(y[2 * j], y[2 * j + 1]); o1[j] = pk2(y[8 + 2 * j], y[8 + 2 * j + 1]); }
            bf16* yp = (bf16*)(ws + WS_Y) + (size_t)(t0 + i) * D + 128 * h + e0;
            *(u32x4*)yp = o0; *(u32x4*)(yp + 8) = o1;
        }
    };
    for (int cc = 0; cc < 8; cc += 2) { one_chunk(bufA, cc); one_chunk(bufB, cc + 1); }
#undef RT_LOAD
    if (!MAIN) { f32x4* lp = (f32x4*)(ws + WS_RETL) + (size_t)unit * 4096;
#pragma unroll
        for (int td = 0; td < 8; ++td) lp[(w * 8 + td) * 64 + lane] = st[td]; }
    WG_SYNC();
}
__device__ __forceinline__ void ret_scan(Frame& F, unsigned char* ws) {
    const float* Lb = (const float*)(ws + WS_RETL); float* Sb = (float*)(ws + WS_RETS);
    const int gt = F.vcu * NTHR + F.tid, NGT = F.G * NTHR;
    for (int idx = gt; idx < 8 * 16384; idx += NGT) { const int bh = idx >> 14, el = idx & 16383, h = bh & 3;
        const double g = 1.0 - 1.0 / (double)(32 << h); double p = g; for (int j = 0; j < 9; ++j) p *= p;
        const float c8 = (float)p; float run = 0.f;
        float lv[32];
#pragma unroll
        for (int s = 0; s < 32; ++s) lv[s] = Lb[((size_t)(bh * 32 + s) << 14) + el];
#pragma unroll
        for (int s = 0; s < 32; ++s) { Sb[((size_t)(bh * 32 + s) << 14) + el] = run; run = c8 * run + lv[s]; } }
}

__device__ __forceinline__ void unpack8(const u32x4 r, float (&v)[8]) {
#pragma unroll
    for (int j = 0; j < 4; ++j) { v[2 * j] = bf2f(r[j] & 0xffffu); v[2 * j + 1] = bf2f(r[j] >> 16); } }
__device__ __forceinline__ u32x4 pack8(const float (&v)[8]) { u32x4 o; o.x = pk2(v[0], v[1]); o.y = pk2(v[2], v[3]); o.z = pk2(v[4], v[5]); o.w = pk2(v[6], v[7]); return o; }
__device__ __forceinline__ void conv_unit(Frame& F, const PT& a, unsigned char* ws, int unit) {
    const int b = unit >> 7, s0 = (unit & 127) * 128, ch = F.tid, tid = F.tid;
    const bf16* Z = (const bf16*)(ws + WS_Z); bf16* Y = (bf16*)(ws + WS_Y);
    LAS float* cv = (LAS float*)F.lds;
    LAS bf16* ct = (LAS bf16*)(F.lds + 65536);
    const float* p_dw = a.in(I_E_DW_W); const float* p_lg = a.in(I_E_CV_LN_G); const float* p_lb = a.in(I_E_CV_LN_B);
    float wk[31];
#pragma unroll
    for (int k = 0; k < 31; ++k) wk[k] = p_dw[k * 512 + ch];
    const float bias = a.in(I_E_DW_B)[ch];
    const int ltok = tid >> 4, lseg = tid & 15;
    u32x4 ra[4], rb[4];
#define CV_LOAD(sfirst) do { const int _s = (sfirst) + ltok; const bf16* _zr = Z + (size_t)(b * SEQ + (_s >= 0 ? _s : 0)) * EVEN_IN + 2048 + 32 * lseg; \
        _Pragma("unroll") for (int j = 0; j < 4; ++j) { ra[j] = *(const u32x4*)(_zr + 8 * j); rb[j] = *(const u32x4*)(_zr + 512 + 8 * j); } } while (0)
#define CV_GLU_TO_LDS() do { _Pragma("unroll") for (int j = 0; j < 4; ++j) { float av[8], bv[8]; unpack8(ra[j], av); unpack8(rb[j], bv); \
        _Pragma("unroll") for (int k = 0; k < 8; ++k) av[k] = av[k] * fast_sigmoid(bv[k]); \
        *(LAS u32x4*)(ct + ltok * 512 + 32 * lseg + 8 * j) = pack8(av); } } while (0)
    float c[62];
    const f32x4 g0 = *(const f32x4*)(p_lg + 8 * F.lane), g1 = *(const f32x4*)(p_lg + 8 * F.lane + 4);
    const f32x4 b0 = *(const f32x4*)(p_lb + 8 * F.lane), b1 = *(const f32x4*)(p_lb + 8 * F.lane + 4);
    CV_LOAD(s0 - 32);
    if (s0 - 32 + ltok < 0) {
#pragma unroll
        for (int j = 0; j < 4; ++j) ra[j] = (u32x4){0u, 0u, 0u, 0u}; }
    CV_GLU_TO_LDS();
    CV_LOAD(s0);
    WG_SYNC();
#pragma unroll
    for (int j = 0; j < 30; ++j) c[j] = bf2f(ct[(j + 2) * 512 + ch]);
    WG_SYNC();
    for (int p = 0; p < 4; ++p) {
        CV_GLU_TO_LDS();
        CV_LOAD(s0 + 32 * (p < 3 ? p + 1 : p));
        WG_SYNC();
#pragma unroll
        for (int j = 0; j < 32; ++j) c[30 + j] = bf2f(ct[j * 512 + ch]);
        float o[32];
#pragma unroll
        for (int i = 0; i < 32; ++i) { float acc = bias;
#pragma unroll
            for (int k = 0; k < 31; ++k) acc = __builtin_fmaf(wk[k], c[i + k], acc);
            o[i] = acc; }
#pragma unroll
        for (int i = 0; i < 32; ++i) cv[i * 512 + ch] = o[i];
#pragma unroll
        for (int j = 0; j < 30; ++j) c[j] = c[j + 32];
        WG_SYNC();
#pragma unroll
        for (int x = 0; x < 4; ++x) { const int i = 4 * F.wave + x; const LAS f32x4* r = (const LAS f32x4*)(cv + i * 512 + 8 * F.lane);
            f32x4 v0 = r[0], v1 = r[1]; float s = (v0[0] + v0[1]) + (v0[2] + v0[3]) + (v1[0] + v1[1]) + (v1[2] + v1[3]);
            const float mu = wave_sum(s) * (1.f / 512.f); v0 = v0 - mu; v1 = v1 - mu;
            float q = (v0[0] * v0[0] + v0[1] * v0[1]) + (v0[2] * v0[2] + v0[3] * v0[3]) + (v1[0] * v1[0] + v1[1] * v1[1]) + (v1[2] * v1[2] + v1[3] * v1[3]);
            const float rstd = 1.0f / sqrtf(wave_sum(q) * (1.f / 512.f) + EPS);
            float y[8];
#pragma unroll
            for (int k = 0; k < 4; ++k) { y[k] = silu_f(v0[k] * rstd * g0[k] + b0[k]); y[4 + k] = silu_f(v1[k] * rstd * g1[k] + b1[k]); }
            *(u32x4*)(Y + (size_t)(b * SEQ + s0 + 32 * p + i) * D + 512 + 8 * F.lane) = pack8(y); }
        WG_SYNC();
    }
#undef CV_LOAD
#undef CV_GLU_TO_LDS
}

constexpr int M1_VS = 0, M1_WS = 34816, M1_ST = 69632, M1_SP = 70656, M1_LD = 272, M1_LDS = 132;
__device__ __forceinline__ void mixer1_unit(Frame& F, const PT& a, unsigned char* ws, int unit) {
    const int t0 = unit * 128, s0 = (unit & 127) * 128;
    const int tid = F.tid, lane = F.lane, w = F.wave;
    const bf16* Z = (const bf16*)(ws + WS_Z); bf16* Y = (bf16*)(ws + WS_Y);
    LAS unsigned char* L = F.lds; LAS f32x2* stt = (LAS f32x2*)(L + M1_ST); LAS float* SP = (LAS float*)(L + M1_SP);
    const float* p_lng = a.in(I_O_SG_LN_G); const float* p_lnb = a.in(I_O_SG_LN_B); const float* p_sgb = a.in(I_O_SG_B); const float* p_scw = a.in(I_O_SC_W);
    LAS float* GL = (LAS float*)(L + 139264);
    { GL[tid] = p_lng[tid]; GL[512 + tid] = p_lnb[tid]; GL[1024 + tid] = p_sgb[tid]; }
#pragma unroll
    for (int b8 = 0; b8 < 2; ++b8) { u32x4 raw[8];
#pragma unroll
        for (int x = 0; x < 8; ++x) raw[x] = *(const u32x4*)(Z + (size_t)(t0 + 16 * w + 8 * b8 + x) * ODD_IN + 512 + 8 * lane);
#pragma unroll
        for (int x = 0; x < 8; ++x) { float v[8]; unpack8(raw[x], v); float s = 0.f;
#pragma unroll
            for (int j = 0; j < 8; ++j) { v[j] = gelu_tanh(v[j]); s += v[j]; }
            const float mu = wave_sum(s) * (1.f / 512.f); float q = 0.f;
#pragma unroll
            for (int j = 0; j < 8; ++j) { const float d = v[j] - mu; q += d * d; }
            const float rstd = 1.0f / sqrtf(wave_sum(q) * (1.f / 512.f) + EPS);
            if (lane == 0) stt[16 * w + 8 * b8 + x] = (f32x2){mu, rstd}; } }
    WG_SYNC();
    const int q4 = lane >> 4, r16 = lane & 15;
    const int tk = tid >> 2, part = tid & 3;
    u32x4 raw[4], wr4[4], uraw[4];
#define M1_LOAD_FILL(g_) do { const bf16* _zr = Z + (size_t)(t0 + tk) * ODD_IN + 512 + 128 * (g_) + 32 * part; const bf16* _ws = (const bf16*)(ws + WS_SGW) + (size_t)((g_) * 128 + tk) * 128 + 32 * part; \
        _Pragma("unroll") for (int j = 0; j < 4; ++j) { raw[j] = *(const u32x4*)(_zr + 8 * j); wr4[j] = *(const u32x4*)(_ws + 8 * j); } } while (0)
    M1_LOAD_FILL(0);
#pragma unroll
    for (int g = 0; g < 4; ++g) {
        { const bf16* zu = Z + (size_t)(t0 + tk) * ODD_IN + 128 * g + 32 * part;
#pragma unroll
          for (int j = 0; j < 4; ++j) uraw[j] = *(const u32x4*)(zu + 8 * j); }
        { f32x4 lg[8], lb[8];
#pragma unroll
          for (int j = 0; j < 8; ++j) { lg[j] = *(const LAS f32x4*)(GL + 128 * g + 32 * part + 4 * j); lb[j] = *(const LAS f32x4*)(GL + 512 + 128 * g + 32 * part + 4 * j); }
          const f32x2 ms = stt[tk];
#pragma unroll
          for (int j = 0; j < 4; ++j) { float v[8]; unpack8(raw[j], v);
#pragma unroll
              for (int k = 0; k < 8; ++k) v[k] = (gelu_tanh(v[k]) - ms[0]) * ms[1] * lg[2 * j + (k >> 2)][k & 3] + lb[2 * j + (k >> 2)][k & 3];
              *(LAS u32x4*)(L + M1_VS + tk * M1_LD + (32 * part + 8 * j) * 2) = pack8(v);
              *(LAS u32x4*)(L + M1_WS + tk * M1_LD + (32 * part + 8 * j) * 2) = wr4[j]; } }
        if (g < 3) M1_LOAD_FILL(g + 1);
        WG_SYNC();
        { f32x4 acc[8];
#pragma unroll
          for (int ct = 0; ct < 8; ++ct) acc[ct] = (f32x4){0.f, 0.f, 0.f, 0.f};
#pragma unroll
          for (int ks = 0; ks < 4; ++ks) { const bf16x8 af = frag_row(L + M1_WS, M1_LD, 16 * w, 32 * ks, lane);
#pragma unroll
              for (int ct = 0; ct < 8; ++ct) acc[ct] = mma16(af, frag_tr(L + M1_VS, M1_LD, 32 * ks, 16 * ct, lane), acc[ct]); }
#pragma unroll
          for (int jj = 0; jj < 4; ++jj) { const int p = 16 * w + 4 * q4 + jj; const float sb = GL[1024 + g * 128 + p];
#pragma unroll
              for (int ct = 0; ct < 8; ++ct) SP[p * M1_LDS + 16 * ct + r16] = acc[ct][jj] + sb; } }
        WG_SYNC();
        { bf16* yo = Y + (size_t)(t0 + tk) * D + 128 * g + 32 * part;
#pragma unroll
          for (int j = 0; j < 4; ++j) { float v[8]; unpack8(uraw[j], v); const f32x4 s0v = *(const LAS f32x4*)(SP + tk * M1_LDS + 32 * part + 8 * j), s1v = *(const LAS f32x4*)(SP + tk * M1_LDS + 32 * part + 8 * j + 4);
#pragma unroll
              for (int k = 0; k < 4; ++k) { v[k] = gelu_tanh(v[k]) * s0v[k]; v[4 + k] = gelu_tanh(v[4 + k]) * s1v[k]; }
              *(u32x4*)(yo + 8 * j) = pack8(v); } }
    }
#undef M1_LOAD_FILL
    { const int ch0 = 8 * lane; float w0[8], w1[8], w2[8];
#pragma unroll
      for (int j = 0; j < 2; ++j) { const f32x4 a0 = *(const f32x4*)(p_scw + ch0 + 4 * j), a1 = *(const f32x4*)(p_scw + 512 + ch0 + 4 * j), a2 = *(const f32x4*)(p_scw + 1024 + ch0 + 4 * j);
#pragma unroll
          for (int k = 0; k < 4; ++k) { w0[4 * j + k] = a0[k]; w1[4 * j + k] = a1[k]; w2[4 * j + k] = a2[k]; } }
#pragma unroll
      for (int b8 = 0; b8 < 2; ++b8) { const int tb = 16 * w + 8 * b8;
          u32x4 cg[10], hv[10], bg[8];
#pragma unroll
          for (int x = 0; x < 10; ++x) { const int tt = tb - 2 + x; const bool ok = (s0 + tt) >= 0; const bf16* zr = Z + (size_t)(t0 + (ok ? tt : 0)) * ODD_IN + ch0;
              cg[x] = *(const u32x4*)(zr + 1536); hv[x] = *(const u32x4*)(zr + 2048); }
#pragma unroll
          for (int x = 0; x < 8; ++x) bg[x] = *(const u32x4*)(Z + (size_t)(t0 + tb + x) * ODD_IN + 1024 + ch0);
          __builtin_amdgcn_sched_barrier(0);
#pragma unroll
          for (int x = 0; x < 2; ++x) { if ((s0 + tb - 2 + x) < 0) cg[x] = (u32x4){0u, 0u, 0u, 0u}; }
          float pr[10][8];
#pragma unroll
          for (int x = 0; x < 10; ++x) { float c8[8], h8[8]; unpack8(cg[x], c8); unpack8(hv[x], h8);
#pragma unroll
              for (int k = 0; k < 8; ++k) pr[x][k] = c8[k] * h8[k]; }
#pragma unroll
          for (int x = 0; x < 8; ++x) { float b8v[8], y[8]; unpack8(bg[x], b8v);
#pragma unroll
              for (int k = 0; k < 8; ++k) y[k] = b8v[k] * (w0[k] * pr[x][k] + w1[k] * pr[x + 1][k] + w2[k] * pr[x + 2][k]);
              *(u32x4*)(Y + (size_t)(t0 + tb + x) * D + 512 + ch0) = pack8(y); } }
    }
    WG_SYNC();
}

__device__ __forceinline__ void route_phase(Frame& F, const PT& a, unsigned char* ws, const float* hres) {
    LAS float* rt = (LAS float*)F.lds;
    LAS int* lcnt = (LAS int*)(F.lds + 32768); LAS int* lbase = lcnt + 8;
    LAS int* te = (LAS int*)(F.lds + 33024); LAS int* tr = te + 256; LAS float* tg = (LAS float*)(tr + 256);
    unsigned* gcnt = (unsigned*)(ws + WS_CTL) + CW_CNT;
    int* row_tok = (int*)(ws + WS_ROWTOK); u32x2* tokinfo = (u32x2*)(ws + WS_TOKINFO);
    const float* p_rt = a.in(I_O_ROUTER); const float* p_ng = a.in(I_O_NORM_FFN);
    for (int i = F.tid; i < 8192; i += NTHR) { const int d = i >> 3, e = i & 7; rt[e * 1024 + d] = p_rt[i]; }
    if (F.tid < 8) lcnt[F.tid] = 0;
    __syncthreads();
    f32x4 gnr[4];
    { const f32x4* gr0 = (const f32x4*)p_ng + F.lane;
#pragma unroll
      for (int j = 0; j < 4; ++j) gnr[j] = gr0[64 * j]; }
    for (int base = F.vcu * 128; base < T; base += F.G * 128) {
        u32x2 va[4], ma[4], vb[4], mb[4];
        { const u32x2* xr = (const u32x2*)(hres + (size_t)(base + 16 * F.wave) * D) + F.lane;
#pragma unroll
          for (int j = 0; j < 4; ++j) { va[j] = xr[64 * j]; ma[j] = xr[256 + 64 * j]; vb[j] = xr[512 + 64 * j]; mb[j] = xr[768 + 64 * j]; } }
        auto one_token = [&](u32x2 (&vn)[4], u32x2 (&mn)[4], const int x) __attribute__((always_inline)) { const int tl = 16 * F.wave + x, t = base + tl;
            f32x4 v[4]; float s = 0.f;
#pragma unroll
            for (int j = 0; j < 4; ++j) { v[j][0] = bf2f(vn[j][0] & 0xffffu) + bf2f(mn[j][0] & 0xffffu); v[j][1] = bf2f(vn[j][0] >> 16) + bf2f(mn[j][0] >> 16);
                                          v[j][2] = bf2f(vn[j][1] & 0xffffu) + bf2f(mn[j][1] & 0xffffu); v[j][3] = bf2f(vn[j][1] >> 16) + bf2f(mn[j][1] >> 16); }
            { const u32x2* xr = (const u32x2*)(hres + (size_t)(t + (x < 14 ? 2 : 0)) * D) + F.lane;
#pragma unroll
              for (int j = 0; j < 4; ++j) { vn[j] = xr[64 * j]; mn[j] = xr[256 + 64 * j]; } }
#pragma unroll
            for (int j = 0; j < 4; ++j) s += (v[j][0] * v[j][0] + v[j][1] * v[j][1]) + (v[j][2] * v[j][2] + v[j][3] * v[j][3]);
            const float r = __builtin_amdgcn_rsqf(wave_sum(s) * (1.f / D) + EPS);
            unsigned* o4 = (unsigned*)(ws + WS_XN8 + (size_t)t * D) + F.lane;
            float lg[8];
#pragma unroll
            for (int e = 0; e < 8; ++e) lg[e] = 0.f;
#pragma unroll
            for (int j = 0; j < 4; ++j) { const f32x4 g = gnr[j]; f32x4 xn; xn[0] = v[j][0] * r * g[0]; xn[1] = v[j][1] * r * g[1]; xn[2] = v[j][2] * r * g[2]; xn[3] = v[j][3] * r * g[3];
                o4[64 * j] = pk4_fp8(xn[0], xn[1], xn[2], xn[3]);
#pragma unroll
                for (int e = 0; e < 8; ++e) { const f32x4 rw = *(const LAS f32x4*)(rt + e * 1024 + 256 * j + 4 * F.lane); lg[e] += (xn[0] * rw[0] + xn[1] * rw[1]) + (xn[2] * rw[2] + xn[3] * rw[3]); } }
#pragma unroll
            for (int e = 0; e < 8; ++e) lg[e] = wave_sum(lg[e]);
            int e1 = 0; float m1 = lg[0];
#pragma unroll
            for (int e = 1; e < 8; ++e) if (lg[e] > m1) { m1 = lg[e]; e1 = e; }
            int e2 = -1; float m2 = 0.f;
#pragma unroll
            for (int e = 0; e < 8; ++e) if (e != e1 && (e2 < 0 || lg[e] > m2)) { m2 = lg[e]; e2 = e; }
            const float p2 = __expf(m2 - m1), g1 = __builtin_amdgcn_rcpf(1.0f + p2), g2 = p2 * g1;
            if (F.lane == 0) { te[2 * tl] = e1; te[2 * tl + 1] = e2; tg[2 * tl] = g1; tg[2 * tl + 1] = g2;
                tr[2 * tl] = __hip_atomic_fetch_add(lcnt + e1, 1, __ATOMIC_RELAXED, __HIP_MEMORY_SCOPE_WORKGROUP); tr[2 * tl + 1] = __hip_atomic_fetch_add(lcnt + e2, 1, __ATOMIC_RELAXED, __HIP_MEMORY_SCOPE_WORKGROUP); } };
        for (int x = 0; x < 16; x += 2) { one_token(va, ma, x); one_token(vb, mb, x + 1); }
        __syncthreads();
        if (F.tid < 8) { lbase[F.tid] = (int)__hip_atomic_fetch_add(gcnt + 64 * F.tid, (unsigned)lcnt[F.tid], RLX_AGENT); }
        __syncthreads();
        if (F.tid < 256) { const int e = te[F.tid], idx = lbase[e] + tr[F.tid], t = base + (F.tid >> 1);
            row_tok[e * 32768 + idx] = t;
            tokinfo[(size_t)t * 2 + (F.tid & 1)] = (u32x2){((unsigned)e << 24) | (unsigned)idx, __float_as_uint(tg[F.tid])}; }
        __syncthreads();
        if (F.tid < 8) lcnt[F.tid] = 0;
        __syncthreads();
    }
}
__device__ __forceinline__ void combine_phase(Frame& F, const PT& a, unsigned char* ws, const LAS int* bstart, float* out) {
    const int gw = F.vcu * NWAVES + F.wave, NGW = F.G * NWAVES;
    const u32x2* tokinfo = (const u32x2*)(ws + WS_TOKINFO); const bf16* YM = (const bf16*)(ws + WS_YMOE); const bf16* SL = (const bf16*)(ws + WS_SLAB); const float* p_fn = a.in(I_FINAL_NORM);
    const f32x4* gr = (const f32x4*)p_fn + F.lane; f32x4 gn[4];
#pragma unroll
    for (int j = 0; j < 4; ++j) gn[j] = gr[64 * j];
    for (int tb = gw; tb < T; tb += 16 * NGW) {
        u32x2 inf0 = {0u, 0u}, inf1 = {0u, 0u};
        { const int tl = tb + (F.lane & 15) * NGW; if (tl < T) { inf0 = tokinfo[(size_t)tl * 2]; inf1 = tokinfo[(size_t)tl * 2 + 1]; } }
        u32x2 hn[4], mn[4], y0n[4], y1n[4]; size_t p0n = 0, p1n = 0;
#define CMB_ISSUE(k) do { const int _t = tb + (k) * NGW; const unsigned _a0 = __builtin_amdgcn_readlane(inf0[0], (k)), _a1 = __builtin_amdgcn_readlane(inf1[0], (k)); \
        p0n = (size_t)bstart[_a0 >> 24] * 256 + (_a0 & 0xffffffu); p1n = (size_t)bstart[_a1 >> 24] * 256 + (_a1 & 0xffffffu); \
        const u32x2* _xr = (const u32x2*)(out + (size_t)_t * D) + F.lane; \
        const u32x2* _y0 = (const u32x2*)(YM + (p0n < 65536 ? p0n : 0) * D) + F.lane; const u32x2* _y1 = (const u32x2*)(YM + (p1n < 65536 ? p1n : 0) * D) + F.lane; \
        _Pragma("unroll") for (int j = 0; j < 4; ++j) { hn[j] = _xr[64 * j]; mn[j] = _xr[256 + 64 * j]; y0n[j] = _y0[64 * j]; y1n[j] = _y1[64 * j]; } } while (0)
        CMB_ISSUE(0);
#pragma unroll
        for (int k = 0; k < 16; ++k) { const int t = tb + k * NGW; if (t >= T) break;
            f32x4 v[4]; u32x2 ya[4], yb[4]; const size_t p0 = p0n, p1 = p1n;
#pragma unroll
            for (int j = 0; j < 4; ++j) { v[j][0] = bf2f(hn[j][0] & 0xffffu) + bf2f(mn[j][0] & 0xffffu); v[j][1] = bf2f(hn[j][0] >> 16) + bf2f(mn[j][0] >> 16);
                                          v[j][2] = bf2f(hn[j][1] & 0xffffu) + bf2f(mn[j][1] & 0xffffu); v[j][3] = bf2f(hn[j][1] >> 16) + bf2f(mn[j][1] >> 16); ya[j] = y0n[j]; yb[j] = y1n[j]; }
            const float g0 = __uint_as_float(__builtin_amdgcn_readlane(inf0[1], k)), g1 = __uint_as_float(__builtin_amdgcn_readlane(inf1[1], k));
            if (k < 15 && t + NGW < T) CMB_ISSUE(k + 1);
#pragma unroll
            for (int kk = 0; kk < 2; ++kk) { const size_t p = kk ? p1 : p0; const float g = kk ? g1 : g0;
                if (p < (size_t)65536) {
#pragma unroll
                    for (int j = 0; j < 4; ++j) { const u32x2 a0 = kk ? yb[j] : ya[j]; v[j][0] += g * bf2f(a0[0] & 0xffffu); v[j][1] += g * bf2f(a0[0] >> 16); v[j][2] += g * bf2f(a0[1] & 0xffffu); v[j][3] += g * bf2f(a0[1] >> 16); } }
                else { f32x4 acc[4];
#pragma unroll
                    for (int j = 0; j < 4; ++j) acc[j] = (f32x4){0.f, 0.f, 0.f, 0.f};
                    for (int ks = 0; ks < 7; ++ks) { const u32x2* y = (const u32x2*)(SL + ((size_t)ks * 2048 + (p - 65536)) * D) + F.lane;
#pragma unroll
                        for (int j = 0; j < 4; ++j) { const u32x2 a0 = y[64 * j]; acc[j][0] += bf2f(a0[0] & 0xffffu); acc[j][1] += bf2f(a0[0] >> 16); acc[j][2] += bf2f(a0[1] & 0xffffu); acc[j][3] += bf2f(a0[1] >> 16); } }
#pragma unroll
                    for (int j = 0; j < 4; ++j) v[j] = v[j] + acc[j] * g; } }
            float s = 0.f;
#pragma unroll
            for (int j = 0; j < 4; ++j) s += (v[j][0] * v[j][0] + v[j][1] * v[j][1]) + (v[j][2] * v[j][2] + v[j][3] * v[j][3]);
            const float r = 1.0f / sqrtf(wave_sum(s) * (1.f / D) + EPS);
            f32x4* xr = (f32x4*)(out + (size_t)t * D) + F.lane;
#pragma unroll
            for (int j = 0; j < 4; ++j) { f32x4 o; o[0] = v[j][0] * r * gn[j][0]; o[1] = v[j][1] * r * gn[j][1]; o[2] = v[j][2] * r * gn[j][2]; o[3] = v[j][3] * r * gn[j][3]; xr[64 * j] = o; }
        }
#undef CMB_ISSUE
    }
}

__global__ void __launch_bounds__(NTHR, 2) mega_fwd(Args args) {
    extern __shared__ __attribute__((aligned(16))) unsigned char lds[];
    Frame F;
    F.lds = (LAS unsigned char*)lds;
    volatile LAS unsigned* MISC = (volatile LAS unsigned*)(F.lds + MISC_OFF);
    F.tid = threadIdx.x; F.lane = F.tid & 63; F.wave = __builtin_amdgcn_readfirstlane(F.tid >> 6);
    F.G = gridDim.x; { const int bx = blockIdx.x; F.vcu = (F.G % 8 == 0) ? (bx % 8) * (F.G / 8) + bx / 8 : bx; }
    for (int u = F.tid; u < 256; u += NTHR) MISC[u] = 0u;
    __syncthreads();
    if (F.tid == 0) {
#pragma unroll
        for (int i = 0; i < 29; ++i) { const unsigned long long v = (i < 27) ? (unsigned long long)args.in[i < 27 ? i : 0] : (i == 27 ? (unsigned long long)args.out : (unsigned long long)args.ws);
            MISC[128 + 2 * i] = (unsigned)v; MISC[128 + 2 * i + 1] = (unsigned)(v >> 32); } }
    __syncthreads();
    const PT pt{MISC + 128};
    unsigned char* const ws = (unsigned char*)pt.p(28);
    unsigned* ctl = (unsigned*)(ws + WS_CTL);
    XcdBarrier bar = xcd_barrier_post(ctl + CW_BAR, MISC + 8);
#define GRID_BAR() xcd_barrier(bar)
    const int bx = (int)blockIdx.x;
    float* const hres = (float*)pt.p(27);
    bf16* const HM = (bf16*)hres;
    bf16* const XN = (bf16*)(ws + WS_XN);
    LAS unsigned char* const ring = F.lds;
    const LAS unsigned short* const rowoff = (const LAS unsigned short*)(F.lds + ROWOFF_OFF);

    RopeJob rj; rope_init(rj, F);
    refresh(F); convert_weights(F, pt, ws, 0, CV_TOTAL, rj);
    refresh(F); misc_tables(F, pt, ws, rj);
    refresh(F); norm_phase(F, pt.in(I_X), pt.in(I_E_NORM_MIX), XN);
    GRID_BAR();
    { pg8::PlainSched S; S.o.init(T / 256, EVEN_IN / 256, F.G, bx); S.Abase = (const char*)XN; S.Bbase = (const char*)(ws + WS_W_EIN); S.tstep = 256u * D * 2u; S.tstepA = 0u;
      pg8::EpiZ0 E{(bf16*)(ws + WS_Z), (const float*)(ws + WS_ROPE), (const float*)(ws + WS_ROPE) + (size_t)SEQ * 64};
      pg8::gemm_phase<pg8::EpiZ0, pg8::PlainSched, false, true, true>(ring, rowoff, D, S, E); }
    GRID_BAR();
    for (int u = F.vcu; u < 256; u += F.G) { refresh(F); ret_unit<false>(F, pt, ws, u); refresh(F); conv_unit(F, pt, ws, u); }
    GRID_BAR();
    refresh(F); ret_scan(F, ws);
    GRID_BAR();
    for (int u = F.vcu; u < 256; u += F.G) { refresh(F); ret_unit<true>(F, pt, ws, u); }
    GRID_BAR();
    { pg8::PlainSched S; S.o.init(T / 256, D / 256, F.G, bx); S.Abase = (const char*)(ws + WS_Y); S.Bbase = (const char*)(ws + WS_W_EOUT); S.tstep = 256u * D * 2u; S.tstepA = 0u;
      pg8::EpiResB<0> E{pt.in(I_X), nullptr, 0, XN, D, (float*)(ws + WS_SSP), (LAS float*)(F.lds + ROWOFF_OFF)};
      pg8::gemm_phase<pg8::EpiResB<0>, pg8::PlainSched, false, true, true>(ring, rowoff, D, S, E); }
    GRID_BAR();
    { pg8::PlainSched S; S.o.init(T / 256, 2 * DFF / 256, F.G, bx); S.Abase = (const char*)XN; S.Bbase = (const char*)(ws + WS_W_FGU); S.tstep = 256u * D * 2u; S.tstepA = 0u;
      pg8::EpiSwiGLU E{(bf16*)(ws + WS_HFFN), DFF, (const float*)(ws + WS_SSP)};
      pg8::gemm_phase<pg8::EpiSwiGLU, pg8::PlainSched, false, true, true>(ring, rowoff, D, S, E); }
    GRID_BAR();
    { pg8::PlainSched S; S.o.init(T / 256, D / 256, F.G, bx); S.Abase = (const char*)(ws + WS_HFFN); S.Bbase = (const char*)(ws + WS_W_FDN); S.tstep = 256u * DFF * 2u; S.tstepA = 0u;
      pg8::EpiResB<1> E{nullptr, XN, D, HM, 2 * D, (float*)(ws + WS_SSP), (LAS float*)(F.lds + ROWOFF_OFF)};
      pg8::gemm_phase<pg8::EpiResB<1>, pg8::PlainSched, false, true, true>(ring, rowoff, DFF, S, E); }
    GRID_BAR();
    { pg8::PlainSched S; S.o.init(T / 256, ODD_IN / 256, F.G, bx); S.Abase = (const char*)HM; S.Bbase = (const char*)(ws + WS_W_OIN); S.tstep = 256u * D * 2u; S.tstepA = 256u * D * 4u;
      pg8::EpiBf16 E{(bf16*)(ws + WS_Z), ODD_IN, (const float*)(ws + WS_SSP)};
      pg8::gemm_phase<pg8::EpiBf16, pg8::PlainSched, false, true, true>(ring, rowoff, D, S, E, 0, D * 4); }
    GRID_BAR();
    for (int u = F.vcu; u < 256; u += F.G) { refresh(F); mixer1_unit(F, pt, ws, u); }
    GRID_BAR();
    { pg8::PlainSched S; S.o.init(T / 256, D / 256, F.G, bx); S.Abase = (const char*)(ws + WS_Y); S.Bbase = (const char*)(ws + WS_W_OOUT); S.tstep = 256u * D * 2u; S.tstepA = 0u;
      pg8::EpiBf16S E{HM + D, 2 * D, 1.0f};
      pg8::gemm_phase<pg8::EpiBf16S, pg8::PlainSched, false, true, true>(ring, rowoff, D, S, E); }
    GRID_BAR();
    refresh(F); route_phase(F, pt, ws, hres);
    GRID_BAR();
    LAS int* mcnt = (LAS int*)(F.lds + MISC_OFF + 64 * 4); LAS int* mbst = mcnt + 8;
    refresh(F);
    if (F.tid < 8) mcnt[F.tid] = (int)__hip_atomic_load(ctl + CW_CNT + 64 * F.tid, RLX_AGENT);
    __syncthreads();
    if (F.tid == 0) { int run = 0;
        for (int e = 0; e < 8; ++e) { mbst[e] = run; run += (mcnt[e] + 255) >> 8; }
        mbst[8] = run; }
    __syncthreads();
    const int RB = mbst[8];
    const LAS unsigned short* const rowtok = (const LAS unsigned short*)(F.lds + ROWOFF_OFF);
    { pg8::MoeGuSched S; S.o.init(RB, 2 * DEXP / 256, F.G, bx); S.rb0 = 0; S.bstart = mbst; S.Abase = (const char*)(ws + WS_XN8); S.Bbase = (const char*)(ws + WS_WGU8);
      { refresh(F); LAS unsigned short* rt16 = (LAS unsigned short*)(F.lds + ROWOFF_OFF); const int* row_tok = (const int*)(ws + WS_ROWTOK);
        int tokv[32];
#pragma unroll
        for (int ui = 0; ui < 32; ++ui) { pg8::Unit u; u.pm = 0; u.pn = 0; u.orow = 0; u.ao = 0u; u.bo = 0u; const bool ok = S.next(ui, u);
            const int e = pg8::expert_of(mbst, u.pm), j = u.pm - mbst[e], idx = 256 * j + (F.tid & 255); const bool live = ok && idx < mcnt[e];
            const int ld = row_tok[e * 32768 + (live ? idx : 0)]; tokv[ui] = live ? ld : 0; }
        if (F.tid < 256) {
#pragma unroll
            for (int ui = 0; ui < 32; ++ui) rt16[ui * 256 + F.tid] = (unsigned short)tokv[ui]; }
        __syncthreads(); }
      pg8::EpiSwiGLU8 E{ws + WS_HMOE8, DEXP};
      pg8::gemm_phase<pg8::EpiSwiGLU8, pg8::MoeGuSched, true, true, true, true>(ring, rowtok, D, S, E); }
    GRID_BAR();
    { pg8::MoeDnSched S; S.o.init(RB < 256 ? RB : 256, D / 256, F.G, bx); S.rb0 = 0; S.bstart = mbst; S.Abase = (const char*)(ws + WS_HMOE8); S.Bbase = (const char*)(ws + WS_WDN8);
      pg8::EpiBf16S E{(bf16*)(ws + WS_YMOE), D, W8_INV};
      pg8::gemm_phase<pg8::EpiBf16S, pg8::MoeDnSched, false, true, true, true>(ring, rowtok, DEXP, S, E); }
    if (RB > 256) {
      pg8::MoeDnSplitSched S; S.n = (RB - 256) * 28; S.G = F.G; S.c = bx; S.bstart = mbst; S.Abase = (const char*)(ws + WS_HMOE8); S.Bbase = (const char*)(ws + WS_WDN8);
      pg8::EpiBf16S E{(bf16*)(ws + WS_SLAB), D, W8_INV};
      pg8::gemm_phase<pg8::EpiBf16S, pg8::MoeDnSplitSched, false, true, true, true>(ring, rowtok, DEXP, S, E, 4); }
    GRID_BAR();
    refresh(F); combine_phase(F, pt, ws, mbst, hres);
}

extern "C" void kernel_launch(void* const* d_in, const int* in_sizes, int n_in, void* d_out, int out_size, void* d_ws, size_t ws_size, hipStream_t stream) {
    static int grid = 0;
    if (grid == 0) {
        if (n_in != 27 || in_sizes[0] != T * D || out_size != T * D || ws_size < WS_END) { fprintf(stderr, "kernel_launch: unexpected shapes (n_in %d, in0 %d, out %d, ws %zu); nothing launched\n", n_in, n_in > 0 ? in_sizes[0] : -1, out_size, ws_size); grid = -1; return; }
        int dev = 0, cus = 0, per_cu = 0;
        if (hipGetDevice(&dev) != hipSuccess || hipDeviceGetAttribute(&cus, hipDeviceAttributeMultiprocessorCount, dev) != hipSuccess) { grid = -1; return; }
        if (hipFuncSetAttribute((const void*)mega_fwd, hipFuncAttributeMaxDynamicSharedMemorySize, LDS_BYTES) != hipSuccess) { fprintf(stderr, "kernel_launch: hipFuncSetAttribute failed\n"); grid = -1; return; }
        if (hipOccupancyMaxActiveBlocksPerMultiprocessor(&per_cu, (const void*)mega_fwd, NTHR, LDS_BYTES) != hipSuccess || per_cu < 1) fprintf(stderr, "kernel_launch: occupancy query reports %d\n", per_cu);
        (void)hipGetLastError();
        if (cus != 256) { fprintf(stderr, "kernel_launch: built for a 256-CU device (unit lists of at most 32 units per workgroup and phase); found %d CUs; nothing launched\n", cus); grid = -1; return; }
        grid = cus;
    }
    if (grid < 0) return;
    if (hipMemsetAsync((char*)d_ws + WS_CTL, 0, CTL_ZERO_BYTES, stream) != hipSuccess) return;
    Args a{};
    for (int i = 0; i < 27; ++i) a.in[i] = (const float*)d_in[i];
    a.out = (float*)d_out; a.ws = (unsigned char*)d_ws;
    hipLaunchKernelGGL(mega_fwd, dim3(grid), dim3(NTHR), LDS_BYTES, stream, a);
}
```

```cpp
#include <hip/hip_runtime.h>
#include <cstdio>

#define GAS __attribute__((address_space(1)))
#define LAS __attribute__((address_space(3)))
typedef unsigned short bf16;
typedef short bf16x8 __attribute__((ext_vector_type(8)));
typedef short s16x4 __attribute__((ext_vector_type(4)));
typedef float f32x4 __attribute__((ext_vector_type(4)));
typedef float f32x2 __attribute__((ext_vector_type(2)));
typedef unsigned u32x4 __attribute__((ext_vector_type(4)));
typedef unsigned u32x2 __attribute__((ext_vector_type(2)));
typedef int i32x4 __attribute__((ext_vector_type(4)));
typedef int i32x8 __attribute__((ext_vector_type(8)));

constexpr int BATCH = 2, SEQ = 16384, T = BATCH * SEQ, D = 1024;
constexpr int EVEN_IN = 3072, ODD_IN = 2560, DFF = 2816, NEXP = 8, DEXP = 3584;
constexpr float EPS = 1e-6f;
constexpr int NWAVES = 8, NTHR = 512;

constexpr size_t MiB = 1u << 20;
constexpr size_t WS_CTL = 0, CTL_ZERO_BYTES = 64 * 1024;
constexpr size_t WS_ROWTOK = 1 * MiB;
constexpr size_t WS_TOKINFO = 2 * MiB;
constexpr size_t WS_SSP = 2 * MiB + 512 * 1024;
constexpr size_t WS_WGU8 = 3 * MiB;
constexpr size_t WS_WDN8 = 59 * MiB;
constexpr size_t WS_XN = 87 * MiB;
constexpr size_t WS_Y = 151 * MiB;
constexpr size_t WS_YMOE = 87 * MiB;
constexpr size_t WS_Z = 219 * MiB;
constexpr size_t WS_HFFN = 219 * MiB;
constexpr size_t WS_HMOE8 = 219 * MiB;
constexpr size_t WS_RETL = 411 * MiB;
constexpr size_t WS_RETS = 427 * MiB;
constexpr size_t WS_W_EIN = 443 * MiB;
constexpr size_t WS_W_EOUT = 449 * MiB;
constexpr size_t WS_W_FGU = 451 * MiB;
constexpr size_t WS_W_FDN = 462 * MiB;
constexpr size_t WS_W_OIN = 468 * MiB;
constexpr size_t WS_W_OOUT = 473 * MiB;
constexpr size_t WS_ROPE = 475 * MiB;
constexpr size_t WS_SGW = 483 * MiB;
constexpr size_t WS_XN8 = 450 * MiB;
constexpr size_t WS_SLAB = 482 * MiB;
constexpr size_t WS_END = 510 * MiB;
constexpr size_t EXP_GU_BYTES = (size_t)2 * DEXP * D, EXP_DN_BYTES = (size_t)D * DEXP;
constexpr float W8_SCALE = 64.0f, W8_INV = 1.0f / 64.0f;
constexpr int CW_BAR = 4096, CW_CNT = 8192;

constexpr int LDS_BYTES = 159744;
constexpr int ROWOFF_OFF = 131072;
constexpr int MISC_OFF = LDS_BYTES - 1024;

#define RLX_AGENT __ATOMIC_RELAXED, __HIP_MEMORY_SCOPE_AGENT
#define LDS_WAIT() asm volatile("s_waitcnt lgkmcnt(0)" ::: "memory")
#define VM_WAIT() asm volatile("s_waitcnt vmcnt(0)" ::: "memory")
#define WG_SYNC() do { asm volatile("s_waitcnt lgkmcnt(0)" ::: "memory"); __builtin_amdgcn_s_barrier(); asm volatile("" ::: "memory"); } while (0)

__device__ __forceinline__ float bf2f(unsigned b) { return __uint_as_float(b << 16); }
typedef __bf16 bf16x2_t __attribute__((ext_vector_type(2)));
__device__ __forceinline__ unsigned pk2(float lo, float hi) { const bf16x2_t v = __builtin_convertvector((f32x2){lo, hi}, bf16x2_t); return __builtin_bit_cast(unsigned, v); }
__device__ __forceinline__ unsigned f2bf(float f) { return pk2(f, 0.f) & 0xffffu; }
__device__ __forceinline__ unsigned pk4_fp8(float a, float b, float c, float d) { int r = __builtin_amdgcn_cvt_pk_fp8_f32(a, b, 0, false); r = __builtin_amdgcn_cvt_pk_fp8_f32(c, d, r, true); return (unsigned)r; }
__device__ __forceinline__ float clamp8(float x) { return __builtin_fminf(__builtin_fmaxf(x, -448.0f), 448.0f); }
template <int CTRL, int RMASK> __device__ __forceinline__ float dpp_take(float v) {
    return __builtin_bit_cast(float, __builtin_amdgcn_update_dpp(0, __builtin_bit_cast(int, v), CTRL, RMASK, 0xf, true)); }
__device__ __forceinline__ float wave_sum(float v) {
    v += dpp_take<0x111, 0xf>(v); v += dpp_take<0x112, 0xf>(v); v += dpp_take<0x114, 0xf>(v); v += dpp_take<0x118, 0xf>(v);
    v += dpp_take<0x142, 0xa>(v); v += dpp_take<0x143, 0xc>(v);
    return __builtin_bit_cast(float, __builtin_amdgcn_readlane(__builtin_bit_cast(int, v), 63));
}
template <int CTRL> __device__ __forceinline__ float dpp_all(float v) { return __builtin_bit_cast(float, __builtin_amdgcn_update_dpp(0, __builtin_bit_cast(int, v), CTRL, 0xf, 0xf, false)); }
__device__ __forceinline__ float sum8(float v) { v += dpp_all<0xB1>(v); v += dpp_all<0x4E>(v); v += dpp_all<0x141>(v); return v; }
__device__ __forceinline__ float fast_sigmoid(float x) { return __builtin_amdgcn_rcpf(1.0f + __builtin_amdgcn_exp2f(-1.4426950408889634f * x)); }
__device__ __forceinline__ float silu_f(float x) { return x * fast_sigmoid(x); }
__device__ __forceinline__ f32x2 swiglu2(f32x2 g, f32x2 u) {
    f32x2 e; e.x = __builtin_amdgcn_exp2f(g.x); e.y = __builtin_amdgcn_exp2f(g.y);
    const f32x2 d = e + 1.0f; f32x2 r; r.x = __builtin_amdgcn_rcpf(d.x); r.y = __builtin_amdgcn_rcpf(d.y);
    return (g * u) * r; }
__device__ __forceinline__ float gelu_tanh(float x) {
    const float u = 0.7978845608028654f * (x + 0.044715f * x * x * x);
    return x * fast_sigmoid(2.0f * u);
}

namespace pg8 {
constexpr int BM = 256, BK = 64, HALF = 128, HTB = HALF * BK * 2, STAGE_BYTES = 8 * HTB, NXCD = 8, WGM = 8;
__device__ __forceinline__ int lds_byte(int r, int c) { const int st = (r >> 4) * 2 + (c >> 5), rr = r & 15, cc = c & 31, ob = rr * 64 + cc * 2; return st * 1024 + (ob ^ (((ob >> 9) & 1) << 5)); }
__device__ __forceinline__ void stage_rc(int b, int& R, int& C) { const int st = b / 1024, sb = b % 1024, swz = sb ^ (((sb >> 9) & 1) << 5); R = (st >> 1) * 16 + swz / 64; C = (st & 1) * 32 + (swz % 64) / 2; }
__device__ __forceinline__ int perm32(int rho) { const int n = rho >> 4, i = rho & 15; return 8 * (i >> 2) + 4 * n + (i & 3); }

struct Unit { int pm, pn, orow; unsigned ao, bo; };
struct TileOrder {
    int nM, nN, nwg, G, c, dense;
    __device__ __forceinline__ void init(int nM_, int nN_, int G_, int c_, int dense_ = 0) { nM = nM_; nN = nN_; nwg = nM * nN; G = G_; c = c_; dense = dense_; }
    __device__ __forceinline__ bool next(int i, int& pm, int& pn) const {
        const long L = (long)i * G + c; if (L >= nwg) return false;
        int wgid = (int)L; { const int q = nwg / NXCD, r = nwg % NXCD, xcd = wgid % NXCD, off = wgid / NXCD; wgid = (xcd < r ? xcd * (q + 1) : r * (q + 1) + (xcd - r) * q) + off; }
        if (dense && nM == 16 * NXCD && (nN & 1) == 0) {
            const int q = nwg / NXCD, x = wgid / q, p = wgid - x * q, nfull = nN >> 2;
            if (p < nfull * 64) { const int rr = p >> 5, slot = p & 31; pm = x * 16 + (rr & 1) * 8 + (slot & 7); pn = (rr >> 1) * 4 + (slot >> 3); }
            else { const int p2 = p - nfull * 64; pm = x * 16 + (p2 & 15); pn = nfull * 4 + (p2 >> 4); }
            return true; }
        const int nig = WGM * nN, gid = wgid / nig, fm = gid * WGM, gsz = (nM - fm) < WGM ? (nM - fm) : WGM;
        pm = fm + ((wgid % nig) % gsz); pn = (wgid % nig) / gsz; return true;
    }
};
struct PlainSched {
    TileOrder o; const char* Abase; const char* Bbase; unsigned tstep, tstepA;
    __device__ __forceinline__ bool next(int i, Unit& u) const { int pm, pn; if (!o.next(i, pm, pn)) return false; u.pm = pm; u.pn = pn; u.orow = pm; u.ao = (unsigned)pm * (tstepA ? tstepA : tstep); u.bo = (unsigned)pn * tstep; return true; }
};
__device__ __forceinline__ int expert_of(const LAS int* bstart, int rb) { int e = 0;
#pragma unroll
    for (int j = 1; j < 8; ++j) e += (rb >= bstart[j]) ? 1 : 0;
    return e; }
struct MoeGuSched {
    TileOrder o; int rb0; const LAS int* bstart; const char* Abase; const char* Bbase;
    __device__ __forceinline__ bool next(int i, Unit& u) const { int pm, pn; if (!o.next(i, pm, pn)) return false; const int rb = rb0 + pm, e = expert_of(bstart, rb);
        u.pm = rb; u.pn = pn; u.orow = rb; u.ao = 0u; u.bo = (unsigned)e * (unsigned)EXP_GU_BYTES + (unsigned)pn * (unsigned)(256 * D); return true; }
};
struct MoeDnSched {
    TileOrder o; int rb0; const LAS int* bstart; const char* Abase; const char* Bbase;
    __device__ __forceinline__ bool next(int i, Unit& u) const { int pm, pn; if (!o.next(i, pm, pn)) return false; const int rb = rb0 + pm, e = expert_of(bstart, rb);
        u.pm = rb; u.pn = pn; u.orow = rb; u.ao = (unsigned)rb * (unsigned)(256 * DEXP); u.bo = (unsigned)e * (unsigned)EXP_DN_BYTES + (unsigned)pn * (unsigned)(256 * DEXP); return true; }
};
struct MoeDnSplitSched {
    int n, G, c; const LAS int* bstart; const char* Abase; const char* Bbase;
    __device__ __forceinline__ bool next(int i, Unit& u) const { const int L = i * G + c; if (L >= n) return false; const int ks = L % 7, t = L / 7, pn = t & 3, pm = t >> 2, rb = 256 + pm, e = expert_of(bstart, rb);
        u.pm = rb; u.pn = pn; u.orow = ks * 8 + pm; u.ao = (unsigned)rb * (unsigned)(256 * DEXP) + ks * 512u; u.bo = (unsigned)e * (unsigned)EXP_DN_BYTES + (unsigned)pn * (unsigned)(256 * DEXP) + ks * 512u; return true; }
};

__device__ __forceinline__ float row_rstd(const float* ssp, int row) { const f32x4 p = *(const f32x4*)(ssp + (size_t)row * 4); return 1.0f / sqrtf(((p[0] + p[1]) + (p[2] + p[3])) * (1.0f / D) + EPS); }
__device__ __forceinline__ void row_rstd8(const float* ssp, int row0, float (&rs)[2][4]) {
    f32x4 p[2][4];
#pragma unroll
    for (int ai = 0; ai < 2; ++ai)
#pragma unroll
        for (int m = 0; m < 4; ++m) p[ai][m] = *(const f32x4*)(ssp + (size_t)(row0 + ai * 128 + m * 16) * 4);
#pragma unroll
    for (int ai = 0; ai < 2; ++ai)
#pragma unroll
        for (int m = 0; m < 4; ++m) rs[ai][m] = 1.0f / sqrtf(((p[ai][m][0] + p[ai][m][1]) + (p[ai][m][2] + p[ai][m][3])) * (1.0f / D) + EPS);
}
struct StoreMap { int src4, srow, sgrp; };
__device__ __forceinline__ StoreMap store_map(int fr, int fq) { StoreMap sm; sm.src4 = ((((fr & 3) << 4) | (fq << 2) | (fr >> 2)) << 2); sm.srow = (fq << 2) | (fr >> 2); sm.sgrp = fr & 3; return sm; }
__device__ __forceinline__ u32x4 perm_q(const StoreMap& sm, u32x4 w) { u32x4 r;
    r.x = (unsigned)__builtin_amdgcn_ds_bpermute(sm.src4, (int)w.x); r.y = (unsigned)__builtin_amdgcn_ds_bpermute(sm.src4, (int)w.y);
    r.z = (unsigned)__builtin_amdgcn_ds_bpermute(sm.src4, (int)w.z); r.w = (unsigned)__builtin_amdgcn_ds_bpermute(sm.src4, (int)w.w); return r; }
__device__ __forceinline__ u32x2 perm_q(const StoreMap& sm, u32x2 w) { u32x2 r;
    r.x = (unsigned)__builtin_amdgcn_ds_bpermute(sm.src4, (int)w.x); r.y = (unsigned)__builtin_amdgcn_ds_bpermute(sm.src4, (int)w.y); return r; }
struct EpiBf16 {
    static constexpr bool PERM = true;
    bf16* O; int ldc; const float* ssp;
    __device__ __forceinline__ void operator()(const f32x4 (&acc)[2][2][4][2], const Unit& u, int wr, int wc, int fr, int fq) const {
        const int row0 = u.orow * BM + wr * 64 + fr; const StoreMap sm = store_map(fr, fq);
        bf16* const Os = O + (size_t)(u.orow * BM + wr * 64 + sm.srow) * ldc + u.pn * BM + wc * 32 + 8 * sm.sgrp;
        float rsv[2][4]; row_rstd8(ssp, row0, rsv);
#pragma unroll
        for (int ai = 0; ai < 2; ++ai)
#pragma unroll
            for (int m = 0; m < 4; ++m) { bf16* rowp = Os + (size_t)(ai * HALF + m * 16) * ldc;
                const float rs = rsv[ai][m];
#pragma unroll
                for (int bj = 0; bj < 2; ++bj) { const f32x4 v0 = acc[ai][bj][m][0] * rs, v1 = acc[ai][bj][m][1] * rs;
                    u32x4 w; w.x = pk2(v0[0], v0[1]); w.y = pk2(v0[2], v0[3]); w.z = pk2(v1[0], v1[1]); w.w = pk2(v1[2], v1[3]);
                    *(u32x4*)(rowp + bj * HALF) = perm_q(sm, w); } }
    }
};
struct EpiZ0 {
    static constexpr bool PERM = true;
    bf16* O; const float* ropeC; const float* ropeS;
    __device__ __forceinline__ void operator()(const f32x4 (&acc)[2][2][4][2], const Unit& u, int wr, int wc, int fr, int fq) const {
        const int row0 = u.orow * BM + wr * 64 + fr, col0 = u.pn * BM + wc * 32 + 8 * fq;
        const bool rot = u.pn < 4; const float qs = (u.pn < 2) ? 0.08838834764831845f : 1.0f;
        const int i0 = 16 * wc + 4 * fq; const StoreMap sm = store_map(fr, fq);
        bf16* const Os = O + (size_t)(u.orow * BM + wr * 64 + sm.srow) * EVEN_IN + u.pn * BM + wc * 32 + 8 * sm.sgrp;
        f32x4 csv[2][4], snv[2][4];
        if (rot) {
#pragma unroll
            for (int ai = 0; ai < 2; ++ai)
#pragma unroll
                for (int m = 0; m < 4; ++m) { const int pos = (row0 + ai * HALF + m * 16) & (SEQ - 1); csv[ai][m] = *(const f32x4*)(ropeC + (size_t)pos * 64 + i0); snv[ai][m] = *(const f32x4*)(ropeS + (size_t)pos * 64 + i0); } }
#pragma unroll
        for (int ai = 0; ai < 2; ++ai)
#pragma unroll
            for (int m = 0; m < 4; ++m) { bf16* rowp = Os + (size_t)(ai * HALF + m * 16) * EVEN_IN;
                f32x4 cs = {1.f, 1.f, 1.f, 1.f}, sn = {0.f, 0.f, 0.f, 0.f};
                if (rot) { cs = csv[ai][m]; sn = snv[ai][m]; }
#pragma unroll
                for (int bj = 0; bj < 2; ++bj) { f32x4 v0 = acc[ai][bj][m][0], v1 = acc[ai][bj][m][1];
                    if (rot) { f32x4 r0, r1;
                        r0[0] = (v0[0] * cs[0] - v0[1] * sn[0]) * qs; r0[1] = (v0[1] * cs[0] + v0[0] * sn[0]) * qs;
                        r0[2] = (v0[2] * cs[1] - v0[3] * sn[1]) * qs; r0[3] = (v0[3] * cs[1] + v0[2] * sn[1]) * qs;
                        r1[0] = (v1[0] * cs[2] - v1[1] * sn[2]) * qs; r1[1] = (v1[1] * cs[2] + v1[0] * sn[2]) * qs;
                        r1[2] = (v1[2] * cs[3] - v1[3] * sn[3]) * qs; r1[3] = (v1[3] * cs[3] + v1[2] * sn[3]) * qs;
                        v0 = r0; v1 = r1; }
                    u32x4 w; w.x = pk2(v0[0], v0[1]); w.y = pk2(v0[2], v0[3]); w.z = pk2(v1[0], v1[1]); w.w = pk2(v1[2], v1[3]);
                    *(u32x4*)(rowp + bj * HALF) = perm_q(sm, w); } }
    }
};
struct EpiSwiGLU {
    static constexpr bool PERM = true;
    bf16* O; int ldc; const float* ssp;
    __device__ __forceinline__ void operator()(const f32x4 (&acc)[2][2][4][2], const Unit& u, int wr, int wc, int fr, int fq) const {
        const int row0 = u.orow * BM + wr * 64 + fr; const StoreMap sm = store_map(fr, fq);
        bf16* const Os = O + (size_t)(u.orow * BM + wr * 64 + sm.srow) * ldc + u.pn * HALF + wc * 32 + 8 * sm.sgrp;
        float rsv[2][4]; row_rstd8(ssp, row0, rsv);
        u32x4 pprev = {0u, 0u, 0u, 0u}; bf16* rprev = Os;
#pragma unroll
        for (int ai = 0; ai < 2; ++ai)
#pragma unroll
            for (int m = 0; m < 4; ++m) { bf16* rowp = Os + (size_t)(ai * HALF + m * 16) * ldc;
                const float rs = rsv[ai][m];
                const f32x4 g0 = acc[ai][0][m][0] * rs, g1 = acc[ai][0][m][1] * rs, u0 = acc[ai][1][m][0] * rs, u1 = acc[ai][1][m][1] * rs;
                const f32x2 y0 = swiglu2((f32x2){g0[0], g0[1]}, (f32x2){u0[0], u0[1]}), y1 = swiglu2((f32x2){g0[2], g0[3]}, (f32x2){u0[2], u0[3]});
                const f32x2 y2 = swiglu2((f32x2){g1[0], g1[1]}, (f32x2){u1[0], u1[1]}), y3 = swiglu2((f32x2){g1[2], g1[3]}, (f32x2){u1[2], u1[3]});
                u32x4 w; w.x = pk2(y0.x, y0.y); w.y = pk2(y1.x, y1.y); w.z = pk2(y2.x, y2.y); w.w = pk2(y3.x, y3.y);
                const u32x4 pw = perm_q(sm, w);
                if (ai + m > 0) *(u32x4*)rprev = pprev;
                pprev = pw; rprev = rowp; }
        *(u32x4*)rprev = pprev;
    }
};
struct EpiSwiGLU8 {
    static constexpr bool PERM = true;
    unsigned char* O; int ldc;
    __device__ __forceinline__ void operator()(const f32x4 (&acc)[2][2][4][2], const Unit& u, int wr, int wc, int fr, int fq) const {
        const StoreMap sm = store_map(fr, fq);
        unsigned char* const Os = O + (size_t)(u.orow * BM + wr * 64 + sm.srow) * ldc + u.pn * HALF + wc * 32 + 8 * sm.sgrp;
        u32x2 pprev = {0u, 0u}; unsigned char* rprev = Os;
#pragma unroll
        for (int ai = 0; ai < 2; ++ai)
#pragma unroll
            for (int m = 0; m < 4; ++m) { unsigned char* rowp = Os + (size_t)(ai * HALF + m * 16) * ldc;
                const f32x4 g0 = acc[ai][0][m][0], g1 = acc[ai][0][m][1], u0 = acc[ai][1][m][0], u1 = acc[ai][1][m][1];
                const f32x2 y0 = swiglu2((f32x2){g0[0], g0[1]}, (f32x2){u0[0], u0[1]}), y1 = swiglu2((f32x2){g0[2], g0[3]}, (f32x2){u0[2], u0[3]});
                const f32x2 y2 = swiglu2((f32x2){g1[0], g1[1]}, (f32x2){u1[0], u1[1]}), y3 = swiglu2((f32x2){g1[2], g1[3]}, (f32x2){u1[2], u1[3]});
                u32x2 w; w.x = pk4_fp8(y0.x, y0.y, y1.x, y1.y); w.y = pk4_fp8(y2.x, y2.y, y3.x, y3.y);
                const u32x2 pw = perm_q(sm, w);
                if (ai + m > 0) *(u32x2*)rprev = pprev;
                pprev = pw; rprev = rowp; }
        *(u32x2*)rprev = pprev;
    }
};
struct EpiBf16S {
    static constexpr bool PERM = true;
    bf16* O; int ldc; float scale;
    __device__ __forceinline__ void operator()(const f32x4 (&acc)[2][2][4][2], const Unit& u, int wr, int wc, int fr, int fq) const {
        const StoreMap sm = store_map(fr, fq);
        bf16* const Os = O + (size_t)(u.orow * BM + wr * 64 + sm.srow) * ldc + u.pn * BM + wc * 32 + 8 * sm.sgrp;
#pragma unroll
        for (int ai = 0; ai < 2; ++ai)
#pragma unroll
            for (int m = 0; m < 4; ++m) { bf16* rowp = Os + (size_t)(ai * HALF + m * 16) * ldc;
#pragma unroll
                for (int bj = 0; bj < 2; ++bj) { const f32x4 v0 = acc[ai][bj][m][0] * scale, v1 = acc[ai][bj][m][1] * scale;
                    u32x4 w; w.x = pk2(v0[0], v0[1]); w.y = pk2(v0[2], v0[3]); w.z = pk2(v1[0], v1[1]); w.w = pk2(v1[2], v1[3]);
                    *(u32x4*)(rowp + bj * HALF) = perm_q(sm, w); } }
    }
};
struct EpiRes {
    static constexpr bool PERM = false;
    const float* base; float* out;
    __device__ __forceinline__ void operator()(const f32x4 (&acc)[2][2][4][2], const Unit& u, int wr, int wc, int fr, int fq) const {
        const int row0 = u.orow * BM + wr * 64 + fr, col0 = u.pn * BM + wc * 32 + 4 * fq;
#pragma unroll
        for (int ai = 0; ai < 2; ++ai)
#pragma unroll
            for (int m = 0; m < 4; ++m) { const size_t off = (size_t)(row0 + ai * HALF + m * 16) * D + col0;
#pragma unroll
                for (int bj = 0; bj < 2; ++bj)
#pragma unroll
                    for (int n = 0; n < 2; ++n) { const f32x4 bs = *(const f32x4*)(base + off + bj * HALF + n * 16); *(f32x4*)(out + off + bj * HALF + n * 16) = bs + acc[ai][bj][m][n]; } }
    }
};
template <int MODE> struct EpiResB {
    static constexpr bool PERM = true;
    const float* base; const bf16* xi; int ldi; bf16* xo; int ldo; float* ssp; LAS float* P;
    __device__ __forceinline__ void load_half(int ai, int row0, int col0, f32x4 (&xf)[4][2][2], u32x4 (&xb)[4][2]) const {
#pragma unroll
        for (int m = 0; m < 4; ++m) { const int row = row0 + ai * HALF + m * 16;
#pragma unroll
            for (int bj = 0; bj < 2; ++bj) {
                if (MODE == 0) { const float* p = base + (size_t)row * D + col0 + bj * HALF; xf[m][bj][0] = *(const f32x4*)p; xf[m][bj][1] = *(const f32x4*)(p + 4); }
                else xb[m][bj] = *(const u32x4*)(xi + (size_t)row * ldi + col0 + bj * HALF); } }
    }
    __device__ __forceinline__ void make_half(const f32x4 (&acc)[2][2][4][2], int ai, const f32x4 (&xf)[4][2][2], const u32x4 (&xb)[4][2], u32x4 (&w)[4][2], float (&sq)[4]) const {
#pragma unroll
        for (int m = 0; m < 4; ++m) { float q = 0.f;
#pragma unroll
            for (int bj = 0; bj < 2; ++bj) { f32x4 h0, h1;
                if (MODE == 0) { h0 = xf[m][bj][0]; h1 = xf[m][bj][1]; }
                else { const u32x4 b = xb[m][bj]; h0 = (f32x4){bf2f(b.x & 0xffffu), bf2f(b.x >> 16), bf2f(b.y & 0xffffu), bf2f(b.y >> 16)}; h1 = (f32x4){bf2f(b.z & 0xffffu), bf2f(b.z >> 16), bf2f(b.w & 0xffffu), bf2f(b.w >> 16)}; }
                h0 = h0 + acc[ai][bj][m][0]; h1 = h1 + acc[ai][bj][m][1];
                u32x4 v; v.x = pk2(h0[0], h0[1]); v.y = pk2(h0[2], h0[3]); v.z = pk2(h1[0], h1[1]); v.w = pk2(h1[2], h1[3]); w[m][bj] = v;
                const float r0 = bf2f(v.x & 0xffffu), r1 = bf2f(v.x >> 16), r2 = bf2f(v.y & 0xffffu), r3 = bf2f(v.y >> 16), r4 = bf2f(v.z & 0xffffu), r5 = bf2f(v.z >> 16), r6 = bf2f(v.w & 0xffffu), r7 = bf2f(v.w >> 16);
                q += ((r0 * r0 + r1 * r1) + (r2 * r2 + r3 * r3)) + ((r4 * r4 + r5 * r5) + (r6 * r6 + r7 * r7)); }
            q += __shfl_xor(q, 16); q += __shfl_xor(q, 32); sq[m] = q; }
    }
    __device__ __forceinline__ void store_half(int ai, int row0, int col0, int wr, int wc, int fr, int fq, const u32x4 (&w)[4][2], const float (&sq)[4]) const {
        const StoreMap sm = store_map(fr, fq); const int srow0 = row0 - fr + sm.srow, scol0 = col0 - 8 * fq + 8 * sm.sgrp;
#pragma unroll
        for (int m = 0; m < 4; ++m) { const int row = srow0 + ai * HALF + m * 16;
#pragma unroll
            for (int bj = 0; bj < 2; ++bj) *(u32x4*)(xo + (size_t)row * ldo + scol0 + bj * HALF) = perm_q(sm, w[m][bj]);
            if (fq == 0) P[(ai * HALF + wr * 64 + m * 16 + fr) * 4 + wc] = sq[m]; }
    }
    __device__ __forceinline__ void operator()(const f32x4 (&acc)[2][2][4][2], const Unit& u, int wr, int wc, int fr, int fq) const {
        const int row0 = u.orow * BM + wr * 64 + fr, col0 = u.pn * BM + wc * 32 + 8 * fq;
        f32x4 xf[4][2][2]; u32x4 xb0[4][2], xb1[4][2], w[4][2]; float sq[4];
        if (MODE == 1) { load_half(0, row0, col0, xf, xb0); load_half(1, row0, col0, xf, xb1);
            make_half(acc, 0, xf, xb0, w, sq); store_half(0, row0, col0, wr, wc, fr, fq, w, sq);
            make_half(acc, 1, xf, xb1, w, sq); store_half(1, row0, col0, wr, wc, fr, fq, w, sq); }
        else { u32x4 w1[4][2]; float sq1[4];
            load_half(0, row0, col0, xf, xb0); make_half(acc, 0, xf, xb0, w, sq);
            load_half(1, row0, col0, xf, xb0); store_half(0, row0, col0, wr, wc, fr, fq, w, sq);
            make_half(acc, 1, xf, xb0, w1, sq1); store_half(1, row0, col0, wr, wc, fr, fq, w1, sq1); }
        asm volatile("s_waitcnt lgkmcnt(0)" ::: "memory"); __builtin_amdgcn_s_barrier(); asm volatile("" ::: "memory");
        if (wr == 0) { const int r = wc * 64 + fq * 16 + fr; const f32x4 p = *(const LAS f32x4*)(P + r * 4); ssp[(size_t)(u.orow * BM + r) * 4 + u.pn] = (p[0] + p[1]) + (p[2] + p[3]); }
    }
};

template <class Epi, class Sched, bool GATHER, bool ALIGN_EPI, bool SP2, bool FP8 = false>
__device__ __forceinline__ void gemm_phase(LAS unsigned char* lds, const LAS unsigned short* rowtok, const int K, const Sched& S, const Epi& E, const int nt_unit = 0, const int lda = 0) {
    int tid = threadIdx.x; asm volatile("" : "+v"(tid));
    const int wid = __builtin_amdgcn_readfirstlane(tid >> 6), lane = tid & 63, wr = wid >> 2, wc = wid & 3, fr = lane & 15, fq = lane >> 4;
    const int KB = FP8 ? K : 2 * K;
    const int nt = nt_unit ? nt_unit : KB / (BK * 2);
    unsigned voffA[2], voffB[2]; int gR[2], gC[2];
#pragma unroll
    for (int i = 0; i < 2; ++i) { int R, C; stage_rc(tid * 16 + i * 8192, R, C); const int Rb = Epi::PERM ? ((R & ~31) + perm32(R & 31)) : R;
        voffA[i] = (unsigned)(R * (lda ? lda : KB) + C * 2); voffB[i] = (unsigned)(Rb * KB + C * 2); gR[i] = R; gC[i] = C * 2; }
    const unsigned kstep = (unsigned)(BK * 2);
    const unsigned hstep = (unsigned)(HALF * KB), hstepA = (unsigned)(HALF * (lda ? lda : KB));
    const __amdgpu_buffer_rsrc_t rA = __builtin_amdgcn_make_buffer_rsrc((void*)S.Abase, 0, 0xFFFFFFF0u, 0x00020000), rB = __builtin_amdgcn_make_buffer_rsrc((void*)S.Bbase, 0, 0xFFFFFFF0u, 0x00020000);
    const unsigned ldsw = (unsigned)wid * 1024u;
    const int aoff = lds_byte(wr * 64 + fr, fq * 8), boff = lds_byte(wc * 32 + fr, fq * 8);
    unsigned gcur[2][2], gnxt[2][2];
#define PG8_SA(b, h) (((b) * 2 + (h)) * HTB)
#define PG8_SB(b, h) ((4 + (b) * 2 + (h)) * HTB)
#define PG8_STAGE(bufoff, soff, voff) do { _Pragma("unroll") for (int _i = 0; _i < 2; ++_i) \
        __builtin_amdgcn_raw_ptr_buffer_load_lds(rB, (LAS void*)(lds + (bufoff) + ldsw + _i * 8192), 16, (voff)[_i], (soff), 0, 0); } while (0)
#define PG8_STAGE_A(bufoff, soff, h, GV) do { _Pragma("unroll") for (int _i = 0; _i < 2; ++_i) { \
        if constexpr (GATHER) __builtin_amdgcn_raw_ptr_buffer_load_lds(rA, (LAS void*)(lds + (bufoff) + ldsw + _i * 8192), 16, (GV)[h][_i], (soff), 0, 0); \
        else __builtin_amdgcn_raw_ptr_buffer_load_lds(rA, (LAS void*)(lds + (bufoff) + ldsw + _i * 8192), 16, voffA[_i], (soff) + (h) * hstepA, 0, 0); } } while (0)
#define PG8_LDA(dst, b, h) do { _Pragma("unroll") for (int m = 0; m < 4; ++m) { if constexpr (FP8) { const LAS unsigned char* _p = lds + PG8_SA(b, h) + aoff + m * 2048; \
            dst##8[m] = __builtin_shufflevector(*(const LAS i32x4*)_p, *(const LAS i32x4*)(_p + 1024), 0, 1, 2, 3, 4, 5, 6, 7); } \
        else { _Pragma("unroll") for (int k = 0; k < 2; ++k) dst[m][k] = *(const LAS bf16x8*)(lds + PG8_SA(b, h) + aoff + m * 2048 + k * 1024); } } } while (0)
#define PG8_LDB(dst, b, h) do { _Pragma("unroll") for (int n = 0; n < 2; ++n) { if constexpr (FP8) { const LAS unsigned char* _p = lds + PG8_SB(b, h) + boff + n * 2048; \
            dst##8[n] = __builtin_shufflevector(*(const LAS i32x4*)_p, *(const LAS i32x4*)(_p + 1024), 0, 1, 2, 3, 4, 5, 6, 7); } \
        else { _Pragma("unroll") for (int k = 0; k < 2; ++k) dst[n][k] = *(const LAS bf16x8*)(lds + PG8_SB(b, h) + boff + n * 2048 + k * 1024); } } } while (0)
#define PG8_MMA(ai, bj, At, Bt) do { __builtin_amdgcn_s_setprio(1); _Pragma("unroll") for (int m = 0; m < 4; ++m) _Pragma("unroll") for (int n = 0; n < 2; ++n) { \
        if constexpr (FP8) { asm volatile("v_mfma_scale_f32_16x16x128_f8f6f4 %0, %1, %2, %0, %3, %4 op_sel_hi:[0,0,0]" : "+v"(acc[ai][bj][m][n]) : "v"(Bt##8[n]), "v"(At##8[m]), "v"(scw), "v"(sc1)); } \
        else { _Pragma("unroll") for (int k = 0; k < 2; ++k) acc[ai][bj][m][n] = __builtin_amdgcn_mfma_f32_16x16x32_bf16(Bt[n][k], At[m][k], acc[ai][bj][m][n], 0, 0, 0); } } \
        __builtin_amdgcn_s_setprio(0); } while (0)
#define PG8_WAIT_V(n) asm volatile("s_waitcnt vmcnt(" #n ")" ::: "memory")
#define PG8_WAIT_L(n) asm volatile("s_waitcnt lgkmcnt(" #n ")" ::: "memory")
#define PG8_BAR __builtin_amdgcn_s_barrier()
#define PG8_SCHED __builtin_amdgcn_sched_barrier(0)
#define PG8_GLOAD(G, ord) do { if constexpr (GATHER) { _Pragma("unroll") for (int _h = 0; _h < 2; ++_h) _Pragma("unroll") for (int _i = 0; _i < 2; ++_i) \
        G[_h][_i] = (unsigned)rowtok[(ord) * 256 + _h * HALF + gR[_i]] * (unsigned)KB + (unsigned)gC[_i]; } } while (0)
    LAS int* const ucache = (LAS int*)(lds + 147456);
    if (tid < 32) { Unit u; u.pm = 0; u.pn = 0; u.orow = 0; u.ao = 0u; u.bo = 0u; const bool ok = S.next(tid, u);
        *(LAS i32x4*)(ucache + 8 * tid) = (i32x4){ok ? 1 : 0, u.pm, u.pn, u.orow}; *(LAS i32x4*)(ucache + 8 * tid + 4) = (i32x4){(int)u.ao, (int)u.bo, 0, 0}; }
    asm volatile("s_waitcnt lgkmcnt(0)" ::: "memory"); __builtin_amdgcn_s_barrier(); asm volatile("" ::: "memory");
#define PG8_NEXT(k, U) ([&]() -> bool { if ((k) >= 32) return false; const i32x4 _a = *(const LAS i32x4*)(ucache + 8 * (k)), _b = *(const LAS i32x4*)(ucache + 8 * (k) + 4); \
        (U).pm = __builtin_amdgcn_readfirstlane(_a[1]); (U).pn = __builtin_amdgcn_readfirstlane(_a[2]); (U).orow = __builtin_amdgcn_readfirstlane(_a[3]); \
        (U).ao = (unsigned)__builtin_amdgcn_readfirstlane(_b[0]); (U).bo = (unsigned)__builtin_amdgcn_readfirstlane(_b[1]); return __builtin_amdgcn_readfirstlane(_a[0]) != 0; }())
    Unit cur, nxt; int ui = 0;
    if (!PG8_NEXT(0, cur)) return;
    f32x4 acc[2][2][4][2];
#pragma unroll
    for (int a = 0; a < 2; ++a)
#pragma unroll
        for (int b = 0; b < 2; ++b)
#pragma unroll
            for (int m = 0; m < 4; ++m)
#pragma unroll
                for (int n = 0; n < 2; ++n) { acc[a][b][m][n] = (f32x4){0.f, 0.f, 0.f, 0.f}; if constexpr (FP8) asm volatile("" : "+v"(acc[a][b][m][n])); }
    bf16x8 At[4][2], B0[2][2], B1[2][2]; i32x8 At8[4], B08[2], B18[2];
    int sc1 = 0x7f7f7f7f, scw = 0x79797979; asm volatile("" : "+v"(sc1), "+v"(scw));
    unsigned cA = cur.ao, cB = cur.bo;
#pragma unroll
    for (int h = 0; h < 2; ++h)
#pragma unroll
        for (int i = 0; i < 2; ++i) { gcur[h][i] = 0u; gnxt[h][i] = 0u; }
    PG8_GLOAD(gcur, 0);
    if constexpr (SP2) {
        PG8_STAGE(PG8_SB(0, 0), cB, voffB); PG8_STAGE(PG8_SB(0, 1), cB + hstep, voffB); PG8_STAGE_A(PG8_SA(0, 0), cA, 0, gcur); PG8_STAGE_A(PG8_SA(0, 1), cA, 1, gcur);
        if (wr == 1) PG8_BAR;
        PG8_WAIT_V(2); PG8_BAR;
        PG8_STAGE(PG8_SB(1, 0), cB + kstep, voffB); PG8_STAGE_A(PG8_SA(1, 0), cA + kstep, 0, gcur); PG8_STAGE(PG8_SB(1, 1), cB + hstep + kstep, voffB);
        PG8_WAIT_V(6); PG8_BAR;
    } else {
        PG8_STAGE(PG8_SB(0, 0), cB, voffB); PG8_STAGE_A(PG8_SA(0, 0), cA, 0, gcur); PG8_STAGE(PG8_SB(0, 1), cB + hstep, voffB); PG8_STAGE_A(PG8_SA(0, 1), cA, 1, gcur);
        if (wr == 1) PG8_BAR;
        PG8_WAIT_V(4); PG8_BAR;
        PG8_STAGE(PG8_SB(1, 0), cB + kstep, voffB); PG8_STAGE_A(PG8_SA(1, 0), cA + kstep, 0, gcur); PG8_STAGE(PG8_SB(1, 1), cB + hstep + kstep, voffB);
        PG8_WAIT_V(6); PG8_BAR;
    }
    for (;;) {
        const bool has_next = PG8_NEXT(ui + 1, nxt);
        const unsigned nA = has_next ? nxt.ao : cA, nB = has_next ? nxt.bo : cB;
#pragma nounroll
        for (int t = 0; t < nt; t += 2) {
            const bool last = (t == nt - 2);
            const unsigned a1 = cA + (unsigned)(t + 1) * kstep;
            const unsigned a2 = last ? nA : cA + (unsigned)(t + 2) * kstep, b2 = last ? nB : cB + (unsigned)(t + 2) * kstep;
            const unsigned a3 = a2 + kstep, b3 = b2 + kstep;
            unsigned g2[2][2];
            if constexpr (GATHER) {
                if (last && has_next) { PG8_GLOAD(gnxt, ui + 1); }
#pragma unroll
                for (int h = 0; h < 2; ++h)
#pragma unroll
                    for (int i = 0; i < 2; ++i) g2[h][i] = (last && has_next) ? gnxt[h][i] : gcur[h][i];
            }
            if constexpr (SP2) {
            PG8_LDB(B0, 0, 0); PG8_LDB(B1, 0, 1); PG8_SCHED; PG8_LDA(At, 0, 0); PG8_STAGE_A(PG8_SA(1, 1), a1, 1, gcur);
            PG8_BAR; PG8_MMA(0, 0, At, B0); PG8_MMA(0, 1, At, B1); PG8_WAIT_V(8); PG8_BAR; PG8_SCHED;
            PG8_LDA(At, 0, 1); PG8_STAGE(PG8_SB(0, 0), b2, voffB); PG8_STAGE(PG8_SB(0, 1), b2 + hstep, voffB); PG8_STAGE_A(PG8_SA(0, 0), a2, 0, g2);
            PG8_BAR; PG8_MMA(1, 0, At, B0); PG8_MMA(1, 1, At, B1); PG8_WAIT_V(8); PG8_BAR; PG8_SCHED;
            PG8_LDB(B0, 1, 0); PG8_LDB(B1, 1, 1); PG8_SCHED; PG8_LDA(At, 1, 0); PG8_STAGE_A(PG8_SA(0, 1), a2, 1, g2);
            PG8_BAR; PG8_MMA(0, 0, At, B0); PG8_MMA(0, 1, At, B1); PG8_WAIT_V(8); PG8_BAR; PG8_SCHED;
            PG8_LDA(At, 1, 1); PG8_STAGE(PG8_SB(1, 0), b3, voffB); PG8_STAGE(PG8_SB(1, 1), b3 + hstep, voffB); PG8_STAGE_A(PG8_SA(1, 0), a3, 0, g2);
            PG8_BAR; PG8_MMA(1, 0, At, B0); PG8_MMA(1, 1, At, B1); PG8_WAIT_V(8); PG8_BAR; PG8_SCHED;
            } else {
            PG8_LDB(B0, 0, 0); PG8_SCHED; PG8_LDA(At, 0, 0); PG8_STAGE_A(PG8_SA(1, 1), a1, 1, gcur);
            PG8_WAIT_L(8); PG8_BAR; PG8_WAIT_L(0); PG8_MMA(0, 0, At, B0); PG8_BAR; PG8_SCHED;
            PG8_LDB(B1, 0, 1); PG8_STAGE(PG8_SB(0, 0), b2, voffB);
            PG8_BAR; PG8_WAIT_L(0); PG8_MMA(0, 1, At, B1); PG8_BAR;
            PG8_LDA(At, 0, 1); PG8_STAGE_A(PG8_SA(0, 0), a2, 0, g2);
            PG8_BAR; PG8_WAIT_L(0); PG8_MMA(1, 0, At, B0); PG8_BAR; PG8_SCHED;
            PG8_STAGE(PG8_SB(0, 1), b2 + hstep, voffB);
            PG8_WAIT_V(6); PG8_BAR; PG8_MMA(1, 1, At, B1); PG8_BAR;
            PG8_LDB(B0, 1, 0); PG8_SCHED; PG8_LDA(At, 1, 0); PG8_STAGE_A(PG8_SA(0, 1), a2, 1, g2);
            PG8_WAIT_L(8); PG8_BAR; PG8_WAIT_L(0); PG8_MMA(0, 0, At, B0); PG8_BAR; PG8_SCHED;
            PG8_LDB(B1, 1, 1); PG8_STAGE(PG8_SB(1, 0), b3, voffB);
            PG8_BAR; PG8_WAIT_L(0); PG8_MMA(0, 1, At, B1); PG8_BAR;
            PG8_LDA(At, 1, 1); PG8_STAGE_A(PG8_SA(1, 0), a3, 0, g2);
            PG8_BAR; PG8_WAIT_L(0); PG8_MMA(1, 0, At, B0); PG8_BAR; PG8_SCHED;
            PG8_STAGE(PG8_SB(1, 1), b3 + hstep, voffB);
            PG8_WAIT_V(6); PG8_BAR; PG8_MMA(1, 1, At, B1); PG8_BAR;
            }
        }
        if constexpr (ALIGN_EPI) { if (wr == 0) PG8_BAR; }
        if constexpr (FP8) asm volatile("s_nop 15\n\ts_nop 15" ::: "memory");
        E(acc, cur, wr, wc, fr, fq);
        if (!has_next) break;
#pragma unroll
        for (int a = 0; a < 2; ++a)
#pragma unroll
            for (int b = 0; b < 2; ++b)
#pragma unroll
                for (int m = 0; m < 4; ++m)
#pragma unroll
                    for (int n = 0; n < 2; ++n) { acc[a][b][m][n] = (f32x4){0.f, 0.f, 0.f, 0.f}; if constexpr (FP8) asm volatile("" : "+v"(acc[a][b][m][n])); }
        cur = nxt; cA = nA; cB = nB; ++ui;
        if constexpr (GATHER) {
#pragma unroll
            for (int h = 0; h < 2; ++h)
#pragma unroll
                for (int i = 0; i < 2; ++i) gcur[h][i] = gnxt[h][i];
        }
        if constexpr (ALIGN_EPI) { if (wr == 1) PG8_BAR; }
    }
    PG8_WAIT_V(0);
    if constexpr (!ALIGN_EPI) { if (wr == 0) PG8_BAR; }
    PG8_BAR;
#undef PG8_SA
#undef PG8_SB
#undef PG8_STAGE
#undef PG8_STAGE_A
#undef PG8_LDA
#undef PG8_LDB
#undef PG8_MMA
#undef PG8_WAIT_V
#undef PG8_WAIT_L
#undef PG8_BAR
#undef PG8_SCHED
#undef PG8_GLOAD
#undef PG8_NEXT
}
}

#define XB_TMO      128
#define XB_XCNT(j)  (256  + 64 * (j))
#define XB_XSUB(j)  (1280 + 64 * (j))
#define XB_XGEN(j)  (2304 + 64 * (j))
#define XB_TOP      3328
#define XB_TOPGEN   3392
#define XCD_BAR_WORDS 3456
#define XB_SPIN_CAP (1u << 22)

__device__ __forceinline__ unsigned xb_ld(unsigned* p)              { return __hip_atomic_load(p, __ATOMIC_RELAXED, __HIP_MEMORY_SCOPE_AGENT); }
__device__ __forceinline__ unsigned xb_add(unsigned* p, unsigned v) { return __hip_atomic_fetch_add(p, v, __ATOMIC_RELAXED, __HIP_MEMORY_SCOPE_AGENT); }
__device__ __forceinline__ unsigned xb_xcc_id() { return (unsigned)__builtin_amdgcn_s_getreg((3 << 11) | 20) & 0xFu; }
#define XB_SPIN(cond, bar) do { unsigned _sp = 0; while (cond) { __builtin_amdgcn_s_sleep(1); \
    if ((++_sp & 255u) == 0u) { if (xb_ld(&(bar)[XB_TMO])) break; if (_sp > XB_SPIN_CAP) { atomicAdd(&(bar)[XB_TMO], 1u); break; } } } } while (0)

struct XcdBarrier { unsigned* bar; unsigned x; volatile LAS unsigned* st; };

__device__ __forceinline__ XcdBarrier xcd_barrier_post(unsigned* bar, volatile LAS unsigned* st) {
    XcdBarrier b; b.bar = bar; b.x = xb_xcc_id(); b.st = st;
    if (threadIdx.x == 0) (void)xb_add(&bar[XB_XCNT(b.x)], 1u);
    return b;
}
__device__ __forceinline__ void xcd_barrier_complete(unsigned* bar, unsigned x, unsigned& nloc, unsigned& nx) {
    const unsigned G = gridDim.x * gridDim.y * gridDim.z;
    unsigned sum, cnt, mine, sp = 0u;
    for (;;) {
        sum = 0u; cnt = 0u; mine = 0u;
#pragma unroll
        for (unsigned j = 0; j < 16; ++j) { const unsigned c = xb_ld(&bar[XB_XCNT(j)]); sum += c; cnt += (c > 0u) ? 1u : 0u; mine = (j == x) ? c : mine; }
        if (sum == G) break;
        __builtin_amdgcn_s_sleep(1);
        if ((++sp & 255u) == 0u) { if (xb_ld(&bar[XB_TMO])) break; if (sp > XB_SPIN_CAP) { atomicAdd(&bar[XB_TMO], 1u); break; } }
    }
    nloc = mine > 0u ? mine : 1u; nx = cnt > 0u ? cnt : 1u;
}
__device__ __forceinline__ void xcd_barrier(const XcdBarrier& b) {
    asm volatile("s_waitcnt vmcnt(0)" ::: "memory");
    __syncthreads();
    if (threadIdx.x == 0) {
        unsigned* bar = b.bar;
        __builtin_amdgcn_s_waitcnt(0);
        unsigned nloc = b.st[0], nx = b.st[1];
        if (nloc == 0u) { xcd_barrier_complete(bar, b.x, nloc, nx); b.st[0] = nloc; b.st[1] = nx; }
        const unsigned old = xb_add(&bar[XB_XSUB(b.x)], 1u);
        const unsigned gen = old / nloc;
        if (old + 1u == (gen + 1u) * nloc) {
            __builtin_amdgcn_fence(__ATOMIC_RELEASE, "agent");
            asm volatile("s_waitcnt vmcnt(0)" ::: "memory");
            const unsigned og = xb_add(&bar[XB_TOP], 1u);
            const unsigned tg = og / nx;
            if (og + 1u == (tg + 1u) * nx) xb_add(&bar[XB_TOPGEN], 1u);
            else XB_SPIN(xb_ld(&bar[XB_TOPGEN]) == tg, bar);
            __builtin_amdgcn_fence(__ATOMIC_ACQUIRE, "agent");
            asm volatile("s_waitcnt vmcnt(0)" ::: "memory");
        } else {
            XB_SPIN(xb_ld(&bar[XB_TOPGEN]) == gen, bar);
            __builtin_amdgcn_fence(__ATOMIC_ACQUIRE, "agent");
            asm volatile("s_waitcnt vmcnt(0)" ::: "memory");
        }
    }
    __syncthreads();
}

struct Args { const float* in[27]; float* out; unsigned char* ws; };
enum { I_X = 0, I_E_NORM_MIX, I_E_W_IN, I_E_RET_GN, I_E_DW_W, I_E_DW_B, I_E_CV_LN_G, I_E_CV_LN_B, I_E_W_OUT, I_E_NORM_FFN, I_E_FFN_GATE, I_E_FFN_UP, I_E_FFN_DOWN,
       I_O_NORM_MIX, I_O_W_IN, I_O_SG_LN_G, I_O_SG_LN_B, I_O_SG_W, I_O_SG_B, I_O_SC_W, I_O_W_OUT, I_O_NORM_FFN, I_O_ROUTER, I_O_EXP_GATE, I_O_EXP_UP, I_O_EXP_DOWN, I_FINAL_NORM };

struct Frame {
    LAS unsigned char* lds;
    int tid, lane, wave, vcu, G;
};
__device__ __forceinline__ void refresh(Frame& F) { int t = threadIdx.x; asm volatile("" : "+v"(t)); F.tid = t; F.lane = t & 63; F.wave = __builtin_amdgcn_readfirstlane(t >> 6); }
struct PT {
    volatile LAS unsigned* tab;
    __device__ __forceinline__ const void* p(int i) const { const unsigned lo = __builtin_amdgcn_readfirstlane(tab[2 * i]), hi = __builtin_amdgcn_readfirstlane(tab[2 * i + 1]); return (const void*)(const GAS char*)(((unsigned long long)hi << 32) | lo); }
    __device__ __forceinline__ const float* in(int i) const { return (const float*)p(i); }
};

struct CvtItem { const float* src; int N; unsigned char* dst; int Kb; int f8; int perm; int goff; float scale; };
__device__ __forceinline__ void cvt_make(CvtItem& d, const float* W, const float* W2, int K, int N, int mode, unsigned char* WT, int f8, int item, int gsel = -1) {
    const int nout = (mode == 2) ? 2 * N : N, KT = 128;
    const int nblk = nout / 128, kb = item / nblk, nb = item % nblk, k0 = KT * kb, n0 = 128 * nb;
    const float* src = W; int col0 = n0;
    d.scale = 1.0f;
    if (mode == 2) { src = (nb & 1) ? W2 : W; col0 = 128 * (nb >> 1); d.scale = (nb & 1) ? -0.6931471805599453f : -1.4426950408889634f; }
    d.src = src + (size_t)k0 * N + col0; d.N = N; d.f8 = f8; d.Kb = f8 ? K : 2 * K; d.perm = (mode == 1 && n0 < 1024) ? 1 : 0;
    d.dst = WT + (size_t)n0 * d.Kb + (size_t)k0 * (f8 ? 1 : 2); d.goff = gsel >= 0 ? gsel * 1024 + k0 : -1;
}
struct CvtPtrs { const float *ein, *eout, *fg, *fu, *fd, *oin, *oout, *xg, *xu, *xd, *g_ffn, *g_omix; };
constexpr int CV_I0 = (D / 128) * (EVEN_IN / 128), CV_I1 = (D / 128) * (D / 128), CV_I2 = (D / 128) * (2 * DFF / 128), CV_I3 = (DFF / 128) * (D / 128), CV_I4 = (D / 128) * (ODD_IN / 128), CV_I5 = CV_I1;
constexpr int CV_SMALL = CV_I0 + CV_I1 + CV_I2 + CV_I3 + CV_I4 + CV_I5;
constexpr int CV_IG = (D / 128) * (2 * DEXP / 128), CV_ID = (DEXP / 128) * (D / 128), CV_IE = CV_IG + CV_ID;
constexpr int CV_TOTAL = CV_SMALL + NEXP * CV_IE;
__device__ __forceinline__ void cvt_decode(CvtItem& d, const CvtPtrs& P, unsigned char* ws, int it) {
    int r = it;
    if (r < NEXP * CV_IE) {
        const int e = r / CV_IE; r -= e * CV_IE;
        if (r < CV_IG) cvt_make(d, P.xg + (size_t)e * D * DEXP, P.xu + (size_t)e * D * DEXP, D, DEXP, 2, ws + WS_WGU8 + (size_t)e * EXP_GU_BYTES, 1, r);
        else cvt_make(d, P.xd + (size_t)e * DEXP * D, nullptr, DEXP, D, 0, ws + WS_WDN8 + (size_t)e * EXP_DN_BYTES, 1, r - CV_IG);
        return; }
    r -= NEXP * CV_IE;
    if (r < CV_I0) { cvt_make(d, P.ein, nullptr, D, EVEN_IN, 1, ws + WS_W_EIN, 0, r); return; } r -= CV_I0;
    if (r < CV_I1) { cvt_make(d, P.eout, nullptr, D, D, 0, ws + WS_W_EOUT, 0, r); return; } r -= CV_I1;
    if (r < CV_I2) { cvt_make(d, P.fg, P.fu, D, DFF, 2, ws + WS_W_FGU, 0, r, 0); return; } r -= CV_I2;
    if (r < CV_I3) { cvt_make(d, P.fd, nullptr, DFF, D, 0, ws + WS_W_FDN, 0, r); return; } r -= CV_I3;
    if (r < CV_I4) { cvt_make(d, P.oin, nullptr, D, ODD_IN, 0, ws + WS_W_OIN, 0, r, 1); return; } r -= CV_I4;
    cvt_make(d, P.oout, nullptr, D, D, 0, ws + WS_W_OOUT, 0, r);
}
constexpr int CV_LD = 132;
constexpr int CV_GT = 69632;
__device__ __forceinline__ void cvt_load(const CvtItem& d, f32x4 (&v)[8], int tid) {
    const int c4 = tid & 31, kr = tid >> 5;
#pragma unroll
    for (int i = 0; i < 8; ++i) v[i] = __builtin_nontemporal_load((const f32x4*)(d.src + (size_t)(kr + 16 * i) * d.N + 4 * c4));
}
__device__ __forceinline__ void cvt_store(const CvtItem& d, const f32x4 (&v)[8], LAS float* tile, const LAS float* gt, int tid) {
    const int c4 = tid & 31, kr = tid >> 5;
#pragma unroll
    for (int i = 0; i < 8; ++i) { const float g = (d.goff >= 0 ? gt[d.goff + kr + 16 * i] : 1.0f) * d.scale; *(LAS f32x4*)(tile + (kr + 16 * i) * CV_LD + 4 * c4) = v[i] * g; }
    WG_SYNC();
    const int nl = tid & 127, q = tid >> 7; const int c = d.perm ? ((nl >> 1) + 64 * (nl & 1)) : nl;
    if (d.f8) { const LAS float* s = tile + (32 * q) * CV_LD + c; u32x4 o0, o1;
#pragma unroll
        for (int j = 0; j < 4; ++j) { o0[j] = pk4_fp8(s[(4 * j) * CV_LD] * W8_SCALE, s[(4 * j + 1) * CV_LD] * W8_SCALE, s[(4 * j + 2) * CV_LD] * W8_SCALE, s[(4 * j + 3) * CV_LD] * W8_SCALE);
            o1[j] = pk4_fp8(s[(16 + 4 * j) * CV_LD] * W8_SCALE, s[(16 + 4 * j + 1) * CV_LD] * W8_SCALE, s[(16 + 4 * j + 2) * CV_LD] * W8_SCALE, s[(16 + 4 * j + 3) * CV_LD] * W8_SCALE); }
        unsigned char* o = d.dst + (size_t)nl * d.Kb + 32 * q; *(u32x4*)o = o0; *(u32x4*)(o + 16) = o1; }
    else { const LAS float* s = tile + (32 * q) * CV_LD + c; unsigned char* o = d.dst + (size_t)nl * d.Kb + 64 * q;
#pragma unroll
        for (int h = 0; h < 4; ++h) {
            u32x4 w; w.x = pk2(s[(8 * h) * CV_LD], s[(8 * h + 1) * CV_LD]); w.y = pk2(s[(8 * h + 2) * CV_LD], s[(8 * h + 3) * CV_LD]);
            w.z = pk2(s[(8 * h + 4) * CV_LD], s[(8 * h + 5) * CV_LD]); w.w = pk2(s[(8 * h + 6) * CV_LD], s[(8 * h + 7) * CV_LD]);
            *(u32x4*)(o + 16 * h) = w; } }
    WG_SYNC();
}
__device__ __forceinline__ void sincos_d(double a, float& s, float& c) {
    const double k = __builtin_rint(a * 0.63661977236758134308);
    double r = __builtin_fma(-k, 1.57079632679489655800e+00, a); r = __builtin_fma(-k, 6.12323399573676603587e-17, r);
    const double r2 = r * r;
    double sp = 1.0 / 6227020800.0; sp = sp * r2 - 1.0 / 39916800.0; sp = sp * r2 + 1.0 / 362880.0; sp = sp * r2 - 1.0 / 5040.0; sp = sp * r2 + 1.0 / 120.0; sp = sp * r2 - 1.0 / 6.0; sp = sp * r2 + 1.0; sp = sp * r;
    double cp = 1.0 / 87178291200.0; cp = cp * r2 - 1.0 / 479001600.0; cp = cp * r2 + 1.0 / 3628800.0; cp = cp * r2 - 1.0 / 40320.0; cp = cp * r2 + 1.0 / 720.0; cp = cp * r2 - 1.0 / 24.0; cp = cp * r2 + 0.5; cp = 1.0 - cp * r2;
    const int q = (int)((long long)k & 3);
    const double ss = (q == 0) ? sp : (q == 1) ? cp : (q == 2) ? -sp : -cp;
    const double cc = (q == 0) ? cp : (q == 1) ? -sp : (q == 2) ? -cp : sp;
    s = (float)ss; c = (float)cc;
}

struct RopeJob { double f; int gt, NGT, done; };
__device__ __forceinline__ void rope_init(RopeJob& r, const Frame& F) { r.gt = F.vcu * NTHR + F.tid; r.NGT = F.G * NTHR; r.done = 0;
    double f = 1.0; const int i = r.gt & 63; for (int j = 0; j < i; ++j) f *= 0.8659643233600653; r.f = f; }
__device__ __forceinline__ void rope_step(RopeJob& r, unsigned char* ws) {
    const int idx = r.gt + r.done * r.NGT; ++r.done; if (idx >= SEQ * 64) return;
    float* rc = (float*)(ws + WS_ROPE); float* rs = rc + (size_t)SEQ * 64;
    float s, c; sincos_d((double)(idx >> 6) * r.f, s, c); rc[idx] = c; rs[idx] = s; }
__device__ __forceinline__ void misc_tables(Frame& F, const PT& a, unsigned char* ws, RopeJob& rj) {
    const int gt = F.vcu * NTHR + F.tid, NGT = F.G * NTHR;
    while (rj.gt + rj.done * rj.NGT < SEQ * 64) rope_step(rj, ws);
    bf16* sg = (bf16*)(ws + WS_SGW); const float* sw = a.in(I_O_SG_W);
    for (int idx = gt; idx < 4 * 128 * 128; idx += NGT) { const int p = (idx >> 7) & 127, q = idx & 127; sg[idx] = (bf16)f2bf(((p >> 6) >= (q >> 6)) ? sw[idx] : 0.0f); }
}

__device__ __forceinline__ void convert_weights(Frame& F, const PT& a, unsigned char* ws, int it0, int it1, RopeJob& rj) {
    LAS float* tile = (LAS float*)F.lds; LAS float* gt = (LAS float*)(F.lds + CV_GT);
    CvtPtrs P; P.ein = a.in(I_E_W_IN); P.eout = a.in(I_E_W_OUT); P.fg = a.in(I_E_FFN_GATE); P.fu = a.in(I_E_FFN_UP); P.fd = a.in(I_E_FFN_DOWN); P.oin = a.in(I_O_W_IN); P.oout = a.in(I_O_W_OUT);
    P.xg = a.in(I_O_EXP_GATE); P.xu = a.in(I_O_EXP_UP); P.xd = a.in(I_O_EXP_DOWN); P.g_ffn = a.in(I_E_NORM_FFN); P.g_omix = a.in(I_O_NORM_MIX);
    for (int i = F.tid; i < 2048; i += NTHR) gt[i] = (i < 1024) ? P.g_ffn[i] : P.g_omix[i - 1024];
    __syncthreads();
    const int per = (it1 - it0 + F.G - 1) / F.G; const int itb = it0 + F.vcu * per; const int ite = (itb + per < it1) ? itb + per : it1; const int last = ite - 1;
    if (itb >= ite) return;
#define CV_MIN(a, b) ((a) < (b) ? (a) : (b))
    CvtItem dA0, dA1, dB0, dB1; f32x4 vA0[8], vA1[8], vB0[8], vB1[8];
#define CV_LOAD2(d0, d1, v0, v1, k) do { cvt_decode(d0, P, ws, CV_MIN((k), last)); cvt_decode(d1, P, ws, CV_MIN((k) + 1, last)); cvt_load(d0, v0, F.tid); cvt_load(d1, v1, F.tid); } while (0)
#define CV_STORE2(d0, d1, v0, v1, k) do { cvt_store(d0, v0, tile, gt, F.tid); if ((k) + 1 < ite) cvt_store(d1, v1, tile, gt, F.tid); } while (0)
    CV_LOAD2(dA0, dA1, vA0, vA1, itb);
    for (int k = itb;; k += 4) {
        CV_LOAD2(dB0, dB1, vB0, vB1, k + 2);
        rope_step(rj, ws);
        CV_STORE2(dA0, dA1, vA0, vA1, k);
        if (k + 2 >= ite) break;
        CV_LOAD2(dA0, dA1, vA0, vA1, k + 4);
        rope_step(rj, ws);
        CV_STORE2(dB0, dB1, vB0, vB1, k + 2);
        if (k + 4 >= ite) break;
    }
#undef CV_MIN
#undef CV_LOAD2
#undef CV_STORE2
}
__device__ __forceinline__ void rms_row_to_bf16(const float* xrow, const float* gain, bf16* orow, int lane) {
    const f32x4* xr = (const f32x4*)xrow + lane; const f32x4* gr = (const f32x4*)gain + lane;
    f32x4 v[4]; float s = 0.f;
#pragma unroll
    for (int j = 0; j < 4; ++j) { v[j] = xr[64 * j]; s += (v[j][0] * v[j][0] + v[j][1] * v[j][1]) + (v[j][2] * v[j][2] + v[j][3] * v[j][3]); }
    const float r = 1.0f / sqrtf(wave_sum(s) * (1.f / D) + EPS);
    unsigned long long* o8 = (unsigned long long*)orow + lane;
#pragma unroll
    for (int j = 0; j < 4; ++j) { const f32x4 g = gr[64 * j];
        o8[64 * j] = (unsigned long long)pk2(v[j][0] * r * g[0], v[j][1] * r * g[1]) | ((unsigned long long)pk2(v[j][2] * r * g[2], v[j][3] * r * g[3]) << 32); }
}
__device__ __forceinline__ void norm_phase(Frame& F, const float* x, const float* gain, bf16* XN) {
    const int gw = F.vcu * NWAVES + F.wave, NGW = F.G * NWAVES;
    const f32x4* gr = (const f32x4*)gain + F.lane; f32x4 g[4];
#pragma unroll
    for (int j = 0; j < 4; ++j) g[j] = gr[64 * j];
    for (int m0 = gw; m0 < T; m0 += 4 * NGW) {
        f32x4 v[4][4];
#pragma unroll
        for (int k = 0; k < 4; ++k) { const int m = (m0 + k * NGW < T) ? m0 + k * NGW : m0; const f32x4* xr = (const f32x4*)(x + (size_t)m * D) + F.lane;
#pragma unroll
            for (int j = 0; j < 4; ++j) v[k][j] = xr[64 * j]; }
#pragma unroll
        for (int k = 0; k < 4; ++k) { if (m0 + k * NGW >= T) break; float s = 0.f;
#pragma unroll
            for (int j = 0; j < 4; ++j) s += (v[k][j][0] * v[k][j][0] + v[k][j][1] * v[k][j][1]) + (v[k][j][2] * v[k][j][2] + v[k][j][3] * v[k][j][3]);
            const float r = 1.0f / sqrtf(wave_sum(s) * (1.f / D) + EPS);
            unsigned long long* o8 = (unsigned long long*)(XN + (size_t)(m0 + k * NGW) * D) + F.lane;
#pragma unroll
            for (int j = 0; j < 4; ++j) o8[64 * j] = (unsigned long long)pk2(v[k][j][0] * r * g[j][0], v[k][j][1] * r * g[j][1]) | ((unsigned long long)pk2(v[k][j][2] * r * g[j][2], v[k][j][3] * r * g[j][3]) << 32); }
    }
}
__device__ __forceinline__ bf16x8 frag_row(const LAS unsigned char* base, int ldb, int row0, int k0, int lane) {
    return *(const LAS bf16x8*)(base + (row0 + (lane & 15)) * ldb + (k0 + 8 * (lane >> 4)) * 2);
}
__device__ __forceinline__ bf16x8 frag_tr(const LAS unsigned char* base, int ldb, int k0, int n0, int lane) {
    const int g = lane >> 4, q = (lane & 15) >> 2, p = lane & 3;
    const LAS unsigned char* a0 = base + (k0 + 8 * g + q) * ldb + (n0 + 4 * p) * 2;
    const s16x4 lo = __builtin_amdgcn_ds_read_tr16_b64_v4i16((LAS s16x4*)a0);
    const s16x4 hi = __builtin_amdgcn_ds_read_tr16_b64_v4i16((LAS s16x4*)(a0 + 4 * ldb));
    return (bf16x8){lo[0], lo[1], lo[2], lo[3], hi[0], hi[1], hi[2], hi[3]};
}
__device__ __forceinline__ f32x4 mma16(bf16x8 a, bf16x8 b, f32x4 c) { return __builtin_amdgcn_mfma_f32_16x16x32_bf16(a, b, c, 0, 0, 0); }

constexpr int RT_LDQ = 272, RT_LDP = 144, RT_LDO = 528;
constexpr int RT_QS = 0, RT_KS = 17408, RT_KD = 34816, RT_VS = 52224, RT_PS = 69632, RT_SB = 78848, RT_OS = 113664, RT_PW = 147456;
template <bool MAIN>
__device__ __forceinline__ void ret_unit(Frame& F, const PT& a, unsigned char* ws, int unit) {
    const int b = unit >> 7, h = (unit >> 5) & 3, sc = unit & 31;
    const int tid = F.tid, lane = F.lane, w = F.wave;
    const float* p_gn = MAIN ? a.in(I_E_RET_GN) : nullptr;
    const bf16* Z = (const bf16*)(ws + WS_Z);
    LAS unsigned char* L = F.lds;
    LAS float* pw = (LAS float*)(L + RT_PW);
    if (tid <= 64) { const double g = 1.0 - 1.0 / (double)(32 << h); double p = 1.0; for (int j = 0; j < tid; ++j) p *= g; pw[tid] = (float)p; }
    f32x4 st[8];
    if (MAIN) { const f32x4* sp = (const f32x4*)(ws + WS_RETS) + (size_t)unit * 4096;
#pragma unroll
        for (int td = 0; td < 8; ++td) st[td] = sp[(w * 8 + td) * 64 + lane];
    } else {
#pragma unroll
        for (int td = 0; td < 8; ++td) st[td] = (f32x4){0.f, 0.f, 0.f, 0.f};
    }
    WG_SYNC();
    const float c64 = pw[64];
    const int q4 = lane >> 4, r16 = lane & 15;
    if (MAIN) {
#pragma unroll
        for (int td = 0; td < 8; ++td)
#pragma unroll
            for (int jj = 0; jj < 4; ++jj) *(LAS bf16*)(L + RT_SB + (16 * w + 4 * q4 + jj) * RT_LDQ + (16 * td + r16) * 2) = (bf16)f2bf(st[td][jj]);
    }
    const int lrow = tid >> 3, lseg = tid & 7;
    struct RowBuf { u32x4 k0, k1, v0, v1, q0, q1, g0, g1; };
    RowBuf bufA, bufB; bufA.q0 = bufA.q1 = bufA.g0 = bufA.g1 = bufB.q0 = bufB.q1 = bufB.g0 = bufB.g1 = (u32x4){0u, 0u, 0u, 0u};
    f32x4 gnv[4];
    if (MAIN) {
#pragma unroll
        for (int j = 0; j < 4; ++j) gnv[j] = *(const f32x4*)(p_gn + 128 * h + 16 * (tid & 7) + 4 * j); }
#define RT_LOAD(B_, cc_) do { const bf16* _zr = Z + (size_t)(b * SEQ + (sc * 8 + (cc_)) * 64 + lrow) * EVEN_IN + 128 * h + 16 * lseg; \
        (B_).k0 = *(const u32x4*)(_zr + 512); (B_).k1 = *(const u32x4*)(_zr + 512 + 8); (B_).v0 = *(const u32x4*)(_zr + 1024); (B_).v1 = *(const u32x4*)(_zr + 1024 + 8); \
        if (MAIN) { (B_).q0 = *(const u32x4*)_zr; (B_).q1 = *(const u32x4*)(_zr + 8); (B_).g0 = *(const u32x4*)(_zr + 1536); (B_).g1 = *(const u32x4*)(_zr + 1536 + 8); } } while (0)
    RT_LOAD(bufA, 0); RT_LOAD(bufB, 1);
    auto one_chunk = [&](RowBuf& nb, const int cc) __attribute__((always_inline)) {
        const int t0 = b * SEQ + (sc * 8 + cc) * 64;
        const u32x4 gz0 = nb.g0, gz1 = nb.g1;
        { const u32x4 k0 = nb.k0, k1 = nb.k1, v0 = nb.v0, v1 = nb.v1, q0 = nb.q0, q1 = nb.q1;
          RT_LOAD(nb, cc < 6 ? cc + 2 : cc);
          LAS unsigned char* dst = L + lrow * RT_LDQ + 32 * lseg;
          *(LAS u32x4*)(dst + RT_VS) = v0; *(LAS u32x4*)(dst + RT_VS + 16) = v1;
          if (MAIN) { *(LAS u32x4*)(dst + RT_QS) = q0; *(LAS u32x4*)(dst + RT_QS + 16) = q1;
                      *(LAS u32x4*)(dst + RT_KS) = k0; *(LAS u32x4*)(dst + RT_KS + 16) = k1; }
          const float kd = pw[63 - lrow]; u32x4 d0, d1;
#pragma unroll
          for (int j = 0; j < 4; ++j) { d0[j] = pk2(bf2f(k0[j] & 0xffffu) * kd, bf2f(k0[j] >> 16) * kd); d1[j] = pk2(bf2f(k1[j] & 0xffffu) * kd, bf2f(k1[j] >> 16) * kd); }
          *(LAS u32x4*)(dst + RT_KD) = d0; *(LAS u32x4*)(dst + RT_KD + 16) = d1; }
        WG_SYNC();
        f32x4 oacc[4];
        const int ti = w >> 1, te0 = 4 * (w & 1);
        if (MAIN) {
            bf16x8 qa[4], kb[2][4];
#pragma unroll
            for (int ks = 0; ks < 4; ++ks) { qa[ks] = frag_row(L + RT_QS, RT_LDQ, 16 * ti, 32 * ks, lane);
#pragma unroll
                for (int x = 0; x < 2; ++x) kb[x][ks] = frag_row(L + RT_KS, RT_LDQ, 16 * (2 * (w & 1) + x), 32 * ks, lane); }
            __builtin_amdgcn_sched_barrier(0);
#pragma unroll
            for (int x = 0; x < 2; ++x) { const int tj = 2 * (w & 1) + x; f32x4 p = {0.f, 0.f, 0.f, 0.f};
#pragma unroll
                for (int ks = 0; ks < 4; ++ks) p = mma16(qa[ks], kb[x][ks], p);
#pragma unroll
                for (int jj = 0; jj < 4; ++jj) { const int i = 16 * ti + 4 * q4 + jj, j = 16 * tj + r16; const int dd = i > j ? i - j : j - i;
                    *(LAS bf16*)(L + RT_PS + i * RT_LDP + j * 2) = (bf16)f2bf(p[jj] * pw[dd]); } }
#pragma unroll
            for (int x = 0; x < 4; ++x) oacc[x] = (f32x4){0.f, 0.f, 0.f, 0.f};
#pragma unroll
            for (int kh = 0; kh < 2; ++kh) { bf16x8 sbf[2][4];
#pragma unroll
              for (int ks = 0; ks < 2; ++ks)
#pragma unroll
                  for (int x = 0; x < 4; ++x) sbf[ks][x] = frag_row(L + RT_SB, RT_LDQ, 16 * (te0 + x), 32 * (2 * kh + ks), lane);
              __builtin_amdgcn_sched_barrier(0);
#pragma unroll
              for (int ks = 0; ks < 2; ++ks)
#pragma unroll
                  for (int x = 0; x < 4; ++x) oacc[x] = mma16(qa[2 * kh + ks], sbf[ks][x], oacc[x]); }
#pragma unroll
            for (int x = 0; x < 4; ++x)
#pragma unroll
                for (int jj = 0; jj < 4; ++jj) oacc[x][jj] *= pw[16 * ti + 4 * q4 + jj + 1];
            WG_SYNC();
            { bf16x8 pa[2], vb[2][4];
#pragma unroll
              for (int ks = 0; ks < 2; ++ks) { pa[ks] = frag_row(L + RT_PS, RT_LDP, 16 * ti, 32 * ks, lane);
#pragma unroll
                  for (int x = 0; x < 4; ++x) vb[ks][x] = frag_tr(L + RT_VS, RT_LDQ, 32 * ks, 16 * (te0 + x), lane); }
              __builtin_amdgcn_sched_barrier(0);
#pragma unroll
              for (int ks = 0; ks < 2; ++ks)
#pragma unroll
                  for (int x = 0; x < 4; ++x) oacc[x] = mma16(pa[ks], vb[ks][x], oacc[x]); }
#pragma unroll
            for (int x = 0; x < 4; ++x)
#pragma unroll
                for (int jj = 0; jj < 4; ++jj) *(LAS float*)(L + RT_OS + (16 * ti + 4 * q4 + jj) * RT_LDO + (16 * (te0 + x) + r16) * 4) = oacc[x][jj];
        }
#pragma unroll
        for (int td = 0; td < 8; ++td) st[td] = st[td] * c64;
#pragma unroll
        for (int ks = 0; ks < 2; ++ks) { bf16x8 kd[8]; const bf16x8 va = frag_tr(L + RT_VS, RT_LDQ, 32 * ks, 16 * w, lane);
#pragma unroll
          for (int td = 0; td < 8; ++td) kd[td] = frag_tr(L + RT_KD, RT_LDQ, 32 * ks, 16 * td, lane);
          __builtin_amdgcn_sched_barrier(0);
#pragma unroll
          for (int td = 0; td < 8; ++td) st[td] = mma16(va, kd[td], st[td]); }
        WG_SYNC();
        if (MAIN) {
#pragma unroll
            for (int td = 0; td < 8; ++td)
#pragma unroll
                for (int jj = 0; jj < 4; ++jj) *(LAS bf16*)(L + RT_SB + (16 * w + 4 * q4 + jj) * RT_LDQ + (16 * td + r16) * 2) = (bf16)f2bf(st[td][jj]);
            const int i = lrow, e0 = 16 * lseg;
            f32x4 ov[4]; float s = 0.f;
#pragma unroll
            for (int j = 0; j < 4; ++j) { ov[j] = *(const LAS f32x4*)(L + RT_OS + i * RT_LDO + (e0 + 4 * j) * 4); s += (ov[j][0] + ov[j][1]) + (ov[j][2] + ov[j][3]); }
            s = sum8(s);
            const float mu = s * (1.f / 128.f); float q = 0.f;
#pragma unroll
            for (int j = 0; j < 4; ++j) { ov[j] = ov[j] - mu; q += (ov[j][0] * ov[j][0] + ov[j][1] * ov[j][1]) + (ov[j][2] * ov[j][2] + ov[j][3] * ov[j][3]); }
            q = sum8(q);
            const float rstd = 1.0f / sqrtf(q * (1.f / 128.f) + EPS);
            const u32x4 g0 = gz0, g1 = gz1;
            float y[16];
#pragma unroll
            for (int j = 0; j < 4; ++j) { const f32x4 gg = gnv[j];
#pragma unroll
                for (int k = 0; k < 4; ++k) { const int idx = 4 * j + k; const unsigned gw = (idx < 8) ? g0[idx >> 1] : g1[(idx - 8) >> 1]; const float gv = bf2f((idx & 1) ? (gw >> 16) : (gw & 0xffffu));
                    y[idx] = silu_f(gv) * (ov[j][k] * rstd * gg[k]); } }
            u32x4 o0, o1;
#pragma unroll
            for (int j = 0; j < 4; ++j) { o0[j] = pk2(y[2 * j], y[2 * j + 1]); o1[j] = pk2(y[8 + 2 * j], y[8 + 2 * j + 1]); }
            bf16* yp = (bf16*)(ws + WS_Y) + (size_t)(t0 + i) * D + 128 * h + e0;
            *(u32x4*)yp = o0; *(u32x4*)(yp + 8) = o1;
        }
    };
    for (int cc = 0; cc < 8; cc += 2) { one_chunk(bufA, cc); one_chunk(bufB, cc + 1); }
#undef RT_LOAD
    if (!MAIN) { f32x4* lp = (f32x4*)(ws + WS_RETL) + (size_t)unit * 4096;
#pragma unroll
        for (int td = 0; td < 8; ++td) lp[(w * 8 + td) * 64 + lane] = st[td]; }
    WG_SYNC();
}
__device__ __forceinline__ void ret_scan(Frame& F, unsigned char* ws) {
    const float* Lb = (const float*)(ws + WS_RETL); float* Sb = (float*)(ws + WS_RETS);
    const int gt = F.vcu * NTHR + F.tid, NGT = F.G * NTHR;
    for (int idx = gt; idx < 8 * 16384; idx += NGT) { const int bh = idx >> 14, el = idx & 16383, h = bh & 3;
        const double g = 1.0 - 1.0 / (double)(32 << h); double p = g; for (int j = 0; j < 9; ++j) p *= p;
        const float c8 = (float)p; float run = 0.f;
        float lv[32];
#pragma unroll
        for (int s = 0; s < 32; ++s) lv[s] = Lb[((size_t)(bh * 32 + s) << 14) + el];
#pragma unroll
        for (int s = 0; s < 32; ++s) { Sb[((size_t)(bh * 32 + s) << 14) + el] = run; run = c8 * run + lv[s]; } }
}

__device__ __forceinline__ void unpack8(const u32x4 r, float (&v)[8]) {
#pragma unroll
    for (int j = 0; j < 4; ++j) { v[2 * j] = bf2f(r[j] & 0xffffu); v[2 * j + 1] = bf2f(r[j] >> 16); } }
__device__ __forceinline__ u32x4 pack8(const float (&v)[8]) { u32x4 o; o.x = pk2(v[0], v[1]); o.y = pk2(v[2], v[3]); o.z = pk2(v[4], v[5]); o.w = pk2(v[6], v[7]); return o; }
__device__ __forceinline__ void conv_unit(Frame& F, const PT& a, unsigned char* ws, int unit) {
    const int b = unit >> 7, s0 = (unit & 127) * 128, ch = F.tid, tid = F.tid;
    const bf16* Z = (const bf16*)(ws + WS_Z); bf16* Y = (bf16*)(ws + WS_Y);
    LAS float* cv = (LAS float*)F.lds;
    LAS bf16* ct = (LAS bf16*)(F.lds + 65536);
    const float* p_dw = a.in(I_E_DW_W); const float* p_lg = a.in(I_E_CV_LN_G); const float* p_lb = a.in(I_E_CV_LN_B);
    float wk[31];
#pragma unroll
    for (int k = 0; k < 31; ++k) wk[k] = p_dw[k * 512 + ch];
    const float bias = a.in(I_E_DW_B)[ch];
    const int ltok = tid >> 4, lseg = tid & 15;
    u32x4 ra[4], rb[4];
#define CV_LOAD(sfirst) do { const int _s = (sfirst) + ltok; const bf16* _zr = Z + (size_t)(b * SEQ + (_s >= 0 ? _s : 0)) * EVEN_IN + 2048 + 32 * lseg; \
        _Pragma("unroll") for (int j = 0; j < 4; ++j) { ra[j] = *(const u32x4*)(_zr + 8 * j); rb[j] = *(const u32x4*)(_zr + 512 + 8 * j); } } while (0)
#define CV_GLU_TO_LDS() do { _Pragma("unroll") for (int j = 0; j < 4; ++j) { float av[8], bv[8]; unpack8(ra[j], av); unpack8(rb[j], bv); \
        _Pragma("unroll") for (int k = 0; k < 8; ++k) av[k] = av[k] * fast_sigmoid(bv[k]); \
        *(LAS u32x4*)(ct + ltok * 512 + 32 * lseg + 8 * j) = pack8(av); } } while (0)
    float c[62];
    const f32x4 g0 = *(const f32x4*)(p_lg + 8 * F.lane), g1 = *(const f32x4*)(p_lg + 8 * F.lane + 4);
    const f32x4 b0 = *(const f32x4*)(p_lb + 8 * F.lane), b1 = *(const f32x4*)(p_lb + 8 * F.lane + 4);
    CV_LOAD(s0 - 32);
    if (s0 - 32 + ltok < 0) {
#pragma unroll
        for (int j = 0; j < 4; ++j) ra[j] = (u32x4){0u, 0u, 0u, 0u}; }
    CV_GLU_TO_LDS();
    CV_LOAD(s0);
    WG_SYNC();
#pragma unroll
    for (int j = 0; j < 30; ++j) c[j] = bf2f(ct[(j + 2) * 512 + ch]);
    WG_SYNC();
    for (int p = 0; p < 4; ++p) {
        CV_GLU_TO_LDS();
        CV_LOAD(s0 + 32 * (p < 3 ? p + 1 : p));
        WG_SYNC();
#pragma unroll
        for (int j = 0; j < 32; ++j) c[30 + j] = bf2f(ct[j * 512 + ch]);
        float o[32];
#pragma unroll
        for (int i = 0; i < 32; ++i) { float acc = bias;
#pragma unroll
            for (int k = 0; k < 31; ++k) acc = __builtin_fmaf(wk[k], c[i + k], acc);
            o[i] = acc; }
#pragma unroll
        for (int i = 0; i < 32; ++i) cv[i * 512 + ch] = o[i];
#pragma unroll
        for (int j = 0; j < 30; ++j) c[j] = c[j + 32];
        WG_SYNC();
#pragma unroll
        for (int x = 0; x < 4; ++x) { const int i = 4 * F.wave + x; const LAS f32x4* r = (const LAS f32x4*)(cv + i * 512 + 8 * F.lane);
            f32x4 v0 = r[0], v1 = r[1]; float s = (v0[0] + v0[1]) + (v0[2] + v0[3]) + (v1[0] + v1[1]) + (v1[2] + v1[3]);
            const float mu = wave_sum(s) * (1.f / 512.f); v0 = v0 - mu; v1 = v1 - mu;
            float q = (v0[0] * v0[0] + v0[1] * v0[1]) + (v0[2] * v0[2] + v0[3] * v0[3]) + (v1[0] * v1[0] + v1[1] * v1[1]) + (v1[2] * v1[2] + v1[3] * v1[3]);
            const float rstd = 1.0f / sqrtf(wave_sum(q) * (1.f / 512.f) + EPS);
            float y[8];
#pragma unroll
            for (int k = 0; k < 4; ++k) { y[k] = silu_f(v0[k] * rstd * g0[k] + b0[k]); y[4 + k] = silu_f(v1[k] * rstd * g1[k] + b1[k]); }
            *(u32x4*)(Y + (size_t)(b * SEQ + s0 + 32 * p + i) * D + 512 + 8 * F.lane) = pack8(y); }
        WG_SYNC();
    }
#undef CV_LOAD
#undef CV_GLU_TO_LDS
}

constexpr int M1_VS = 0, M1_WS = 34816, M1_ST = 69632, M1_SP = 70656, M1_LD = 272, M1_LDS = 132;
__device__ __forceinline__ void mixer1_unit(Frame& F, const PT& a, unsigned char* ws, int unit) {
    const int t0 = unit * 128, s0 = (unit & 127) * 128;
    const int tid = F.tid, lane = F.lane, w = F.wave;
    const bf16* Z = (const bf16*)(ws + WS_Z); bf16* Y = (bf16*)(ws + WS_Y);
    LAS unsigned char* L = F.lds; LAS f32x2* stt = (LAS f32x2*)(L + M1_ST); LAS float* SP = (LAS float*)(L + M1_SP);
    const float* p_lng = a.in(I_O_SG_LN_G); const float* p_lnb = a.in(I_O_SG_LN_B); const float* p_sgb = a.in(I_O_SG_B); const float* p_scw = a.in(I_O_SC_W);
    LAS float* GL = (LAS float*)(L + 139264);
    { GL[tid] = p_lng[tid]; GL[512 + tid] = p_lnb[tid]; GL[1024 + tid] = p_sgb[tid]; }
#pragma unroll
    for (int b8 = 0; b8 < 2; ++b8) { u32x4 raw[8];
#pragma unroll
        for (int x = 0; x < 8; ++x) raw[x] = *(const u32x4*)(Z + (size_t)(t0 + 16 * w + 8 * b8 + x) * ODD_IN + 512 + 8 * lane);
#pragma unroll
        for (int x = 0; x < 8; ++x) { float v[8]; unpack8(raw[x], v); float s = 0.f;
#pragma unroll
            for (int j = 0; j < 8; ++j) { v[j] = gelu_tanh(v[j]); s += v[j]; }
            const float mu = wave_sum(s) * (1.f / 512.f); float q = 0.f;
#pragma unroll
            for (int j = 0; j < 8; ++j) { const float d = v[j] - mu; q += d * d; }
            const float rstd = 1.0f / sqrtf(wave_sum(q) * (1.f / 512.f) + EPS);
            if (lane == 0) stt[16 * w + 8 * b8 + x] = (f32x2){mu, rstd}; } }
    WG_SYNC();
    const int q4 = lane >> 4, r16 = lane & 15;
    const int tk = tid >> 2, part = tid & 3;
    u32x4 raw[4], wr4[4], uraw[4];
#define M1_LOAD_FILL(g_) do { const bf16* _zr = Z + (size_t)(t0 + tk) * ODD_IN + 512 + 128 * (g_) + 32 * part; const bf16* _ws = (const bf16*)(ws + WS_SGW) + (size_t)((g_) * 128 + tk) * 128 + 32 * part; \
        _Pragma("unroll") for (int j = 0; j < 4; ++j) { raw[j] = *(const u32x4*)(_zr + 8 * j); wr4[j] = *(const u32x4*)(_ws + 8 * j); } } while (0)
    M1_LOAD_FILL(0);
#pragma unroll
    for (int g = 0; g < 4; ++g) {
        { const bf16* zu = Z + (size_t)(t0 + tk) * ODD_IN + 128 * g + 32 * part;
#pragma unroll
          for (int j = 0; j < 4; ++j) uraw[j] = *(const u32x4*)(zu + 8 * j); }
        { f32x4 lg[8], lb[8];
#pragma unroll
          for (int j = 0; j < 8; ++j) { lg[j] = *(const LAS f32x4*)(GL + 128 * g + 32 * part + 4 * j); lb[j] = *(const LAS f32x4*)(GL + 512 + 128 * g + 32 * part + 4 * j); }
          const f32x2 ms = stt[tk];
#pragma unroll
          for (int j = 0; j < 4; ++j) { float v[8]; unpack8(raw[j], v);
#pragma unroll
              for (int k = 0; k < 8; ++k) v[k] = (gelu_tanh(v[k]) - ms[0]) * ms[1] * lg[2 * j + (k >> 2)][k & 3] + lb[2 * j + (k >> 2)][k & 3];
              *(LAS u32x4*)(L + M1_VS + tk * M1_LD + (32 * part + 8 * j) * 2) = pack8(v);
              *(LAS u32x4*)(L + M1_WS + tk * M1_LD + (32 * part + 8 * j) * 2) = wr4[j]; } }
        if (g < 3) M1_LOAD_FILL(g + 1);
        WG_SYNC();
        { f32x4 acc[8];
#pragma unroll
          for (int ct = 0; ct < 8; ++ct) acc[ct] = (f32x4){0.f, 0.f, 0.f, 0.f};
#pragma unroll
          for (int ks = 0; ks < 4; ++ks) { const bf16x8 af = frag_row(L + M1_WS, M1_LD, 16 * w, 32 * ks, lane);
#pragma unroll
              for (int ct = 0; ct < 8; ++ct) acc[ct] = mma16(af, frag_tr(L + M1_VS, M1_LD, 32 * ks, 16 * ct, lane), acc[ct]); }
#pragma unroll
          for (int jj = 0; jj < 4; ++jj) { const int p = 16 * w + 4 * q4 + jj; const float sb = GL[1024 + g * 128 + p];
#pragma unroll
              for (int ct = 0; ct < 8; ++ct) SP[p * M1_LDS + 16 * ct + r16] = acc[ct][jj] + sb; } }
        WG_SYNC();
        { bf16* yo = Y + (size_t)(t0 + tk) * D + 128 * g + 32 * part;
#pragma unroll
          for (int j = 0; j < 4; ++j) { float v[8]; unpack8(uraw[j], v); const f32x4 s0v = *(const LAS f32x4*)(SP + tk * M1_LDS + 32 * part + 8 * j), s1v = *(const LAS f32x4*)(SP + tk * M1_LDS + 32 * part + 8 * j + 4);
#pragma unroll
              for (int k = 0; k < 4; ++k) { v[k] = gelu_tanh(v[k]) * s0v[k]; v[4 + k] = gelu_tanh(v[4 + k]) * s1v[k]; }
              *(u32x4*)(yo + 8 * j) = pack8(v); } }
    }
#undef M1_LOAD_FILL
    { const int ch0 = 8 * lane; float w0[8], w1[8], w2[8];
#pragma unroll
      for (int j = 0; j < 2; ++j) { const f32x4 a0 = *(const f32x4*)(p_scw + ch0 + 4 * j), a1 = *(const f32x4*)(p_scw + 512 + ch0 + 4 * j), a2 = *(const f32x4*)(p_scw + 1024 + ch0 + 4 * j);
#pragma unroll
          for (int k = 0; k < 4; ++k) { w0[4 * j + k] = a0[k]; w1[4 * j + k] = a1[k]; w2[4 * j + k] = a2[k]; } }
#pragma unroll
      for (int b8 = 0; b8 < 2; ++b8) { const int tb = 16 * w + 8 * b8;
          u32x4 cg[10], hv[10], bg[8];
#pragma unroll
          for (int x = 0; x < 10; ++x) { const int tt = tb - 2 + x; const bool ok = (s0 + tt) >= 0; const bf16* zr = Z + (size_t)(t0 + (ok ? tt : 0)) * ODD_IN + ch0;
              cg[x] = *(const u32x4*)(zr + 1536); hv[x] = *(const u32x4*)(zr + 2048); }
#pragma unroll
          for (int x = 0; x < 8; ++x) bg[x] = *(const u32x4*)(Z + (size_t)(t0 + tb + x) * ODD_IN + 1024 + ch0);
          __builtin_amdgcn_sched_barrier(0);
#pragma unroll
          for (int x = 0; x < 2; ++x) { if ((s0 + tb - 2 + x) < 0) cg[x] = (u32x4){0u, 0u, 0u, 0u}; }
          float pr[10][8];
#pragma unroll
          for (int x = 0; x < 10; ++x) { float c8[8], h8[8]; unpack8(cg[x], c8); unpack8(hv[x], h8);
#pragma unroll
              for (int k = 0; k < 8; ++k) pr[x][k] = c8[k] * h8[k]; }
#pragma unroll
          for (int x = 0; x < 8; ++x) { float b8v[8], y[8]; unpack8(bg[x], b8v);
#pragma unroll
              for (int k = 0; k < 8; ++k) y[k] = b8v[k] * (w0[k] * pr[x][k] + w1[k] * pr[x + 1][k] + w2[k] * pr[x + 2][k]);
              *(u32x4*)(Y + (size_t)(t0 + tb + x) * D + 512 + ch0) = pack8(y); } }
    }
    WG_SYNC();
}

__device__ __forceinline__ void route_phase(Frame& F, const PT& a, unsigned char* ws, const float* hres) {
    LAS float* rt = (LAS float*)F.lds;
    LAS int* lcnt = (LAS int*)(F.lds + 32768); LAS int* lbase = lcnt + 8;
    LAS int* te = (LAS int*)(F.lds + 33024); LAS int* tr = te + 256; LAS float* tg = (LAS float*)(tr + 256);
    unsigned* gcnt = (unsigned*)(ws + WS_CTL) + CW_CNT;
    int* row_tok = (int*)(ws + WS_ROWTOK); u32x2* tokinfo = (u32x2*)(ws + WS_TOKINFO);
    const float* p_rt = a.in(I_O_ROUTER); const float* p_ng = a.in(I_O_NORM_FFN);
    for (int i = F.tid; i < 8192; i += NTHR) { const int d = i >> 3, e = i & 7; rt[e * 1024 + d] = p_rt[i]; }
    if (F.tid < 8) lcnt[F.tid] = 0;
    __syncthreads();
    f32x4 gnr[4];
    { const f32x4* gr0 = (const f32x4*)p_ng + F.lane;
#pragma unroll
      for (int j = 0; j < 4; ++j) gnr[j] = gr0[64 * j]; }
    for (int base = F.vcu * 128; base < T; base += F.G * 128) {
        u32x2 va[4], ma[4], vb[4], mb[4];
        { const u32x2* xr = (const u32x2*)(hres + (size_t)(base + 16 * F.wave) * D) + F.lane;
#pragma unroll
          for (int j = 0; j < 4; ++j) { va[j] = xr[64 * j]; ma[j] = xr[256 + 64 * j]; vb[j] = xr[512 + 64 * j]; mb[j] = xr[768 + 64 * j]; } }
        auto one_token = [&](u32x2 (&vn)[4], u32x2 (&mn)[4], const int x) __attribute__((always_inline)) { const int tl = 16 * F.wave + x, t = base + tl;
            f32x4 v[4]; float s = 0.f;
#pragma unroll
            for (int j = 0; j < 4; ++j) { v[j][0] = bf2f(vn[j][0] & 0xffffu) + bf2f(mn[j][0] & 0xffffu); v[j][1] = bf2f(vn[j][0] >> 16) + bf2f(mn[j][0] >> 16);
                                          v[j][2] = bf2f(vn[j][1] & 0xffffu) + bf2f(mn[j][1] & 0xffffu); v[j][3] = bf2f(vn[j][1] >> 16) + bf2f(mn[j][1] >> 16); }
            { const u32x2* xr = (const u32x2*)(hres + (size_t)(t + (x < 14 ? 2 : 0)) * D) + F.lane;
#pragma unroll
              for (int j = 0; j < 4; ++j) { vn[j] = xr[64 * j]; mn[j] = xr[256 + 64 * j]; } }
#pragma unroll
            for (int j = 0; j < 4; ++j) s += (v[j][0] * v[j][0] + v[j][1] * v[j][1]) + (v[j][2] * v[j][2] + v[j][3] * v[j][3]);
            const float r = __builtin_amdgcn_rsqf(wave_sum(s) * (1.f / D) + EPS);
            unsigned* o4 = (unsigned*)(ws + WS_XN8 + (size_t)t * D) + F.lane;
            float lg[8];
#pragma unroll
            for (int e = 0; e < 8; ++e) lg[e] = 0.f;
#pragma unroll
            for (int j = 0; j < 4; ++j) { const f32x4 g = gnr[j]; f32x4 xn; xn[0] = v[j][0] * r * g[0]; xn[1] = v[j][1] * r * g[1]; xn[2] = v[j][2] * r * g[2]; xn[3] = v[j][3] * r * g[3];
                o4[64 * j] = pk4_fp8(xn[0], xn[1], xn[2], xn[3]);
#pragma unroll
                for (int e = 0; e < 8; ++e) { const f32x4 rw = *(const LAS f32x4*)(rt + e * 1024 + 256 * j + 4 * F.lane); lg[e] += (xn[0] * rw[0] + xn[1] * rw[1]) + (xn[2] * rw[2] + xn[3] * rw[3]); } }
#pragma unroll
            for (int e = 0; e < 8; ++e) lg[e] = wave_sum(lg[e]);
            int e1 = 0; float m1 = lg[0];
#pragma unroll
            for (int e = 1; e < 8; ++e) if (lg[e] > m1) { m1 = lg[e]; e1 = e; }
            int e2 = -1; float m2 = 0.f;
#pragma unroll
            for (int e = 0; e < 8; ++e) if (e != e1 && (e2 < 0 || lg[e] > m2)) { m2 = lg[e]; e2 = e; }
            const float p2 = __expf(m2 - m1), g1 = __builtin_amdgcn_rcpf(1.0f + p2), g2 = p2 * g1;
            if (F.lane == 0) { te[2 * tl] = e1; te[2 * tl + 1] = e2; tg[2 * tl] = g1; tg[2 * tl + 1] = g2;
                tr[2 * tl] = __hip_atomic_fetch_add(lcnt + e1, 1, __ATOMIC_RELAXED, __HIP_MEMORY_SCOPE_WORKGROUP); tr[2 * tl + 1] = __hip_atomic_fetch_add(lcnt + e2, 1, __ATOMIC_RELAXED, __HIP_MEMORY_SCOPE_WORKGROUP); } };
        for (int x = 0; x < 16; x += 2) { one_token(va, ma, x); one_token(vb, mb, x + 1); }
        __syncthreads();
        if (F.tid < 8) { lbase[F.tid] = (int)__hip_atomic_fetch_add(gcnt + 64 * F.tid, (unsigned)lcnt[F.tid], RLX_AGENT); }
        __syncthreads();
        if (F.tid < 256) { const int e = te[F.tid], idx = lbase[e] + tr[F.tid], t = base + (F.tid >> 1);
            row_tok[e * 32768 + idx] = t;
            tokinfo[(size_t)t * 2 + (F.tid & 1)] = (u32x2){((unsigned)e << 24) | (unsigned)idx, __float_as_uint(tg[F.tid])}; }
        __syncthreads();
        if (F.tid < 8) lcnt[F.tid] = 0;
        __syncthreads();
    }
}
__device__ __forceinline__ void combine_phase(Frame& F, const PT& a, unsigned char* ws, const LAS int* bstart, float* out) {
    const int gw = F.vcu * NWAVES + F.wave, NGW = F.G * NWAVES;
    const u32x2* tokinfo = (const u32x2*)(ws + WS_TOKINFO); const bf16* YM = (const bf16*)(ws + WS_YMOE); const bf16* SL = (const bf16*)(ws + WS_SLAB); const float* p_fn = a.in(I_FINAL_NORM);
    const f32x4* gr = (const f32x4*)p_fn + F.lane; f32x4 gn[4];
#pragma unroll
    for (int j = 0; j < 4; ++j) gn[j] = gr[64 * j];
    for (int tb = gw; tb < T; tb += 16 * NGW) {
        u32x2 inf0 = {0u, 0u}, inf1 = {0u, 0u};
        { const int tl = tb + (F.lane & 15) * NGW; if (tl < T) { inf0 = tokinfo[(size_t)tl * 2]; inf1 = tokinfo[(size_t)tl * 2 + 1]; } }
        u32x2 hn[4], mn[4], y0n[4], y1n[4]; size_t p0n = 0, p1n = 0;
#define CMB_ISSUE(k) do { const int _t = tb + (k) * NGW; const unsigned _a0 = __builtin_amdgcn_readlane(inf0[0], (k)), _a1 = __builtin_amdgcn_readlane(inf1[0], (k)); \
        p0n = (size_t)bstart[_a0 >> 24] * 256 + (_a0 & 0xffffffu); p1n = (size_t)bstart[_a1 >> 24] * 256 + (_a1 & 0xffffffu); \
        const u32x2* _xr = (const u32x2*)(out + (size_t)_t * D) + F.lane; \
        const u32x2* _y0 = (const u32x2*)(YM + (p0n < 65536 ? p0n : 0) * D) + F.lane; const u32x2* _y1 = (const u32x2*)(YM + (p1n < 65536 ? p1n : 0) * D) + F.lane; \
        _Pragma("unroll") for (int j = 0; j < 4; ++j) { hn[j] = _xr[64 * j]; mn[j] = _xr[256 + 64 * j]; y0n[j] = _y0[64 * j]; y1n[j] = _y1[64 * j]; } } while (0)
        CMB_ISSUE(0);
#pragma unroll
        for (int k = 0; k < 16; ++k) { const int t = tb + k * NGW; if (t >= T) break;
            f32x4 v[4]; u32x2 ya[4], yb[4]; const size_t p0 = p0n, p1 = p1n;
#pragma unroll
            for (int j = 0; j < 4; ++j) { v[j][0] = bf2f(hn[j][0] & 0xffffu) + bf2f(mn[j][0] & 0xffffu); v[j][1] = bf2f(hn[j][0] >> 16) + bf2f(mn[j][0] >> 16);
                                          v[j][2] = bf2f(hn[j][1] & 0xffffu) + bf2f(mn[j][1] & 0xffffu); v[j][3] = bf2f(hn[j][1] >> 16) + bf2f(mn[j][1] >> 16); ya[j] = y0n[j]; yb[j] = y1n[j]; }
            const float g0 = __uint_as_float(__builtin_amdgcn_readlane(inf0[1], k)), g1 = __uint_as_float(__builtin_amdgcn_readlane(inf1[1], k));
            if (k < 15 && t + NGW < T) CMB_ISSUE(k + 1);
#pragma unroll
            for (int kk = 0; kk < 2; ++kk) { const size_t p = kk ? p1 : p0; const float g = kk ? g1 : g0;
                if (p < (size_t)65536) {
#pragma unroll
                    for (int j = 0; j < 4; ++j) { const u32x2 a0 = kk ? yb[j] : ya[j]; v[j][0] += g * bf2f(a0[0] & 0xffffu); v[j][1] += g * bf2f(a0[0] >> 16); v[j][2] += g * bf2f(a0[1] & 0xffffu); v[j][3] += g * bf2f(a0[1] >> 16); } }
                else { f32x4 acc[4];
#pragma unroll
                    for (int j = 0; j < 4; ++j) acc[j] = (f32x4){0.f, 0.f, 0.f, 0.f};
                    for (int ks = 0; ks < 7; ++ks) { const u32x2* y = (const u32x2*)(SL + ((size_t)ks * 2048 + (p - 65536)) * D) + F.lane;
#pragma unroll
                        for (int j = 0; j < 4; ++j) { const u32x2 a0 = y[64 * j]; acc[j][0] += bf2f(a0[0] & 0xffffu); acc[j][1] += bf2f(a0[0] >> 16); acc[j][2] += bf2f(a0[1] & 0xffffu); acc[j][3] += bf2f(a0[1] >> 16); } }
#pragma unroll
                    for (int j = 0; j < 4; ++j) v[j] = v[j] + acc[j] * g; } }
            float s = 0.f;
#pragma unroll
            for (int j = 0; j < 4; ++j) s += (v[j][0] * v[j][0] + v[j][1] * v[j][1]) + (v[j][2] * v[j][2] + v[j][3] * v[j][3]);
            const float r = 1.0f / sqrtf(wave_sum(s) * (1.f / D) + EPS);
            f32x4* xr = (f32x4*)(out + (size_t)t * D) + F.lane;
#pragma unroll
            for (int j = 0; j < 4; ++j) { f32x4 o; o[0] = v[j][0] * r * gn[j][0]; o[1] = v[j][1] * r * gn[j][1]; o[2] = v[j][2] * r * gn[j][2]; o[3] = v[j][3] * r * gn[j][3]; xr[64 * j] = o; }
        }
#undef CMB_ISSUE
    }
}

__global__ void __launch_bounds__(NTHR, 2) mega_fwd(Args args) {
    extern __shared__ __attribute__((aligned(16))) unsigned char lds[];
    Frame F;
    F.lds = (LAS unsigned char*)lds;
    volatile LAS unsigned* MISC = (volatile LAS unsigned*)(F.lds + MISC_OFF);
    F.tid = threadIdx.x; F.lane = F.tid & 63; F.wave = __builtin_amdgcn_readfirstlane(F.tid >> 6);
    F.G = gridDim.x; { const int bx = blockIdx.x; F.vcu = (F.G % 8 == 0) ? (bx % 8) * (F.G / 8) + bx / 8 : bx; }
    for (int u = F.tid; u < 256; u += NTHR) MISC[u] = 0u;
    __syncthreads();
    if (F.tid == 0) {
#pragma unroll
        for (int i = 0; i < 29; ++i) { const unsigned long long v = (i < 27) ? (unsigned long long)args.in[i < 27 ? i : 0] : (i == 27 ? (unsigned long long)args.out : (unsigned long long)args.ws);
            MISC[128 + 2 * i] = (unsigned)v; MISC[128 + 2 * i + 1] = (unsigned)(v >> 32); } }
    __syncthreads();
    const PT pt{MISC + 128};
    unsigned char* const ws = (unsigned char*)pt.p(28);
    unsigned* ctl = (unsigned*)(ws + WS_CTL);
    XcdBarrier bar = xcd_barrier_post(ctl + CW_BAR, MISC + 8);
#define GRID_BAR() xcd_barrier(bar)
    const int bx = (int)blockIdx.x;
    float* const hres = (float*)pt.p(27);
    bf16* const HM = (bf16*)hres;
    bf16* const XN = (bf16*)(ws + WS_XN);
    LAS unsigned char* const ring = F.lds;
    const LAS unsigned short* const rowoff = (const LAS unsigned short*)(F.lds + ROWOFF_OFF);

    RopeJob rj; rope_init(rj, F);
    refresh(F); convert_weights(F, pt, ws, 0, CV_TOTAL, rj);
    refresh(F); misc_tables(F, pt, ws, rj);
    refresh(F); norm_phase(F, pt.in(I_X), pt.in(I_E_NORM_MIX), XN);
    GRID_BAR();
    { pg8::PlainSched S; S.o.init(T / 256, EVEN_IN / 256, F.G, bx, 1); S.Abase = (const char*)XN; S.Bbase = (const char*)(ws + WS_W_EIN); S.tstep = 256u * D * 2u; S.tstepA = 0u;
      pg8::EpiZ0 E{(bf16*)(ws + WS_Z), (const float*)(ws + WS_ROPE), (const float*)(ws + WS_ROPE) + (size_t)SEQ * 64};
      pg8::gemm_phase<pg8::EpiZ0, pg8::PlainSched, false, true, true>(ring, rowoff, D, S, E); }
    GRID_BAR();
    for (int u = F.vcu; u < 256; u += F.G) { refresh(F); ret_unit<false>(F, pt, ws, u); refresh(F); conv_unit(F, pt, ws, u); }
    GRID_BAR();
    refresh(F); ret_scan(F, ws);
    GRID_BAR();
    for (int u = F.vcu; u < 256; u += F.G) { refresh(F); ret_unit<true>(F, pt, ws, u); }
    GRID_BAR();
    { pg8::PlainSched S; S.o.init(T / 256, D / 256, F.G, bx, 1); S.Abase = (const char*)(ws + WS_Y); S.Bbase = (const char*)(ws + WS_W_EOUT); S.tstep = 256u * D * 2u; S.tstepA = 0u;
      pg8::EpiResB<0> E{pt.in(I_X), nullptr, 0, XN, D, (float*)(ws + WS_SSP), (LAS float*)(F.lds + ROWOFF_OFF)};
      pg8::gemm_phase<pg8::EpiResB<0>, pg8::PlainSched, false, true, true>(ring, rowoff, D, S, E); }
    GRID_BAR();
    { pg8::PlainSched S; S.o.init(T / 256, 2 * DFF / 256, F.G, bx, 1); S.Abase = (const char*)XN; S.Bbase = (const char*)(ws + WS_W_FGU); S.tstep = 256u * D * 2u; S.tstepA = 0u;
      pg8::EpiSwiGLU E{(bf16*)(ws + WS_HFFN), DFF, (const float*)(ws + WS_SSP)};
      pg8::gemm_phase<pg8::EpiSwiGLU, pg8::PlainSched, false, true, true>(ring, rowoff, D, S, E); }
    GRID_BAR();
    { pg8::PlainSched S; S.o.init(T / 256, D / 256, F.G, bx, 1); S.Abase = (const char*)(ws + WS_HFFN); S.Bbase = (const char*)(ws + WS_W_FDN); S.tstep = 256u * DFF * 2u; S.tstepA = 0u;
      pg8::EpiResB<1> E{nullptr, XN, D, HM, 2 * D, (float*)(ws + WS_SSP), (LAS float*)(F.lds + ROWOFF_OFF)};
      pg8::gemm_phase<pg8::EpiResB<1>, pg8::PlainSched, false, true, true>(ring, rowoff, DFF, S, E); }
    GRID_BAR();
    { pg8::PlainSched S; S.o.init(T / 256, ODD_IN / 256, F.G, bx, 1); S.Abase = (const char*)HM; S.Bbase = (const char*)(ws + WS_W_OIN); S.tstep = 256u * D * 2u; S.tstepA = 256u * D * 4u;
      pg8::EpiBf16 E{(bf16*)(ws + WS_Z), ODD_IN, (const float*)(ws + WS_SSP)};
      pg8::gemm_phase<pg8::EpiBf16, pg8::PlainSched, false, true, true>(ring, rowoff, D, S, E, 0, D * 4); }
    GRID_BAR();
    for (int u = F.vcu; u < 256; u += F.G) { refresh(F); mixer1_unit(F, pt, ws, u); }
    GRID_BAR();
    { pg8::PlainSched S; S.o.init(T / 256, D / 256, F.G, bx, 1); S.Abase = (const char*)(ws + WS_Y); S.Bbase = (const char*)(ws + WS_W_OOUT); S.tstep = 256u * D * 2u; S.tstepA = 0u;
      pg8::EpiBf16S E{HM + D, 2 * D, 1.0f};
      pg8::gemm_phase<pg8::EpiBf16S, pg8::PlainSched, false, true, true>(ring, rowoff, D, S, E); }
    GRID_BAR();
    refresh(F); route_phase(F, pt, ws, hres);
    GRID_BAR();
    LAS int* mcnt = (LAS int*)(F.lds + MISC_OFF + 64 * 4); LAS int* mbst = mcnt + 8;
    refresh(F);
    if (F.tid < 8) mcnt[F.tid] = (int)__hip_atomic_load(ctl + CW_CNT + 64 * F.tid, RLX_AGENT);
    __syncthreads();
    if (F.tid == 0) { int run = 0;
        for (int e = 0; e < 8; ++e) { mbst[e] = run; run += (mcnt[e] + 255) >> 8; }
        mbst[8] = run; }
    __syncthreads();
    const int RB = mbst[8];
    const LAS unsigned short* const rowtok = (const LAS unsigned short*)(F.lds + ROWOFF_OFF);
#define MOE_GU(R0, NRB) do { pg8::MoeGuSched S; S.o.init((NRB), 2 * DEXP / 256, F.G, bx); S.rb0 = (R0); S.bstart = mbst; S.Abase = (const char*)(ws + WS_XN8); S.Bbase = (const char*)(ws + WS_WGU8); \
      { refresh(F); LAS unsigned short* rt16 = (LAS unsigned short*)(F.lds + ROWOFF_OFF); const int* row_tok = (const int*)(ws + WS_ROWTOK); \
        int tokv[32]; \
        _Pragma("unroll") for (int ui = 0; ui < 32; ++ui) { pg8::Unit u; u.pm = 0; u.pn = 0; u.orow = 0; u.ao = 0u; u.bo = 0u; const bool ok = S.next(ui, u); \
            const int e = pg8::expert_of(mbst, u.pm), j = u.pm - mbst[e], idx = 256 * j + (F.tid & 255); const bool live = ok && idx < mcnt[e]; \
            const int ld = row_tok[e * 32768 + (live ? idx : 0)]; tokv[ui] = live ? ld : 0; } \
        if (F.tid < 256) { _Pragma("unroll") for (int ui = 0; ui < 32; ++ui) rt16[ui * 256 + F.tid] = (unsigned short)tokv[ui]; } \
        __syncthreads(); } \
      pg8::EpiSwiGLU8 E{ws + WS_HMOE8, DEXP}; \
      pg8::gemm_phase<pg8::EpiSwiGLU8, pg8::MoeGuSched, true, true, true, true>(ring, rowtok, D, S, E); } while (0)
#define MOE_DN(R0, NRB) do { pg8::MoeDnSched S; S.o.init((NRB), D / 256, F.G, bx); S.rb0 = (R0); S.bstart = mbst; S.Abase = (const char*)(ws + WS_HMOE8); S.Bbase = (const char*)(ws + WS_WDN8); \
      pg8::EpiBf16S E{(bf16*)(ws + WS_YMOE), D, 1.0f}; \
      pg8::gemm_phase<pg8::EpiBf16S, pg8::MoeDnSched, false, true, true, true>(ring, rowtok, DEXP, S, E); } while (0)
    const int RBH = 128, RBM = RB < 256 ? RB : 256;
    MOE_GU(0, RBH);
    GRID_BAR();
    MOE_DN(0, RBH);
    MOE_GU(RBH, RB - RBH);
    GRID_BAR();
    MOE_DN(RBH, RBM - RBH);
    if (RB > 256) {
      pg8::MoeDnSplitSched S; S.n = (RB - 256) * 28; S.G = F.G; S.c = bx; S.bstart = mbst; S.Abase = (const char*)(ws + WS_HMOE8); S.Bbase = (const char*)(ws + WS_WDN8);
      pg8::EpiBf16S E{(bf16*)(ws + WS_SLAB), D, 1.0f};
      pg8::gemm_phase<pg8::EpiBf16S, pg8::MoeDnSplitSched, false, true, true, true>(ring, rowtok, DEXP, S, E, 4); }
#undef MOE_GU
#undef MOE_DN
    GRID_BAR();
    refresh(F); combine_phase(F, pt, ws, mbst, hres);
}

extern "C" void kernel_launch(void* const* d_in, const int* in_sizes, int n_in, void* d_out, int out_size, void* d_ws, size_t ws_size, hipStream_t stream) {
    static int grid = 0;
    if (grid == 0) {
        if (n_in != 27 || in_sizes[0] != T * D || out_size != T * D || ws_size < WS_END) { fprintf(stderr, "kernel_launch: unexpected shapes (n_in %d, in0 %d, out %d, ws %zu); nothing launched\n", n_in, n_in > 0 ? in_sizes[0] : -1, out_size, ws_size); grid = -1; return; }
        int dev = 0, cus = 0, per_cu = 0;
        if (hipGetDevice(&dev) != hipSuccess || hipDeviceGetAttribute(&cus, hipDeviceAttributeMultiprocessorCount, dev) != hipSuccess) { grid = -1; return; }
        if (hipFuncSetAttribute((const void*)mega_fwd, hipFuncAttributeMaxDynamicSharedMemorySize, LDS_BYTES) != hipSuccess) { fprintf(stderr, "kernel_launch: hipFuncSetAttribute failed\n"); grid = -1; return; }
        if (hipOccupancyMaxActiveBlocksPerMultiprocessor(&per_cu, (const void*)mega_fwd, NTHR, LDS_BYTES) != hipSuccess || per_cu < 1) fprintf(stderr, "kernel_launch: occupancy query reports %d\n", per_cu);
        (void)hipGetLastError();
        if (cus != 256) { fprintf(stderr, "kernel_launch: built for a 256-CU device (unit lists of at most 32 units per workgroup and phase); found %d CUs; nothing launched\n", cus); grid = -1; return; }
        grid = cus;
    }
    if (grid < 0) return;
    if (hipMemsetAsync((char*)d_ws + WS_CTL, 0, CTL_ZERO_BYTES, stream) != hipSuccess) return;
    Args a{};
    for (int i = 0; i < 27; ++i) a.in[i] = (const float*)d_in[i];
    a.out = (float*)d_out; a.ws = (unsigned char*)d_ws;
    hipLaunchKernelGGL(mega_fwd, dim3(grid), dim3(NTHR), LDS_BYTES, stream, a);
}
```

```cpp
#include <hip/hip_runtime.h>
#include <cstdio>

#define GAS __attribute__((address_space(1)))
#define LAS __attribute__((address_space(3)))
typedef unsigned short bf16;
typedef short bf16x8 __attribute__((ext_vector_type(8)));
typedef short s16x4 __attribute__((ext_vector_type(4)));
typedef float f32x4 __attribute__((ext_vector_type(4)));
typedef float f32x2 __attribute__((ext_vector_type(2)));
typedef unsigned u32x4 __attribute__((ext_vector_type(4)));
typedef unsigned u32x2 __attribute__((ext_vector_type(2)));
typedef int i32x4 __attribute__((ext_vector_type(4)));
typedef int i32x8 __attribute__((ext_vector_type(8)));

constexpr int BATCH = 2, SEQ = 16384, T = BATCH * SEQ, D = 1024;
constexpr int EVEN_IN = 3072, ODD_IN = 2560, DFF = 2816, NEXP = 8, DEXP = 3584;
constexpr float EPS = 1e-6f;
constexpr int NWAVES = 8, NTHR = 512;

constexpr size_t MiB = 1u << 20;
constexpr size_t WS_CTL = 0, CTL_ZERO_BYTES = 64 * 1024;
constexpr size_t WS_ROWTOK = 1 * MiB;
constexpr size_t WS_TOKINFO = 2 * MiB;
constexpr size_t WS_SSP = 2 * MiB + 512 * 1024;
constexpr size_t WS_WGU8 = 3 * MiB;
constexpr size_t WS_WDN8 = 59 * MiB;
constexpr size_t WS_XN = 87 * MiB;
constexpr size_t WS_Y = 151 * MiB;
constexpr size_t WS_YMOE = 87 * MiB;
constexpr size_t WS_Z = 219 * MiB;
constexpr size_t WS_HFFN = 219 * MiB;
constexpr size_t WS_HMOE8 = 219 * MiB;
constexpr size_t WS_RETL = 411 * MiB;
constexpr size_t WS_RETS = 427 * MiB;
constexpr size_t WS_W_EIN = 443 * MiB;
constexpr size_t WS_W_EOUT = 449 * MiB;
constexpr size_t WS_W_FGU = 451 * MiB;
constexpr size_t WS_W_FDN = 462 * MiB;
constexpr size_t WS_W_OIN = 468 * MiB;
constexpr size_t WS_W_OOUT = 473 * MiB;
constexpr size_t WS_ROPE = 475 * MiB;
constexpr size_t WS_SGW = 483 * MiB;
constexpr size_t WS_XN8 = 450 * MiB;
constexpr size_t WS_SLAB = 482 * MiB;
constexpr size_t WS_END = 510 * MiB;
constexpr size_t EXP_GU_BYTES = (size_t)2 * DEXP * D, EXP_DN_BYTES = (size_t)D * DEXP;
constexpr float W8_SCALE = 64.0f, W8_INV = 1.0f / 64.0f;
constexpr int CW_BAR = 4096, CW_CNT = 8192;

constexpr int LDS_BYTES = 159744;
constexpr int ROWOFF_OFF = 131072;
constexpr int MISC_OFF = LDS_BYTES - 1024;

#define RLX_AGENT __ATOMIC_RELAXED, __HIP_MEMORY_SCOPE_AGENT
#define LDS_WAIT() asm volatile("s_waitcnt lgkmcnt(0)" ::: "memory")
#define VM_WAIT() asm volatile("s_waitcnt vmcnt(0)" ::: "memory")
#define WG_SYNC() do { asm volatile("s_waitcnt lgkmcnt(0)" ::: "memory"); __builtin_amdgcn_s_barrier(); asm volatile("" ::: "memory"); } while (0)

__device__ __forceinline__ float bf2f(unsigned b) { return __uint_as_float(b << 16); }
typedef __bf16 bf16x2_t __attribute__((ext_vector_type(2)));
__device__ __forceinline__ unsigned pk2(float lo, float hi) { const bf16x2_t v = __builtin_convertvector((f32x2){lo, hi}, bf16x2_t); return __builtin_bit_cast(unsigned, v); }
__device__ __forceinline__ unsigned f2bf(float f) { return pk2(f, 0.f) & 0xffffu; }
__device__ __forceinline__ unsigned pk4_fp8(float a, float b, float c, float d) { int r = __builtin_amdgcn_cvt_pk_fp8_f32(a, b, 0, false); r = __builtin_amdgcn_cvt_pk_fp8_f32(c, d, r, true); return (unsigned)r; }
__device__ __forceinline__ float clamp8(float x) { return __builtin_fminf(__builtin_fmaxf(x, -448.0f), 448.0f); }
template <int CTRL, int RMASK> __device__ __forceinline__ float dpp_take(float v) {
    return __builtin_bit_cast(float, __builtin_amdgcn_update_dpp(0, __builtin_bit_cast(int, v), CTRL, RMASK, 0xf, true)); }
__device__ __forceinline__ float wave_sum(float v) {
    v += dpp_take<0x111, 0xf>(v); v += dpp_take<0x112, 0xf>(v); v += dpp_take<0x114, 0xf>(v); v += dpp_take<0x118, 0xf>(v);
    v += dpp_take<0x142, 0xa>(v); v += dpp_take<0x143, 0xc>(v);
    return __builtin_bit_cast(float, __builtin_amdgcn_readlane(__builtin_bit_cast(int, v), 63));
}
template <int CTRL> __device__ __forceinline__ float dpp_all(float v) { return __builtin_bit_cast(float, __builtin_amdgcn_update_dpp(0, __builtin_bit_cast(int, v), CTRL, 0xf, 0xf, false)); }
__device__ __forceinline__ float sum8(float v) { v += dpp_all<0xB1>(v); v += dpp_all<0x4E>(v); v += dpp_all<0x141>(v); return v; }
__device__ __forceinline__ float fast_sigmoid(float x) { return __builtin_amdgcn_rcpf(1.0f + __builtin_amdgcn_exp2f(-1.4426950408889634f * x)); }
__device__ __forceinline__ float silu_f(float x) { return x * fast_sigmoid(x); }
__device__ __forceinline__ f32x2 swiglu2(f32x2 g, f32x2 u) {
    f32x2 e; e.x = __builtin_amdgcn_exp2f(g.x); e.y = __builtin_amdgcn_exp2f(g.y);
    const f32x2 d = e + 1.0f; f32x2 r; r.x = __builtin_amdgcn_rcpf(d.x); r.y = __builtin_amdgcn_rcpf(d.y);
    return (g * u) * r; }
__device__ __forceinline__ float gelu_tanh(float x) {
    const float u = 0.7978845608028654f * (x + 0.044715f * x * x * x);
    return x * fast_sigmoid(2.0f * u);
}

namespace pg8 {
constexpr int BM = 256, BK = 64, HALF = 128, HTB = HALF * BK * 2, STAGE_BYTES = 8 * HTB, NXCD = 8, WGM = 8;
__device__ __forceinline__ int lds_byte(int r, int c) { const int st = (r >> 4) * 2 + (c >> 5), rr = r & 15, cc = c & 31, ob = rr * 64 + cc * 2; return st * 1024 + (ob ^ (((ob >> 9) & 1) << 5)); }
__device__ __forceinline__ void stage_rc(int b, int& R, int& C) { const int st = b / 1024, sb = b % 1024, swz = sb ^ (((sb >> 9) & 1) << 5); R = (st >> 1) * 16 + swz / 64; C = (st & 1) * 32 + (swz % 64) / 2; }
__device__ __forceinline__ int perm32(int rho) { const int n = rho >> 4, i = rho & 15; return 8 * (i >> 2) + 4 * n + (i & 3); }

struct Unit { int pm, pn, orow; unsigned ao, bo; };
struct TileOrder {
    int nM, nN, nwg, G, c;
    __device__ __forceinline__ void init(int nM_, int nN_, int G_, int c_) { nM = nM_; nN = nN_; nwg = nM * nN; G = G_; c = c_; }
    __device__ __forceinline__ bool next(int i, int& pm, int& pn) const {
        const long L = (long)i * G + c; if (L >= nwg) return false;
        int wgid = (int)L; { const int q = nwg / NXCD, r = nwg % NXCD, xcd = wgid % NXCD, off = wgid / NXCD; wgid = (xcd < r ? xcd * (q + 1) : r * (q + 1) + (xcd - r) * q) + off; }
        if (nM == 16 * NXCD && (nN & 1) == 0) {
            const int q = nwg / NXCD, x = wgid / q, p = wgid - x * q, nfull = nN >> 2;
            if (p < nfull * 64) { const int rr = p >> 5, slot = p & 31; pm = x * 16 + (rr & 1) * 8 + (slot & 7); pn = (rr >> 1) * 4 + (slot >> 3); }
            else { const int p2 = p - nfull * 64; pm = x * 16 + (p2 & 15); pn = nfull * 4 + (p2 >> 4); }
            return true; }
        const int nig = WGM * nN, gid = wgid / nig, fm = gid * WGM, gsz = (nM - fm) < WGM ? (nM - fm) : WGM;
        pm = fm + ((wgid % nig) % gsz); pn = (wgid % nig) / gsz; return true;
    }
};
struct PlainSched {
    static constexpr bool REVK = true;
    TileOrder o; const char* Abase; const char* Bbase; unsigned tstep, tstepA;
    __device__ __forceinline__ bool next(int i, Unit& u) const { int pm, pn; if (!o.next(i, pm, pn)) return false; u.pm = pm; u.pn = pn; u.orow = pm; u.ao = (unsigned)pm * (tstepA ? tstepA : tstep); u.bo = (unsigned)pn * tstep; return true; }
};
__device__ __forceinline__ int expert_of(const LAS int* bstart, int rb) { int e = 0;
#pragma unroll
    for (int j = 1; j < 8; ++j) e += (rb >= bstart[j]) ? 1 : 0;
    return e; }
struct MoeGuSched {
    static constexpr bool REVK = false;
    TileOrder o; int rb0; const LAS int* bstart; const char* Abase; const char* Bbase;
    __device__ __forceinline__ bool next(int i, Unit& u) const { int pm, pn; if (!o.next(i, pm, pn)) return false; const int rb = rb0 + pm, e = expert_of(bstart, rb);
        u.pm = rb; u.pn = pn; u.orow = rb; u.ao = 0u; u.bo = (unsigned)e * (unsigned)EXP_GU_BYTES + (unsigned)pn * (unsigned)(256 * D); return true; }
};
struct MoeDnSched {
    static constexpr bool REVK = false;
    TileOrder o; int rb0; const LAS int* bstart; const char* Abase; const char* Bbase;
    __device__ __forceinline__ bool next(int i, Unit& u) const { int pm, pn; if (!o.next(i, pm, pn)) return false; const int rb = rb0 + pm, e = expert_of(bstart, rb);
        u.pm = rb; u.pn = pn; u.orow = rb; u.ao = (unsigned)rb * (unsigned)(256 * DEXP); u.bo = (unsigned)e * (unsigned)EXP_DN_BYTES + (unsigned)pn * (unsigned)(256 * DEXP); return true; }
};
struct MoeDnSplitSched {
    static constexpr bool REVK = false;
    int n, G, c; const LAS int* bstart; const char* Abase; const char* Bbase;
    __device__ __forceinline__ bool next(int i, Unit& u) const { const int L = i * G + c; if (L >= n) return false; const int ks = L % 7, t = L / 7, pn = t & 3, pm = t >> 2, rb = 256 + pm, e = expert_of(bstart, rb);
        u.pm = rb; u.pn = pn; u.orow = ks * 8 + pm; u.ao = (unsigned)rb * (unsigned)(256 * DEXP) + ks * 512u; u.bo = (unsigned)e * (unsigned)EXP_DN_BYTES + (unsigned)pn * (unsigned)(256 * DEXP) + ks * 512u; return true; }
};

__device__ __forceinline__ float row_rstd(const float* ssp, int row) { const f32x4 p = *(const f32x4*)(ssp + (size_t)row * 4); return 1.0f / sqrtf(((p[0] + p[1]) + (p[2] + p[3])) * (1.0f / D) + EPS); }
__device__ __forceinline__ void row_rstd8(const float* ssp, int row0, float (&rs)[2][4]) {
    f32x4 p[2][4];
#pragma unroll
    for (int ai = 0; ai < 2; ++ai)
#pragma unroll
        for (int m = 0; m < 4; ++m) p[ai][m] = *(const f32x4*)(ssp + (size_t)(row0 + ai * 128 + m * 16) * 4);
#pragma unroll
    for (int ai = 0; ai < 2; ++ai)
#pragma unroll
        for (int m = 0; m < 4; ++m) rs[ai][m] = 1.0f / sqrtf(((p[ai][m][0] + p[ai][m][1]) + (p[ai][m][2] + p[ai][m][3])) * (1.0f / D) + EPS);
}
struct StoreMap { int src4, srow, sgrp; };
__device__ __forceinline__ StoreMap store_map(int fr, int fq) { StoreMap sm; sm.src4 = ((((fr & 3) << 4) | (fq << 2) | (fr >> 2)) << 2); sm.srow = (fq << 2) | (fr >> 2); sm.sgrp = fr & 3; return sm; }
__device__ __forceinline__ u32x4 perm_q(const StoreMap& sm, u32x4 w) { u32x4 r;
    r.x = (unsigned)__builtin_amdgcn_ds_bpermute(sm.src4, (int)w.x); r.y = (unsigned)__builtin_amdgcn_ds_bpermute(sm.src4, (int)w.y);
    r.z = (unsigned)__builtin_amdgcn_ds_bpermute(sm.src4, (int)w.z); r.w = (unsigned)__builtin_amdgcn_ds_bpermute(sm.src4, (int)w.w); return r; }
__device__ __forceinline__ u32x2 perm_q(const StoreMap& sm, u32x2 w) { u32x2 r;
    r.x = (unsigned)__builtin_amdgcn_ds_bpermute(sm.src4, (int)w.x); r.y = (unsigned)__builtin_amdgcn_ds_bpermute(sm.src4, (int)w.y); return r; }
struct EpiBf16 {
    static constexpr bool PERM = true;
    bf16* O; int ldc; const float* ssp;
    __device__ __forceinline__ void operator()(const f32x4 (&acc)[2][2][4][2], const Unit& u, int wr, int wc, int fr, int fq) const {
        const int row0 = u.orow * BM + wr * 64 + fr; const StoreMap sm = store_map(fr, fq);
        bf16* const Os = O + (size_t)(u.orow * BM + wr * 64 + sm.srow) * ldc + u.pn * BM + wc * 32 + 8 * sm.sgrp;
        float rsv[2][4]; row_rstd8(ssp, row0, rsv);
#pragma unroll
        for (int ai = 0; ai < 2; ++ai)
#pragma unroll
            for (int m = 0; m < 4; ++m) { bf16* rowp = Os + (size_t)(ai * HALF + m * 16) * ldc;
                const float rs = rsv[ai][m];
#pragma unroll
                for (int bj = 0; bj < 2; ++bj) { const f32x4 v0 = acc[ai][bj][m][0] * rs, v1 = acc[ai][bj][m][1] * rs;
                    u32x4 w; w.x = pk2(v0[0], v0[1]); w.y = pk2(v0[2], v0[3]); w.z = pk2(v1[0], v1[1]); w.w = pk2(v1[2], v1[3]);
                    *(u32x4*)(rowp + bj * HALF) = perm_q(sm, w); } }
    }
};
struct EpiZ0 {
    static constexpr bool PERM = true;
    bf16* O; const float* ropeC; const float* ropeS;
    __device__ __forceinline__ void operator()(const f32x4 (&acc)[2][2][4][2], const Unit& u, int wr, int wc, int fr, int fq) const {
        const int row0 = u.orow * BM + wr * 64 + fr, col0 = u.pn * BM + wc * 32 + 8 * fq;
        const bool rot = u.pn < 4; const float qs = (u.pn < 2) ? 0.08838834764831845f : 1.0f;
        const int i0 = 16 * wc + 4 * fq; const StoreMap sm = store_map(fr, fq);
        bf16* const Os = O + (size_t)(u.orow * BM + wr * 64 + sm.srow) * EVEN_IN + u.pn * BM + wc * 32 + 8 * sm.sgrp;
        f32x4 csv[2][4], snv[2][4];
        if (rot) {
#pragma unroll
            for (int ai = 0; ai < 2; ++ai)
#pragma unroll
                for (int m = 0; m < 4; ++m) { const int pos = (row0 + ai * HALF + m * 16) & (SEQ - 1); csv[ai][m] = *(const f32x4*)(ropeC + (size_t)pos * 64 + i0); snv[ai][m] = *(const f32x4*)(ropeS + (size_t)pos * 64 + i0); } }
#pragma unroll
        for (int ai = 0; ai < 2; ++ai)
#pragma unroll
            for (int m = 0; m < 4; ++m) { bf16* rowp = Os + (size_t)(ai * HALF + m * 16) * EVEN_IN;
                f32x4 cs = {1.f, 1.f, 1.f, 1.f}, sn = {0.f, 0.f, 0.f, 0.f};
                if (rot) { cs = csv[ai][m]; sn = snv[ai][m]; }
#pragma unroll
                for (int bj = 0; bj < 2; ++bj) { f32x4 v0 = acc[ai][bj][m][0], v1 = acc[ai][bj][m][1];
                    if (rot) { f32x4 r0, r1;
                        r0[0] = (v0[0] * cs[0] - v0[1] * sn[0]) * qs; r0[1] = (v0[1] * cs[0] + v0[0] * sn[0]) * qs;
                        r0[2] = (v0[2] * cs[1] - v0[3] * sn[1]) * qs; r0[3] = (v0[3] * cs[1] + v0[2] * sn[1]) * qs;
                        r1[0] = (v1[0] * cs[2] - v1[1] * sn[2]) * qs; r1[1] = (v1[1] * cs[2] + v1[0] * sn[2]) * qs;
                        r1[2] = (v1[2] * cs[3] - v1[3] * sn[3]) * qs; r1[3] = (v1[3] * cs[3] + v1[2] * sn[3]) * qs;
                        v0 = r0; v1 = r1; }
                    u32x4 w; w.x = pk2(v0[0], v0[1]); w.y = pk2(v0[2], v0[3]); w.z = pk2(v1[0], v1[1]); w.w = pk2(v1[2], v1[3]);
                    *(u32x4*)(rowp + bj * HALF) = perm_q(sm, w); } }
    }
};
struct EpiSwiGLU {
    static constexpr bool PERM = true;
    bf16* O; int ldc; const float* ssp;
    __device__ __forceinline__ void operator()(const f32x4 (&acc)[2][2][4][2], const Unit& u, int wr, int wc, int fr, int fq) const {
        const int row0 = u.orow * BM + wr * 64 + fr; const StoreMap sm = store_map(fr, fq);
        bf16* const Os = O + (size_t)(u.orow * BM + wr * 64 + sm.srow) * ldc + u.pn * HALF + wc * 32 + 8 * sm.sgrp;
        float rsv[2][4]; row_rstd8(ssp, row0, rsv);
        u32x4 pprev = {0u, 0u, 0u, 0u}; bf16* rprev = Os;
#pragma unroll
        for (int ai = 0; ai < 2; ++ai)
#pragma unroll
            for (int m = 0; m < 4; ++m) { bf16* rowp = Os + (size_t)(ai * HALF + m * 16) * ldc;
                const float rs = rsv[ai][m];
                const f32x4 g0 = acc[ai][0][m][0] * rs, g1 = acc[ai][0][m][1] * rs, u0 = acc[ai][1][m][0] * rs, u1 = acc[ai][1][m][1] * rs;
                const f32x2 y0 = swiglu2((f32x2){g0[0], g0[1]}, (f32x2){u0[0], u0[1]}), y1 = swiglu2((f32x2){g0[2], g0[3]}, (f32x2){u0[2], u0[3]});
                const f32x2 y2 = swiglu2((f32x2){g1[0], g1[1]}, (f32x2){u1[0], u1[1]}), y3 = swiglu2((f32x2){g1[2], g1[3]}, (f32x2){u1[2], u1[3]});
                u32x4 w; w.x = pk2(y0.x, y0.y); w.y = pk2(y1.x, y1.y); w.z = pk2(y2.x, y2.y); w.w = pk2(y3.x, y3.y);
                const u32x4 pw = perm_q(sm, w);
                if (ai + m > 0) *(u32x4*)rprev = pprev;
                pprev = pw; rprev = rowp; }
        *(u32x4*)rprev = pprev;
    }
};
struct EpiSwiGLU8 {
    static constexpr bool PERM = true;
    unsigned char* O; int ldc;
    __device__ __forceinline__ void operator()(const f32x4 (&acc)[2][2][4][2], const Unit& u, int wr, int wc, int fr, int fq) const {
        const StoreMap sm = store_map(fr, fq);
        unsigned char* const Os = O + (size_t)(u.orow * BM + wr * 64 + sm.srow) * ldc + u.pn * HALF + wc * 32 + 8 * sm.sgrp;
        u32x2 pprev = {0u, 0u}; unsigned char* rprev = Os;
#pragma unroll
        for (int ai = 0; ai < 2; ++ai)
#pragma unroll
            for (int m = 0; m < 4; ++m) { unsigned char* rowp = Os + (size_t)(ai * HALF + m * 16) * ldc;
                const f32x4 g0 = acc[ai][0][m][0], g1 = acc[ai][0][m][1], u0 = acc[ai][1][m][0], u1 = acc[ai][1][m][1];
                const f32x2 y0 = swiglu2((f32x2){g0[0], g0[1]}, (f32x2){u0[0], u0[1]}), y1 = swiglu2((f32x2){g0[2], g0[3]}, (f32x2){u0[2], u0[3]});
                const f32x2 y2 = swiglu2((f32x2){g1[0], g1[1]}, (f32x2){u1[0], u1[1]}), y3 = swiglu2((f32x2){g1[2], g1[3]}, (f32x2){u1[2], u1[3]});
                u32x2 w; w.x = pk4_fp8(y0.x, y0.y, y1.x, y1.y); w.y = pk4_fp8(y2.x, y2.y, y3.x, y3.y);
                const u32x2 pw = perm_q(sm, w);
                if (ai + m > 0) *(u32x2*)rprev = pprev;
                pprev = pw; rprev = rowp; }
        *(u32x2*)rprev = pprev;
    }
};
struct EpiBf16S {
    static constexpr bool PERM = true;
    bf16* O; int ldc; float scale;
    __device__ __forceinline__ void operator()(const f32x4 (&acc)[2][2][4][2], const Unit& u, int wr, int wc, int fr, int fq) const {
        const StoreMap sm = store_map(fr, fq);
        bf16* const Os = O + (size_t)(u.orow * BM + wr * 64 + sm.srow) * ldc + u.pn * BM + wc * 32 + 8 * sm.sgrp;
#pragma unroll
        for (int ai = 0; ai < 2; ++ai)
#pragma unroll
            for (int m = 0; m < 4; ++m) { bf16* rowp = Os + (size_t)(ai * HALF + m * 16) * ldc;
#pragma unroll
                for (int bj = 0; bj < 2; ++bj) { const f32x4 v0 = acc[ai][bj][m][0] * scale, v1 = acc[ai][bj][m][1] * scale;
                    u32x4 w; w.x = pk2(v0[0], v0[1]); w.y = pk2(v0[2], v0[3]); w.z = pk2(v1[0], v1[1]); w.w = pk2(v1[2], v1[3]);
                    *(u32x4*)(rowp + bj * HALF) = perm_q(sm, w); } }
    }
};
struct EpiRes {
    static constexpr bool PERM = false;
    const float* base; float* out;
    __device__ __forceinline__ void operator()(const f32x4 (&acc)[2][2][4][2], const Unit& u, int wr, int wc, int fr, int fq) const {
        const int row0 = u.orow * BM + wr * 64 + fr, col0 = u.pn * BM + wc * 32 + 4 * fq;
#pragma unroll
        for (int ai = 0; ai < 2; ++ai)
#pragma unroll
            for (int m = 0; m < 4; ++m) { const size_t off = (size_t)(row0 + ai * HALF + m * 16) * D + col0;
#pragma unroll
                for (int bj = 0; bj < 2; ++bj)
#pragma unroll
                    for (int n = 0; n < 2; ++n) { const f32x4 bs = *(const f32x4*)(base + off + bj * HALF + n * 16); *(f32x4*)(out + off + bj * HALF + n * 16) = bs + acc[ai][bj][m][n]; } }
    }
};
template <int MODE> struct EpiResB {
    static constexpr bool PERM = true;
    const float* base; const bf16* xi; int ldi; bf16* xo; int ldo; float* ssp; LAS float* P;
    __device__ __forceinline__ void load_half(int ai, int row0, int col0, f32x4 (&xf)[4][2][2], u32x4 (&xb)[4][2]) const {
#pragma unroll
        for (int m = 0; m < 4; ++m) { const int row = row0 + ai * HALF + m * 16;
#pragma unroll
            for (int bj = 0; bj < 2; ++bj) {
                if (MODE == 0) { const float* p = base + (size_t)row * D + col0 + bj * HALF; xf[m][bj][0] = *(const f32x4*)p; xf[m][bj][1] = *(const f32x4*)(p + 4); }
                else xb[m][bj] = *(const u32x4*)(xi + (size_t)row * ldi + col0 + bj * HALF); } }
    }
    __device__ __forceinline__ void make_half(const f32x4 (&acc)[2][2][4][2], int ai, const f32x4 (&xf)[4][2][2], const u32x4 (&xb)[4][2], u32x4 (&w)[4][2], float (&sq)[4]) const {
#pragma unroll
        for (int m = 0; m < 4; ++m) { float q = 0.f;
#pragma unroll
            for (int bj = 0; bj < 2; ++bj) { f32x4 h0, h1;
                if (MODE == 0) { h0 = xf[m][bj][0]; h1 = xf[m][bj][1]; }
                else { const u32x4 b = xb[m][bj]; h0 = (f32x4){bf2f(b.x & 0xffffu), bf2f(b.x >> 16), bf2f(b.y & 0xffffu), bf2f(b.y >> 16)}; h1 = (f32x4){bf2f(b.z & 0xffffu), bf2f(b.z >> 16), bf2f(b.w & 0xffffu), bf2f(b.w >> 16)}; }
                h0 = h0 + acc[ai][bj][m][0]; h1 = h1 + acc[ai][bj][m][1];
                u32x4 v; v.x = pk2(h0[0], h0[1]); v.y = pk2(h0[2], h0[3]); v.z = pk2(h1[0], h1[1]); v.w = pk2(h1[2], h1[3]); w[m][bj] = v;
                const float r0 = bf2f(v.x & 0xffffu), r1 = bf2f(v.x >> 16), r2 = bf2f(v.y & 0xffffu), r3 = bf2f(v.y >> 16), r4 = bf2f(v.z & 0xffffu), r5 = bf2f(v.z >> 16), r6 = bf2f(v.w & 0xffffu), r7 = bf2f(v.w >> 16);
                q += ((r0 * r0 + r1 * r1) + (r2 * r2 + r3 * r3)) + ((r4 * r4 + r5 * r5) + (r6 * r6 + r7 * r7)); }
            q += __shfl_xor(q, 16); q += __shfl_xor(q, 32); sq[m] = q; }
    }
    __device__ __forceinline__ void store_half(int ai, int row0, int col0, int wr, int wc, int fr, int fq, const u32x4 (&w)[4][2], const float (&sq)[4]) const {
        const StoreMap sm = store_map(fr, fq); const int srow0 = row0 - fr + sm.srow, scol0 = col0 - 8 * fq + 8 * sm.sgrp;
#pragma unroll
        for (int m = 0; m < 4; ++m) { const int row = srow0 + ai * HALF + m * 16;
#pragma unroll
            for (int bj = 0; bj < 2; ++bj) *(u32x4*)(xo + (size_t)row * ldo + scol0 + bj * HALF) = perm_q(sm, w[m][bj]);
            if (fq == 0) P[(ai * HALF + wr * 64 + m * 16 + fr) * 4 + wc] = sq[m]; }
    }
    __device__ __forceinline__ void operator()(const f32x4 (&acc)[2][2][4][2], const Unit& u, int wr, int wc, int fr, int fq) const {
        const int row0 = u.orow * BM + wr * 64 + fr, col0 = u.pn * BM + wc * 32 + 8 * fq;
        f32x4 xf[4][2][2]; u32x4 xb0[4][2], xb1[4][2], w[4][2]; float sq[4];
        if (MODE == 1) { load_half(0, row0, col0, xf, xb0); load_half(1, row0, col0, xf, xb1);
            make_half(acc, 0, xf, xb0, w, sq); store_half(0, row0, col0, wr, wc, fr, fq, w, sq);
            make_half(acc, 1, xf, xb1, w, sq); store_half(1, row0, col0, wr, wc, fr, fq, w, sq); }
        else { u32x4 w1[4][2]; float sq1[4];
            load_half(0, row0, col0, xf, xb0); make_half(acc, 0, xf, xb0, w, sq);
            load_half(1, row0, col0, xf, xb0); store_half(0, row0, col0, wr, wc, fr, fq, w, sq);
            make_half(acc, 1, xf, xb0, w1, sq1); store_half(1, row0, col0, wr, wc, fr, fq, w1, sq1); }
        asm volatile("s_waitcnt lgkmcnt(0)" ::: "memory"); __builtin_amdgcn_s_barrier(); asm volatile("" ::: "memory");
        if (wr == 0) { const int r = wc * 64 + fq * 16 + fr; const f32x4 p = *(const LAS f32x4*)(P + r * 4); ssp[(size_t)(u.orow * BM + r) * 4 + u.pn] = (p[0] + p[1]) + (p[2] + p[3]); }
    }
};

template <class Epi, class Sched, bool GATHER, bool ALIGN_EPI, bool SP2, bool FP8 = false>
__device__ __forceinline__ void gemm_phase(LAS unsigned char* lds, const LAS unsigned short* rowtok, const int K, const Sched& S, const Epi& E, const int nt_unit = 0, const int lda = 0) {
    int tid = threadIdx.x; asm volatile("" : "+v"(tid));
    const int wid = __builtin_amdgcn_readfirstlane(tid >> 6), lane = tid & 63, wr = wid >> 2, wc = wid & 3, fr = lane & 15, fq = lane >> 4;
    const int KB = FP8 ? K : 2 * K;
    const int nt = nt_unit ? nt_unit : KB / (BK * 2);
    unsigned voffA[2], voffB[2]; int gR[2], gC[2];
#pragma unroll
    for (int i = 0; i < 2; ++i) { int R, C; stage_rc(tid * 16 + i * 8192, R, C); const int Rb = Epi::PERM ? ((R & ~31) + perm32(R & 31)) : R;
        voffA[i] = (unsigned)(R * (lda ? lda : KB) + C * 2); voffB[i] = (unsigned)(Rb * KB + C * 2); gR[i] = R; gC[i] = C * 2; }
    const unsigned kstep = (unsigned)(BK * 2);
    const unsigned hstep = (unsigned)(HALF * KB), hstepA = (unsigned)(HALF * (lda ? lda : KB));
    const __amdgpu_buffer_rsrc_t rA = __builtin_amdgcn_make_buffer_rsrc((void*)S.Abase, 0, 0xFFFFFFF0u, 0x00020000), rB = __builtin_amdgcn_make_buffer_rsrc((void*)S.Bbase, 0, 0xFFFFFFF0u, 0x00020000);
    const unsigned ldsw = (unsigned)wid * 1024u;
    const int aoff = lds_byte(wr * 64 + fr, fq * 8), boff = lds_byte(wc * 32 + fr, fq * 8);
    unsigned gcur[2][2], gnxt[2][2];
#define PG8_SA(b, h) (((b) * 2 + (h)) * HTB)
#define PG8_SB(b, h) ((4 + (b) * 2 + (h)) * HTB)
#define PG8_STAGE(bufoff, soff, voff) do { _Pragma("unroll") for (int _i = 0; _i < 2; ++_i) \
        __builtin_amdgcn_raw_ptr_buffer_load_lds(rB, (LAS void*)(lds + (bufoff) + ldsw + _i * 8192), 16, (voff)[_i], (soff), 0, 0); } while (0)
#define PG8_STAGE_A(bufoff, soff, h, GV) do { _Pragma("unroll") for (int _i = 0; _i < 2; ++_i) { \
        if constexpr (GATHER) __builtin_amdgcn_raw_ptr_buffer_load_lds(rA, (LAS void*)(lds + (bufoff) + ldsw + _i * 8192), 16, (GV)[h][_i], (soff), 0, 0); \
        else __builtin_amdgcn_raw_ptr_buffer_load_lds(rA, (LAS void*)(lds + (bufoff) + ldsw + _i * 8192), 16, voffA[_i], (soff) + (h) * hstepA, 0, 0); } } while (0)
#define PG8_LDA(dst, b, h) do { _Pragma("unroll") for (int m = 0; m < 4; ++m) { if constexpr (FP8) { const LAS unsigned char* _p = lds + PG8_SA(b, h) + aoff + m * 2048; \
            dst##8[m] = __builtin_shufflevector(*(const LAS i32x4*)_p, *(const LAS i32x4*)(_p + 1024), 0, 1, 2, 3, 4, 5, 6, 7); } \
        else { _Pragma("unroll") for (int k = 0; k < 2; ++k) dst[m][k] = *(const LAS bf16x8*)(lds + PG8_SA(b, h) + aoff + m * 2048 + k * 1024); } } } while (0)
#define PG8_LDB(dst, b, h) do { _Pragma("unroll") for (int n = 0; n < 2; ++n) { if constexpr (FP8) { const LAS unsigned char* _p = lds + PG8_SB(b, h) + boff + n * 2048; \
            dst##8[n] = __builtin_shufflevector(*(const LAS i32x4*)_p, *(const LAS i32x4*)(_p + 1024), 0, 1, 2, 3, 4, 5, 6, 7); } \
        else { _Pragma("unroll") for (int k = 0; k < 2; ++k) dst[n][k] = *(const LAS bf16x8*)(lds + PG8_SB(b, h) + boff + n * 2048 + k * 1024); } } } while (0)
#define PG8_MMA(ai, bj, At, Bt) do { __builtin_amdgcn_s_setprio(1); _Pragma("unroll") for (int m = 0; m < 4; ++m) _Pragma("unroll") for (int n = 0; n < 2; ++n) { \
        if constexpr (FP8) { asm volatile("v_mfma_scale_f32_16x16x128_f8f6f4 %0, %1, %2, %0, %3, %4 op_sel_hi:[0,0,0]" : "+v"(acc[ai][bj][m][n]) : "v"(Bt##8[n]), "v"(At##8[m]), "v"(scw), "v"(sc1)); } \
        else { _Pragma("unroll") for (int k = 0; k < 2; ++k) acc[ai][bj][m][n] = __builtin_amdgcn_mfma_f32_16x16x32_bf16(Bt[n][k], At[m][k], acc[ai][bj][m][n], 0, 0, 0); } } \
        __builtin_amdgcn_s_setprio(0); } while (0)
#define PG8_WAIT_V(n) asm volatile("s_waitcnt vmcnt(" #n ")" ::: "memory")
#define PG8_WAIT_L(n) asm volatile("s_waitcnt lgkmcnt(" #n ")" ::: "memory")
#define PG8_BAR __builtin_amdgcn_s_barrier()
#define PG8_SCHED __builtin_amdgcn_sched_barrier(0)
#define PG8_GLOAD(G, ord) do { if constexpr (GATHER) { _Pragma("unroll") for (int _h = 0; _h < 2; ++_h) _Pragma("unroll") for (int _i = 0; _i < 2; ++_i) \
        G[_h][_i] = (unsigned)rowtok[(ord) * 256 + _h * HALF + gR[_i]] * (unsigned)KB + (unsigned)gC[_i]; } } while (0)
    LAS int* const ucache = (LAS int*)(lds + 147456);
    if (tid < 32) { Unit u; u.pm = 0; u.pn = 0; u.orow = 0; u.ao = 0u; u.bo = 0u; const bool ok = S.next(tid, u);
        *(LAS i32x4*)(ucache + 8 * tid) = (i32x4){ok ? 1 : 0, u.pm, u.pn, u.orow}; *(LAS i32x4*)(ucache + 8 * tid + 4) = (i32x4){(int)u.ao, (int)u.bo, 0, 0}; }
    asm volatile("s_waitcnt lgkmcnt(0)" ::: "memory"); __builtin_amdgcn_s_barrier(); asm volatile("" ::: "memory");
#define PG8_NEXT(k, U) ([&]() -> bool { if ((k) >= 32) return false; const i32x4 _a = *(const LAS i32x4*)(ucache + 8 * (k)), _b = *(const LAS i32x4*)(ucache + 8 * (k) + 4); \
        (U).pm = __builtin_amdgcn_readfirstlane(_a[1]); (U).pn = __builtin_amdgcn_readfirstlane(_a[2]); (U).orow = __builtin_amdgcn_readfirstlane(_a[3]); \
        (U).ao = (unsigned)__builtin_amdgcn_readfirstlane(_b[0]); (U).bo = (unsigned)__builtin_amdgcn_readfirstlane(_b[1]); return __builtin_amdgcn_readfirstlane(_a[0]) != 0; }())
    Unit cur, nxt; int ui = 0;
    if (!PG8_NEXT(0, cur)) return;
    f32x4 acc[2][2][4][2];
#pragma unroll
    for (int a = 0; a < 2; ++a)
#pragma unroll
        for (int b = 0; b < 2; ++b)
#pragma unroll
            for (int m = 0; m < 4; ++m)
#pragma unroll
                for (int n = 0; n < 2; ++n) { acc[a][b][m][n] = (f32x4){0.f, 0.f, 0.f, 0.f}; if constexpr (FP8) asm volatile("" : "+v"(acc[a][b][m][n])); }
    bf16x8 At[4][2], B0[2][2], B1[2][2]; i32x8 At8[4], B08[2], B18[2];
    int sc1 = 0x7f7f7f7f, scw = 0x79797979; asm volatile("" : "+v"(sc1), "+v"(scw));
    unsigned cA = cur.ao, cB = cur.bo;
#pragma unroll
    for (int h = 0; h < 2; ++h)
#pragma unroll
        for (int i = 0; i < 2; ++i) { gcur[h][i] = 0u; gnxt[h][i] = 0u; }
    PG8_GLOAD(gcur, 0);
    if constexpr (SP2) {
        PG8_STAGE(PG8_SB(0, 0), cB, voffB); PG8_STAGE(PG8_SB(0, 1), cB + hstep, voffB); PG8_STAGE_A(PG8_SA(0, 0), cA, 0, gcur); PG8_STAGE_A(PG8_SA(0, 1), cA, 1, gcur);
        if (wr == 1) PG8_BAR;
        PG8_WAIT_V(2); PG8_BAR;
        PG8_STAGE(PG8_SB(1, 0), cB + kstep, voffB); PG8_STAGE_A(PG8_SA(1, 0), cA + kstep, 0, gcur); PG8_STAGE(PG8_SB(1, 1), cB + hstep + kstep, voffB);
        PG8_WAIT_V(6); PG8_BAR;
    } else {
        PG8_STAGE(PG8_SB(0, 0), cB, voffB); PG8_STAGE_A(PG8_SA(0, 0), cA, 0, gcur); PG8_STAGE(PG8_SB(0, 1), cB + hstep, voffB); PG8_STAGE_A(PG8_SA(0, 1), cA, 1, gcur);
        if (wr == 1) PG8_BAR;
        PG8_WAIT_V(4); PG8_BAR;
        PG8_STAGE(PG8_SB(1, 0), cB + kstep, voffB); PG8_STAGE_A(PG8_SA(1, 0), cA + kstep, 0, gcur); PG8_STAGE(PG8_SB(1, 1), cB + hstep + kstep, voffB);
        PG8_WAIT_V(6); PG8_BAR;
    }
    for (;;) {
        const bool has_next = PG8_NEXT(ui + 1, nxt);
        const unsigned nA = has_next ? nxt.ao : cA, nB = has_next ? nxt.bo : cB;
        const int dirc = (Sched::REVK && nt_unit == 0) ? (ui & 1) : 0, dirn = (Sched::REVK && nt_unit == 0 && has_next) ? ((ui + 1) & 1) : 0;
#pragma nounroll
        for (int t = 0; t < nt; t += 2) {
            const bool last = (t == nt - 2);
            const int kt = dirc ? nt - 2 - t : t, k2 = dirc ? kt - 2 : kt + 2, kn = dirn ? nt - 2 : 0;
            const unsigned a1 = cA + (unsigned)(kt + 1) * kstep;
            const unsigned a2 = last ? nA + (unsigned)kn * kstep : cA + (unsigned)k2 * kstep, b2 = last ? nB + (unsigned)kn * kstep : cB + (unsigned)k2 * kstep;
            const unsigned a3 = a2 + kstep, b3 = b2 + kstep;
            unsigned g2[2][2];
            if constexpr (GATHER) {
                if (last && has_next) { PG8_GLOAD(gnxt, ui + 1); }
#pragma unroll
                for (int h = 0; h < 2; ++h)
#pragma unroll
                    for (int i = 0; i < 2; ++i) g2[h][i] = (last && has_next) ? gnxt[h][i] : gcur[h][i];
            }
            if constexpr (SP2) {
            PG8_LDB(B0, 0, 0); PG8_LDB(B1, 0, 1); PG8_SCHED; PG8_LDA(At, 0, 0); PG8_STAGE_A(PG8_SA(1, 1), a1, 1, gcur);
            PG8_BAR; PG8_MMA(0, 0, At, B0); PG8_MMA(0, 1, At, B1); PG8_WAIT_V(8); PG8_BAR; PG8_SCHED;
            PG8_LDA(At, 0, 1); PG8_STAGE(PG8_SB(0, 0), b2, voffB); PG8_STAGE(PG8_SB(0, 1), b2 + hstep, voffB); PG8_STAGE_A(PG8_SA(0, 0), a2, 0, g2);
            PG8_BAR; PG8_MMA(1, 0, At, B0); PG8_MMA(1, 1, At, B1); PG8_WAIT_V(8); PG8_BAR; PG8_SCHED;
            PG8_LDB(B0, 1, 0); PG8_LDB(B1, 1, 1); PG8_SCHED; PG8_LDA(At, 1, 0); PG8_STAGE_A(PG8_SA(0, 1), a2, 1, g2);
            PG8_BAR; PG8_MMA(0, 0, At, B0); PG8_MMA(0, 1, At, B1); PG8_WAIT_V(8); PG8_BAR; PG8_SCHED;
            PG8_LDA(At, 1, 1); PG8_STAGE(PG8_SB(1, 0), b3, voffB); PG8_STAGE(PG8_SB(1, 1), b3 + hstep, voffB); PG8_STAGE_A(PG8_SA(1, 0), a3, 0, g2);
            PG8_BAR; PG8_MMA(1, 0, At, B0); PG8_MMA(1, 1, At, B1); PG8_WAIT_V(8); PG8_BAR; PG8_SCHED;
            } else {
            PG8_LDB(B0, 0, 0); PG8_SCHED; PG8_LDA(At, 0, 0); PG8_STAGE_A(PG8_SA(1, 1), a1, 1, gcur);
            PG8_WAIT_L(8); PG8_BAR; PG8_WAIT_L(0); PG8_MMA(0, 0, At, B0); PG8_BAR; PG8_SCHED;
            PG8_LDB(B1, 0, 1); PG8_STAGE(PG8_SB(0, 0), b2, voffB);
            PG8_BAR; PG8_WAIT_L(0); PG8_MMA(0, 1, At, B1); PG8_BAR;
            PG8_LDA(At, 0, 1); PG8_STAGE_A(PG8_SA(0, 0), a2, 0, g2);
            PG8_BAR; PG8_WAIT_L(0); PG8_MMA(1, 0, At, B0); PG8_BAR; PG8_SCHED;
            PG8_STAGE(PG8_SB(0, 1), b2 + hstep, voffB);
            PG8_WAIT_V(6); PG8_BAR; PG8_MMA(1, 1, At, B1); PG8_BAR;
            PG8_LDB(B0, 1, 0); PG8_SCHED; PG8_LDA(At, 1, 0); PG8_STAGE_A(PG8_SA(0, 1), a2, 1, g2);
            PG8_WAIT_L(8); PG8_BAR; PG8_WAIT_L(0); PG8_MMA(0, 0, At, B0); PG8_BAR; PG8_SCHED;
            PG8_LDB(B1, 1, 1); PG8_STAGE(PG8_SB(1, 0), b3, voffB);
            PG8_BAR; PG8_WAIT_L(0); PG8_MMA(0, 1, At, B1); PG8_BAR;
            PG8_LDA(At, 1, 1); PG8_STAGE_A(PG8_SA(1, 0), a3, 0, g2);
            PG8_BAR; PG8_WAIT_L(0); PG8_MMA(1, 0, At, B0); PG8_BAR; PG8_SCHED;
            PG8_STAGE(PG8_SB(1, 1), b3 + hstep, voffB);
            PG8_WAIT_V(6); PG8_BAR; PG8_MMA(1, 1, At, B1); PG8_BAR;
            }
        }
        if constexpr (ALIGN_EPI) { if (wr == 0) PG8_BAR; }
        if constexpr (FP8) asm volatile("s_nop 15\n\ts_nop 15" ::: "memory");
        E(acc, cur, wr, wc, fr, fq);
        if (!has_next) break;
#pragma unroll
        for (int a = 0; a < 2; ++a)
#pragma unroll
            for (int b = 0; b < 2; ++b)
#pragma unroll
                for (int m = 0; m < 4; ++m)
#pragma unroll
                    for (int n = 0; n < 2; ++n) { acc[a][b][m][n] = (f32x4){0.f, 0.f, 0.f, 0.f}; if constexpr (FP8) asm volatile("" : "+v"(acc[a][b][m][n])); }
        cur = nxt; cA = nA; cB = nB; ++ui;
        if constexpr (GATHER) {
#pragma unroll
            for (int h = 0; h < 2; ++h)
#pragma unroll
                for (int i = 0; i < 2; ++i) gcur[h][i] = gnxt[h][i];
        }
        if constexpr (ALIGN_EPI) { if (wr == 1) PG8_BAR; }
    }
    PG8_WAIT_V(0);
    if constexpr (!ALIGN_EPI) { if (wr == 0) PG8_BAR; }
    PG8_BAR;
#undef PG8_SA
#undef PG8_SB
#undef PG8_STAGE
#undef PG8_STAGE_A
#undef PG8_LDA
#undef PG8_LDB
#undef PG8_MMA
#undef PG8_WAIT_V
#undef PG8_WAIT_L
#undef PG8_BAR
#undef PG8_SCHED
#undef PG8_GLOAD
#undef PG8_NEXT
}
}

#define XB_TMO      128
#define XB_XCNT(j)  (256  + 64 * (j))
#define XB_XSUB(j)  (1280 + 64 * (j))
#define XB_XGEN(j)  (2304 + 64 * (j))
#define XB_TOP      3328
#define XB_TOPGEN   3392
#define XCD_BAR_WORDS 3456
#define XB_SPIN_CAP (1u << 22)

__device__ __forceinline__ unsigned xb_ld(unsigned* p)              { return __hip_atomic_load(p, __ATOMIC_RELAXED, __HIP_MEMORY_SCOPE_AGENT); }
__device__ __forceinline__ unsigned xb_add(unsigned* p, unsigned v) { return __hip_atomic_fetch_add(p, v, __ATOMIC_RELAXED, __HIP_MEMORY_SCOPE_AGENT); }
__device__ __forceinline__ unsigned xb_xcc_id() { return (unsigned)__builtin_amdgcn_s_getreg((3 << 11) | 20) & 0xFu; }
#define XB_SPIN(cond, bar) do { unsigned _sp = 0; while (cond) { __builtin_amdgcn_s_sleep(1); \
    if ((++_sp & 255u) == 0u) { if (xb_ld(&(bar)[XB_TMO])) break; if (_sp > XB_SPIN_CAP) { atomicAdd(&(bar)[XB_TMO], 1u); break; } } } } while (0)

struct XcdBarrier { unsigned* bar; unsigned x; volatile LAS unsigned* st; };

__device__ __forceinline__ XcdBarrier xcd_barrier_post(unsigned* bar, volatile LAS unsigned* st) {
    XcdBarrier b; b.bar = bar; b.x = xb_xcc_id(); b.st = st;
    if (threadIdx.x == 0) (void)xb_add(&bar[XB_XCNT(b.x)], 1u);
    return b;
}
__device__ __forceinline__ void xcd_barrier_complete(unsigned* bar, unsigned x, unsigned& nloc, unsigned& nx) {
    const unsigned G = gridDim.x * gridDim.y * gridDim.z;
    unsigned sum, cnt, mine, sp = 0u;
    for (;;) {
        sum = 0u; cnt = 0u; mine = 0u;
#pragma unroll
        for (unsigned j = 0; j < 16; ++j) { const unsigned c = xb_ld(&bar[XB_XCNT(j)]); sum += c; cnt += (c > 0u) ? 1u : 0u; mine = (j == x) ? c : mine; }
        if (sum == G) break;
        __builtin_amdgcn_s_sleep(1);
        if ((++sp & 255u) == 0u) { if (xb_ld(&bar[XB_TMO])) break; if (sp > XB_SPIN_CAP) { atomicAdd(&bar[XB_TMO], 1u); break; } }
    }
    nloc = mine > 0u ? mine : 1u; nx = cnt > 0u ? cnt : 1u;
}
__device__ __forceinline__ void xcd_barrier(const XcdBarrier& b) {
    asm volatile("s_waitcnt vmcnt(0)" ::: "memory");
    __syncthreads();
    if (threadIdx.x == 0) {
        unsigned* bar = b.bar;
        __builtin_amdgcn_s_waitcnt(0);
        unsigned nloc = b.st[0], nx = b.st[1];
        if (nloc == 0u) { xcd_barrier_complete(bar, b.x, nloc, nx); b.st[0] = nloc; b.st[1] = nx; }
        const unsigned old = xb_add(&bar[XB_XSUB(b.x)], 1u);
        const unsigned gen = old / nloc;
        if (old + 1u == (gen + 1u) * nloc) {
            __builtin_amdgcn_fence(__ATOMIC_RELEASE, "agent");
            asm volatile("s_waitcnt vmcnt(0)" ::: "memory");
            const unsigned og = xb_add(&bar[XB_TOP], 1u);
            const unsigned tg = og / nx;
            if (og + 1u == (tg + 1u) * nx) xb_add(&bar[XB_TOPGEN], 1u);
            else XB_SPIN(xb_ld(&bar[XB_TOPGEN]) == tg, bar);
            __builtin_amdgcn_fence(__ATOMIC_ACQUIRE, "agent");
            asm volatile("s_waitcnt vmcnt(0)" ::: "memory");
        } else {
            XB_SPIN(xb_ld(&bar[XB_TOPGEN]) == gen, bar);
            __builtin_amdgcn_fence(__ATOMIC_ACQUIRE, "agent");
            asm volatile("s_waitcnt vmcnt(0)" ::: "memory");
        }
    }
    __syncthreads();
}

struct Args { const float* in[27]; float* out; unsigned char* ws; };
enum { I_X = 0, I_E_NORM_MIX, I_E_W_IN, I_E_RET_GN, I_E_DW_W, I_E_DW_B, I_E_CV_LN_G, I_E_CV_LN_B, I_E_W_OUT, I_E_NORM_FFN, I_E_FFN_GATE, I_E_FFN_UP, I_E_FFN_DOWN,
       I_O_NORM_MIX, I_O_W_IN, I_O_SG_LN_G, I_O_SG_LN_B, I_O_SG_W, I_O_SG_B, I_O_SC_W, I_O_W_OUT, I_O_NORM_FFN, I_O_ROUTER, I_O_EXP_GATE, I_O_EXP_UP, I_O_EXP_DOWN, I_FINAL_NORM };

struct Frame {
    LAS unsigned char* lds;
    int tid, lane, wave, vcu, G;
};
__device__ __forceinline__ void refresh(Frame& F) { int t = threadIdx.x; asm volatile("" : "+v"(t)); F.tid = t; F.lane = t & 63; F.wave = __builtin_amdgcn_readfirstlane(t >> 6); }
struct PT {
    volatile LAS unsigned* tab;
    __device__ __forceinline__ const void* p(int i) const { const unsigned lo = __builtin_amdgcn_readfirstlane(tab[2 * i]), hi = __builtin_amdgcn_readfirstlane(tab[2 * i + 1]); return (const void*)(const GAS char*)(((unsigned long long)hi << 32) | lo); }
    __device__ __forceinline__ const float* in(int i) const { return (const float*)p(i); }
};

struct CvtItem { const float* src; int N; unsigned char* dst; int Kb; int f8; int perm; int goff; float scale; };
__device__ __forceinline__ void cvt_make(CvtItem& d, const float* W, const float* W2, int K, int N, int mode, unsigned char* WT, int f8, int item, int gsel = -1) {
    const int nout = (mode == 2) ? 2 * N : N, KT = 128;
    const int nblk = nout / 128, kb = item / nblk, nb = item % nblk, k0 = KT * kb, n0 = 128 * nb;
    const float* src = W; int col0 = n0;
    d.scale = 1.0f;
    if (mode == 2) { src = (nb & 1) ? W2 : W; col0 = 128 * (nb >> 1); d.scale = (nb & 1) ? -0.6931471805599453f : -1.4426950408889634f; }
    d.src = src + (size_t)k0 * N + col0; d.N = N; d.f8 = f8; d.Kb = f8 ? K : 2 * K; d.perm = (mode == 1 && n0 < 1024) ? 1 : 0;
    d.dst = WT + (size_t)n0 * d.Kb + (size_t)k0 * (f8 ? 1 : 2); d.goff = gsel >= 0 ? gsel * 1024 + k0 : -1;
}
struct CvtPtrs { const float *ein, *eout, *fg, *fu, *fd, *oin, *oout, *xg, *xu, *xd, *g_ffn, *g_omix; };
constexpr int CV_I0 = (D / 128) * (EVEN_IN / 128), CV_I1 = (D / 128) * (D / 128), CV_I2 = (D / 128) * (2 * DFF / 128), CV_I3 = (DFF / 128) * (D / 128), CV_I4 = (D / 128) * (ODD_IN / 128), CV_I5 = CV_I1;
constexpr int CV_SMALL = CV_I0 + CV_I1 + CV_I2 + CV_I3 + CV_I4 + CV_I5;
constexpr int CV_IG = (D / 128) * (2 * DEXP / 128), CV_ID = (DEXP / 128) * (D / 128), CV_IE = CV_IG + CV_ID;
constexpr int CV_TOTAL = CV_SMALL + NEXP * CV_IE;
__device__ __forceinline__ void cvt_decode(CvtItem& d, const CvtPtrs& P, unsigned char* ws, int it) {
    int r = it;
    if (r < NEXP * CV_IE) {
        const int e = r / CV_IE; r -= e * CV_IE;
        if (r < CV_IG) cvt_make(d, P.xg + (size_t)e * D * DEXP, P.xu + (size_t)e * D * DEXP, D, DEXP, 2, ws + WS_WGU8 + (size_t)e * EXP_GU_BYTES, 1, r);
        else cvt_make(d, P.xd + (size_t)e * DEXP * D, nullptr, DEXP, D, 0, ws + WS_WDN8 + (size_t)e * EXP_DN_BYTES, 1, r - CV_IG);
        return; }
    r -= NEXP * CV_IE;
    if (r < CV_I0) { cvt_make(d, P.ein, nullptr, D, EVEN_IN, 1, ws + WS_W_EIN, 0, r); return; } r -= CV_I0;
    if (r < CV_I1) { cvt_make(d, P.eout, nullptr, D, D, 0, ws + WS_W_EOUT, 0, r); return; } r -= CV_I1;
    if (r < CV_I2) { cvt_make(d, P.fg, P.fu, D, DFF, 2, ws + WS_W_FGU, 0, r, 0); return; } r -= CV_I2;
    if (r < CV_I3) { cvt_make(d, P.fd, nullptr, DFF, D, 0, ws + WS_W_FDN, 0, r); return; } r -= CV_I3;
    if (r < CV_I4) { cvt_make(d, P.oin, nullptr, D, ODD_IN, 0, ws + WS_W_OIN, 0, r, 1); return; } r -= CV_I4;
    cvt_make(d, P.oout, nullptr, D, D, 0, ws + WS_W_OOUT, 0, r);
}
constexpr int CV_LD = 132;
constexpr int CV_GT = 69632;
__device__ __forceinline__ void cvt_load(const CvtItem& d, f32x4 (&v)[8], int tid) {
    const int c4 = tid & 31, kr = tid >> 5;
#pragma unroll
    for (int i = 0; i < 8; ++i) v[i] = __builtin_nontemporal_load((const f32x4*)(d.src + (size_t)(kr + 16 * i) * d.N + 4 * c4));
}
__device__ __forceinline__ void cvt_store(const CvtItem& d, const f32x4 (&v)[8], LAS float* tile, const LAS float* gt, int tid) {
    const int c4 = tid & 31, kr = tid >> 5;
#pragma unroll
    for (int i = 0; i < 8; ++i) { const float g = (d.goff >= 0 ? gt[d.goff + kr + 16 * i] : 1.0f) * d.scale; *(LAS f32x4*)(tile + (kr + 16 * i) * CV_LD + 4 * c4) = v[i] * g; }
    WG_SYNC();
    const int nl = tid & 127, q = tid >> 7; const int c = d.perm ? ((nl >> 1) + 64 * (nl & 1)) : nl;
    if (d.f8) { const LAS float* s = tile + (32 * q) * CV_LD + c; u32x4 o0, o1;
#pragma unroll
        for (int j = 0; j < 4; ++j) { o0[j] = pk4_fp8(s[(4 * j) * CV_LD] * W8_SCALE, s[(4 * j + 1) * CV_LD] * W8_SCALE, s[(4 * j + 2) * CV_LD] * W8_SCALE, s[(4 * j + 3) * CV_LD] * W8_SCALE);
            o1[j] = pk4_fp8(s[(16 + 4 * j) * CV_LD] * W8_SCALE, s[(16 + 4 * j + 1) * CV_LD] * W8_SCALE, s[(16 + 4 * j + 2) * CV_LD] * W8_SCALE, s[(16 + 4 * j + 3) * CV_LD] * W8_SCALE); }
        unsigned char* o = d.dst + (size_t)nl * d.Kb + 32 * q; *(u32x4*)o = o0; *(u32x4*)(o + 16) = o1; }
    else { const LAS float* s = tile + (32 * q) * CV_LD + c; unsigned char* o = d.dst + (size_t)nl * d.Kb + 64 * q;
#pragma unroll
        for (int h = 0; h < 4; ++h) {
            u32x4 w; w.x = pk2(s[(8 * h) * CV_LD], s[(8 * h + 1) * CV_LD]); w.y = pk2(s[(8 * h + 2) * CV_LD], s[(8 * h + 3) * CV_LD]);
            w.z = pk2(s[(8 * h + 4) * CV_LD], s[(8 * h + 5) * CV_LD]); w.w = pk2(s[(8 * h + 6) * CV_LD], s[(8 * h + 7) * CV_LD]);
            *(u32x4*)(o + 16 * h) = w; } }
    WG_SYNC();
}
__device__ __forceinline__ void sincos_d(double a, float& s, float& c) {
    const double k = __builtin_rint(a * 0.63661977236758134308);
    double r = __builtin_fma(-k, 1.57079632679489655800e+00, a); r = __builtin_fma(-k, 6.12323399573676603587e-17, r);
    const double r2 = r * r;
    double sp = 1.0 / 6227020800.0; sp = sp * r2 - 1.0 / 39916800.0; sp = sp * r2 + 1.0 / 362880.0; sp = sp * r2 - 1.0 / 5040.0; sp = sp * r2 + 1.0 / 120.0; sp = sp * r2 - 1.0 / 6.0; sp = sp * r2 + 1.0; sp = sp * r;
    double cp = 1.0 / 87178291200.0; cp = cp * r2 - 1.0 / 479001600.0; cp = cp * r2 + 1.0 / 3628800.0; cp = cp * r2 - 1.0 / 40320.0; cp = cp * r2 + 1.0 / 720.0; cp = cp * r2 - 1.0 / 24.0; cp = cp * r2 + 0.5; cp = 1.0 - cp * r2;
    const int q = (int)((long long)k & 3);
    const double ss = (q == 0) ? sp : (q == 1) ? cp : (q == 2) ? -sp : -cp;
    const double cc = (q == 0) ? cp : (q == 1) ? -sp : (q == 2) ? -cp : sp;
    s = (float)ss; c = (float)cc;
}

struct RopeJob { double f; int gt, NGT, done; };
__device__ __forceinline__ void rope_init(RopeJob& r, const Frame& F) { r.gt = F.vcu * NTHR + F.tid; r.NGT = F.G * NTHR; r.done = 0;
    double f = 1.0; const int i = r.gt & 63; for (int j = 0; j < i; ++j) f *= 0.8659643233600653; r.f = f; }
__device__ __forceinline__ void rope_step(RopeJob& r, unsigned char* ws) {
    const int idx = r.gt + r.done * r.NGT; ++r.done; if (idx >= SEQ * 64) return;
    float* rc = (float*)(ws + WS_ROPE); float* rs = rc + (size_t)SEQ * 64;
    float s, c; sincos_d((double)(idx >> 6) * r.f, s, c); rc[idx] = c; rs[idx] = s; }
__device__ __forceinline__ void misc_tables(Frame& F, const PT& a, unsigned char* ws, RopeJob& rj) {
    const int gt = F.vcu * NTHR + F.tid, NGT = F.G * NTHR;
    while (rj.gt + rj.done * rj.NGT < SEQ * 64) rope_step(rj, ws);
    bf16* sg = (bf16*)(ws + WS_SGW); const float* sw = a.in(I_O_SG_W);
    for (int idx = gt; idx < 4 * 128 * 128; idx += NGT) { const int p = (idx >> 7) & 127, q = idx & 127; sg[idx] = (bf16)f2bf(((p >> 6) >= (q >> 6)) ? sw[idx] : 0.0f); }
}

__device__ __forceinline__ void convert_weights(Frame& F, const PT& a, unsigned char* ws, int it0, int it1, RopeJob& rj) {
    LAS float* tile = (LAS float*)F.lds; LAS float* gt = (LAS float*)(F.lds + CV_GT);
    CvtPtrs P; P.ein = a.in(I_E_W_IN); P.eout = a.in(I_E_W_OUT); P.fg = a.in(I_E_FFN_GATE); P.fu = a.in(I_E_FFN_UP); P.fd = a.in(I_E_FFN_DOWN); P.oin = a.in(I_O_W_IN); P.oout = a.in(I_O_W_OUT);
    P.xg = a.in(I_O_EXP_GATE); P.xu = a.in(I_O_EXP_UP); P.xd = a.in(I_O_EXP_DOWN); P.g_ffn = a.in(I_E_NORM_FFN); P.g_omix = a.in(I_O_NORM_MIX);
    for (int i = F.tid; i < 2048; i += NTHR) gt[i] = (i < 1024) ? P.g_ffn[i] : P.g_omix[i - 1024];
    __syncthreads();
    const int per = (it1 - it0 + F.G - 1) / F.G; const int itb = it0 + F.vcu * per; const int ite = (itb + per < it1) ? itb + per : it1; const int last = ite - 1;
    if (itb >= ite) return;
#define CV_MIN(a, b) ((a) < (b) ? (a) : (b))
    CvtItem dA0, dA1, dB0, dB1; f32x4 vA0[8], vA1[8], vB0[8], vB1[8];
#define CV_LOAD2(d0, d1, v0, v1, k) do { cvt_decode(d0, P, ws, CV_MIN((k), last)); cvt_decode(d1, P, ws, CV_MIN((k) + 1, last)); cvt_load(d0, v0, F.tid); cvt_load(d1, v1, F.tid); } while (0)
#define CV_STORE2(d0, d1, v0, v1, k) do { cvt_store(d0, v0, tile, gt, F.tid); if ((k) + 1 < ite) cvt_store(d1, v1, tile, gt, F.tid); } while (0)
    CV_LOAD2(dA0, dA1, vA0, vA1, itb);
    for (int k = itb;; k += 4) {
        CV_LOAD2(dB0, dB1, vB0, vB1, k + 2);
        rope_step(rj, ws);
        CV_STORE2(dA0, dA1, vA0, vA1, k);
        if (k + 2 >= ite) break;
        CV_LOAD2(dA0, dA1, vA0, vA1, k + 4);
        rope_step(rj, ws);
        CV_STORE2(dB0, dB1, vB0, vB1, k + 2);
        if (k + 4 >= ite) break;
    }
#undef CV_MIN
#undef CV_LOAD2
#undef CV_STORE2
}
__device__ __forceinline__ void rms_row_to_bf16(const float* xrow, const float* gain, bf16* orow, int lane) {
    const f32x4* xr = (const f32x4*)xrow + lane; const f32x4* gr = (const f32x4*)gain + lane;
    f32x4 v[4]; float s = 0.f;
#pragma unroll
    for (int j = 0; j < 4; ++j) { v[j] = xr[64 * j]; s += (v[j][0] * v[j][0] + v[j][1] * v[j][1]) + (v[j][2] * v[j][2] + v[j][3] * v[j][3]); }
    const float r = 1.0f / sqrtf(wave_sum(s) * (1.f / D) + EPS);
    unsigned long long* o8 = (unsigned long long*)orow + lane;
#pragma unroll
    for (int j = 0; j < 4; ++j) { const f32x4 g = gr[64 * j];
        o8[64 * j] = (unsigned long long)pk2(v[j][0] * r * g[0], v[j][1] * r * g[1]) | ((unsigned long long)pk2(v[j][2] * r * g[2], v[j][3] * r * g[3]) << 32); }
}
__device__ __forceinline__ void norm_phase(Frame& F, const float* x, const float* gain, bf16* XN) {
    const int gw = F.vcu * NWAVES + F.wave, NGW = F.G * NWAVES;
    const f32x4* gr = (const f32x4*)gain + F.lane; f32x4 g[4];
#pragma unroll
    for (int j = 0; j < 4; ++j) g[j] = gr[64 * j];
    for (int m0 = gw; m0 < T; m0 += 4 * NGW) {
        f32x4 v[4][4];
#pragma unroll
        for (int k = 0; k < 4; ++k) { const int m = (m0 + k * NGW < T) ? m0 + k * NGW : m0; const f32x4* xr = (const f32x4*)(x + (size_t)m * D) + F.lane;
#pragma unroll
            for (int j = 0; j < 4; ++j) v[k][j] = xr[64 * j]; }
#pragma unroll
        for (int k = 0; k < 4; ++k) { if (m0 + k * NGW >= T) break; float s = 0.f;
#pragma unroll
            for (int j = 0; j < 4; ++j) s += (v[k][j][0] * v[k][j][0] + v[k][j][1] * v[k][j][1]) + (v[k][j][2] * v[k][j][2] + v[k][j][3] * v[k][j][3]);
            const float r = 1.0f / sqrtf(wave_sum(s) * (1.f / D) + EPS);
            unsigned long long* o8 = (unsigned long long*)(XN + (size_t)(m0 + k * NGW) * D) + F.lane;
#pragma unroll
            for (int j = 0; j < 4; ++j) o8[64 * j] = (unsigned long long)pk2(v[k][j][0] * r * g[j][0], v[k][j][1] * r * g[j][1]) | ((unsigned long long)pk2(v[k][j][2] * r * g[j][2], v[k][j][3] * r * g[j][3]) << 32); }
    }
}
__device__ __forceinline__ bf16x8 frag_row(const LAS unsigned char* base, int ldb, int row0, int k0, int lane) {
    return *(const LAS bf16x8*)(base + (row0 + (lane & 15)) * ldb + (k0 + 8 * (lane >> 4)) * 2);
}
__device__ __forceinline__ bf16x8 frag_tr(const LAS unsigned char* base, int ldb, int k0, int n0, int lane) {
    const int g = lane >> 4, q = (lane & 15) >> 2, p = lane & 3;
    const LAS unsigned char* a0 = base + (k0 + 8 * g + q) * ldb + (n0 + 4 * p) * 2;
    const s16x4 lo = __builtin_amdgcn_ds_read_tr16_b64_v4i16((LAS s16x4*)a0);
    const s16x4 hi = __builtin_amdgcn_ds_read_tr16_b64_v4i16((LAS s16x4*)(a0 + 4 * ldb));
    return (bf16x8){lo[0], lo[1], lo[2], lo[3], hi[0], hi[1], hi[2], hi[3]};
}
__device__ __forceinline__ f32x4 mma16(bf16x8 a, bf16x8 b, f32x4 c) { return __builtin_amdgcn_mfma_f32_16x16x32_bf16(a, b, c, 0, 0, 0); }

constexpr int RT_LDQ = 272, RT_LDP = 144, RT_LDO = 528;
constexpr int RT_QS = 0, RT_KS = 17408, RT_KD = 34816, RT_VS = 52224, RT_PS = 69632, RT_SB = 78848, RT_OS = 113664, RT_PW = 147456;
template <bool MAIN>
__device__ __forceinline__ void ret_unit(Frame& F, const PT& a, unsigned char* ws, int unit) {
    const int b = unit >> 7, h = (unit >> 5) & 3, sc = unit & 31;
    const int tid = F.tid, lane = F.lane, w = F.wave;
    const float* p_gn = MAIN ? a.in(I_E_RET_GN) : nullptr;
    const bf16* Z = (const bf16*)(ws + WS_Z);
    LAS unsigned char* L = F.lds;
    LAS float* pw = (LAS float*)(L + RT_PW);
    if (tid <= 64) { const double g = 1.0 - 1.0 / (double)(32 << h); double p = 1.0; for (int j = 0; j < tid; ++j) p *= g; pw[tid] = (float)p; }
    f32x4 st[8];
    if (MAIN) { const f32x4* sp = (const f32x4*)(ws + WS_RETS) + (size_t)unit * 4096;
#pragma unroll
        for (int td = 0; td < 8; ++td) st[td] = sp[(w * 8 + td) * 64 + lane];
    } else {
#pragma unroll
        for (int td = 0; td < 8; ++td) st[td] = (f32x4){0.f, 0.f, 0.f, 0.f};
    }
    WG_SYNC();
    const float c64 = pw[64];
    const int q4 = lane >> 4, r16 = lane & 15;
    if (MAIN) {
#pragma unroll
        for (int td = 0; td < 8; ++td)
#pragma unroll
            for (int jj = 0; jj < 4; ++jj) *(LAS bf16*)(L + RT_SB + (16 * w + 4 * q4 + jj) * RT_LDQ + (16 * td + r16) * 2) = (bf16)f2bf(st[td][jj]);
    }
    const int lrow = tid >> 3, lseg = tid & 7;
    struct RowBuf { u32x4 k0, k1, v0, v1, q0, q1, g0, g1; };
    RowBuf bufA, bufB; bufA.q0 = bufA.q1 = bufA.g0 = bufA.g1 = bufB.q0 = bufB.q1 = bufB.g0 = bufB.g1 = (u32x4){0u, 0u, 0u, 0u};
    f32x4 gnv[4];
    if (MAIN) {
#pragma unroll
        for (int j = 0; j < 4; ++j) gnv[j] = *(const f32x4*)(p_gn + 128 * h + 16 * (tid & 7) + 4 * j); }
#define RT_LOAD(B_, cc_) do { const bf16* _zr = Z + (size_t)(b * SEQ + (sc * 8 + (cc_)) * 64 + lrow) * EVEN_IN + 128 * h + 16 * lseg; \
        (B_).k0 = *(const u32x4*)(_zr + 512); (B_).k1 = *(const u32x4*)(_zr + 512 + 8); (B_).v0 = *(const u32x4*)(_zr + 1024); (B_).v1 = *(const u32x4*)(_zr + 1024 + 8); \
        if (MAIN) { (B_).q0 = *(const u32x4*)_zr; (B_).q1 = *(const u32x4*)(_zr + 8); (B_).g0 = *(const u32x4*)(_zr + 1536); (B_).g1 = *(const u32x4*)(_zr + 1536 + 8); } } while (0)
    RT_LOAD(bufA, 0); RT_LOAD(bufB, 1);
    auto one_chunk = [&](RowBuf& nb, const int cc) __attribute__((always_inline)) {
        const int t0 = b * SEQ + (sc * 8 + cc) * 64;
        const u32x4 gz0 = nb.g0, gz1 = nb.g1;
        { const u32x4 k0 = nb.k0, k1 = nb.k1, v0 = nb.v0, v1 = nb.v1, q0 = nb.q0, q1 = nb.q1;
          RT_LOAD(nb, cc < 6 ? cc + 2 : cc);
          LAS unsigned char* dst = L + lrow * RT_LDQ + 32 * lseg;
          *(LAS u32x4*)(dst + RT_VS) = v0; *(LAS u32x4*)(dst + RT_VS + 16) = v1;
          if (MAIN) { *(LAS u32x4*)(dst + RT_QS) = q0; *(LAS u32x4*)(dst + RT_QS + 16) = q1;
                      *(LAS u32x4*)(dst + RT_KS) = k0; *(LAS u32x4*)(dst + RT_KS + 16) = k1; }
          const float kd = pw[63 - lrow]; u32x4 d0, d1;
#pragma unroll
          for (int j = 0; j < 4; ++j) { d0[j] = pk2(bf2f(k0[j] & 0xffffu) * kd, bf2f(k0[j] >> 16) * kd); d1[j] = pk2(bf2f(k1[j] & 0xffffu) * kd, bf2f(k1[j] >> 16) * kd); }
          *(LAS u32x4*)(dst + RT_KD) = d0; *(LAS u32x4*)(dst + RT_KD + 16) = d1; }
        WG_SYNC();
        f32x4 oacc[4];
        const int ti = w >> 1, te0 = 4 * (w & 1);
        if (MAIN) {
            bf16x8 qa[4], kb[2][4];
#pragma unroll
            for (int ks = 0; ks < 4; ++ks) { qa[ks] = frag_row(L + RT_QS, RT_LDQ, 16 * ti, 32 * ks, lane);
#pragma unroll
                for (int x = 0; x < 2; ++x) kb[x][ks] = frag_row(L + RT_KS, RT_LDQ, 16 * (2 * (w & 1) + x), 32 * ks, lane); }
            __builtin_amdgcn_sched_barrier(0);
#pragma unroll
            for (int x = 0; x < 2; ++x) { const int tj = 2 * (w & 1) + x; f32x4 p = {0.f, 0.f, 0.f, 0.f};
#pragma unroll
                for (int ks = 0; ks < 4; ++ks) p = mma16(qa[ks], kb[x][ks], p);
#pragma unroll
                for (int jj = 0; jj < 4; ++jj) { const int i = 16 * ti + 4 * q4 + jj, j = 16 * tj + r16; const int dd = i > j ? i - j : j - i;
                    *(LAS bf16*)(L + RT_PS + i * RT_LDP + j * 2) = (bf16)f2bf(p[jj] * pw[dd]); } }
#pragma unroll
            for (int x = 0; x < 4; ++x) oacc[x] = (f32x4){0.f, 0.f, 0.f, 0.f};
#pragma unroll
            for (int kh = 0; kh < 2; ++kh) { bf16x8 sbf[2][4];
#pragma unroll
              for (int ks = 0; ks < 2; ++ks)
#pragma unroll
                  for (int x = 0; x < 4; ++x) sbf[ks][x] = frag_row(L + RT_SB, RT_LDQ, 16 * (te0 + x), 32 * (2 * kh + ks), lane);
              __builtin_amdgcn_sched_barrier(0);
#pragma unroll
              for (int ks = 0; ks < 2; ++ks)
#pragma unroll
                  for (int x = 0; x < 4; ++x) oacc[x] = mma16(qa[2 * kh + ks], sbf[ks][x], oacc[x]); }
#pragma unroll
            for (int x = 0; x < 4; ++x)
#pragma unroll
                for (int jj = 0; jj < 4; ++jj) oacc[x][jj] *= pw[16 * ti + 4 * q4 + jj + 1];
            WG_SYNC();
            { bf16x8 pa[2], vb[2][4];
#pragma unroll
              for (int ks = 0; ks < 2; ++ks) { pa[ks] = frag_row(L + RT_PS, RT_LDP, 16 * ti, 32 * ks, lane);
#pragma unroll
                  for (int x = 0; x < 4; ++x) vb[ks][x] = frag_tr(L + RT_VS, RT_LDQ, 32 * ks, 16 * (te0 + x), lane); }
              __builtin_amdgcn_sched_barrier(0);
#pragma unroll
              for (int ks = 0; ks < 2; ++ks)
#pragma unroll
                  for (int x = 0; x < 4; ++x) oacc[x] = mma16(pa[ks], vb[ks][x], oacc[x]); }
#pragma unroll
            for (int x = 0; x < 4; ++x)
#pragma unroll
                for (int jj = 0; jj < 4; ++jj) *(LAS float*)(L + RT_OS + (16 * ti + 4 * q4 + jj) * RT_LDO + (16 * (te0 + x) + r16) * 4) = oacc[x][jj];
        }
#pragma unroll
        for (int td = 0; td < 8; ++td) st[td] = st[td] * c64;
#pragma unroll
        for (int ks = 0; ks < 2; ++ks) { bf16x8 kd[8]; const bf16x8 va = frag_tr(L + RT_VS, RT_LDQ, 32 * ks, 16 * w, lane);
#pragma unroll
          for (int td = 0; td < 8; ++td) kd[td] = frag_tr(L + RT_KD, RT_LDQ, 32 * ks, 16 * td, lane);
          __builtin_amdgcn_sched_barrier(0);
#pragma unroll
          for (int td = 0; td < 8; ++td) st[td] = mma16(va, kd[td], st[td]); }
        WG_SYNC();
        if (MAIN) {
#pragma unroll
            for (int td = 0; td < 8; ++td)
#pragma unroll
                for (int jj = 0; jj < 4; ++jj) *(LAS bf16*)(L + RT_SB + (16 * w + 4 * q4 + jj) * RT_LDQ + (16 * td + r16) * 2) = (bf16)f2bf(st[td][jj]);
            const int i = lrow, e0 = 16 * lseg;
            f32x4 ov[4]; float s = 0.f;
#pragma unroll
            for (int j = 0; j < 4; ++j) { ov[j] = *(const LAS f32x4*)(L + RT_OS + i * RT_LDO + (e0 + 4 * j) * 4); s += (ov[j][0] + ov[j][1]) + (ov[j][2] + ov[j][3]); }
            s = sum8(s);
            const float mu = s * (1.f / 128.f); float q = 0.f;
#pragma unroll
            for (int j = 0; j < 4; ++j) { ov[j] = ov[j] - mu; q += (ov[j][0] * ov[j][0] + ov[j][1] * ov[j][1]) + (ov[j][2] * ov[j][2] + ov[j][3] * ov[j][3]); }
            q = sum8(q);
            const float rstd = 1.0f / sqrtf(q * (1.f / 128.f) + EPS);
            const u32x4 g0 = gz0, g1 = gz1;
            float y[16];
#pragma unroll
            for (int j = 0; j < 4; ++j) { const f32x4 gg = gnv[j];
#pragma unroll
                for (int k = 0; k < 4; ++k) { const int idx = 4 * j + k; const unsigned gw = (idx < 8) ? g0[idx >> 1] : g1[(idx - 8) >> 1]; const float gv = bf2f((idx & 1) ? (gw >> 16) : (gw & 0xffffu));
                    y[idx] = silu_f(gv) * (ov[j][k] * rstd * gg[k]); } }
            u32x4 o0, o1;
#pragma unroll
            for (int j = 0; j < 4; ++j) { o0[j] = pk2(y[2 * j], y[2 * j + 1]); o1[j] = pk2(y[8 + 2 * j], y[8 + 2 * j + 1]); }
            bf16* yp = (bf16*)(ws + WS_Y) + (size_t)(t0 + i) * D + 128 * h + e0;
            *(u32x4*)yp = o0; *(u32x4*)(yp + 8) = o1;
        }
    };
    for (int cc = 0; cc < 8; cc += 2) { one_chunk(bufA, cc); one_chunk(bufB, cc + 1); }
#undef RT_LOAD
    if (!MAIN) { f32x4* lp = (f32x4*)(ws + WS_RETL) + (size_t)unit * 4096;
#pragma unroll
        for (int td = 0; td < 8; ++td) lp[(w * 8 + td) * 64 + lane] = st[td]; }
    WG_SYNC();
}
__device__ __forceinline__ void ret_scan(Frame& F, unsigned char* ws) {
    const float* Lb = (const float*)(ws + WS_RETL); float* Sb = (float*)(ws + WS_RETS);
    const int gt = F.vcu * NTHR + F.tid, NGT = F.G * NTHR;
    for (int idx = gt; idx < 8 * 16384; idx += NGT) { const int bh = idx >> 14, el = idx & 16383, h = bh & 3;
        const double g = 1.0 - 1.0 / (double)(32 << h); double p = g; for (int j = 0; j < 9; ++j) p *= p;
        const float c8 = (float)p; float run = 0.f;
        float lv[32];
#pragma unroll
        for (int s = 0; s < 32; ++s) lv[s] = Lb[((size_t)(bh * 32 + s) << 14) + el];
#pragma unroll
        for (int s = 0; s < 32; ++s) { Sb[((size_t)(bh * 32 + s) << 14) + el] = run; run = c8 * run + lv[s]; } }
}

__device__ __forceinline__ void unpack8(const u32x4 r, float (&v)[8]) {
#pragma unroll
    for (int j = 0; j < 4; ++j) { v[2 * j] = bf2f(r[j] & 0xffffu); v[2 * j + 1] = bf2f(r[j] >> 16); } }
__device__ __forceinline__ u32x4 pack8(const float (&v)[8]) { u32x4 o; o.x = pk2(v[0], v[1]); o.y = pk2(v[2], v[3]); o.z = pk2(v[4], v[5]); o.w = pk2(v[6], v[7]); return o; }
__device__ __forceinline__ void conv_unit(Frame& F, const PT& a, unsigned char* ws, int unit) {
    const int b = unit >> 7, s0 = (unit & 127) * 128, ch = F.tid, tid = F.tid;
    const bf16* Z = (const bf16*)(ws + WS_Z); bf16* Y = (bf16*)(ws + WS_Y);
    LAS float* cv = (LAS float*)F.lds;
    LAS bf16* ct = (LAS bf16*)(F.lds + 65536);
    const float* p_dw = a.in(I_E_DW_W); const float* p_lg = a.in(I_E_CV_LN_G); const float* p_lb = a.in(I_E_CV_LN_B);
    float wk[31];
#pragma unroll
    for (int k = 0; k < 31; ++k) wk[k] = p_dw[k * 512 + ch];
    const float bias = a.in(I_E_DW_B)[ch];
    const int ltok = tid >> 4, lseg = tid & 15;
    u32x4 ra[4], rb[4];
#define CV_LOAD(sfirst) do { const int _s = (sfirst) + ltok; const bf16* _zr = Z + (size_t)(b * SEQ + (_s >= 0 ? _s : 0)) * EVEN_IN + 2048 + 32 * lseg; \
        _Pragma("unroll") for (int j = 0; j < 4; ++j) { ra[j] = *(const u32x4*)(_zr + 8 * j); rb[j] = *(const u32x4*)(_zr + 512 + 8 * j); } } while (0)
#define CV_GLU_TO_LDS() do { _Pragma("unroll") for (int j = 0; j < 4; ++j) { float av[8], bv[8]; unpack8(ra[j], av); unpack8(rb[j], bv); \
        _Pragma("unroll") for (int k = 0; k < 8; ++k) av[k] = av[k] * fast_sigmoid(bv[k]); \
        *(LAS u32x4*)(ct + ltok * 512 + 32 * lseg + 8 * j) = pack8(av); } } while (0)
    float c[62];
    const f32x4 g0 = *(const f32x4*)(p_lg + 8 * F.lane), g1 = *(const f32x4*)(p_lg + 8 * F.lane + 4);
    const f32x4 b0 = *(const f32x4*)(p_lb + 8 * F.lane), b1 = *(const f32x4*)(p_lb + 8 * F.lane + 4);
    CV_LOAD(s0 - 32);
    if (s0 - 32 + ltok < 0) {
#pragma unroll
        for (int j = 0; j < 4; ++j) ra[j] = (u32x4){0u, 0u, 0u, 0u}; }
    CV_GLU_TO_LDS();
    CV_LOAD(s0);
    WG_SYNC();
#pragma unroll
    for (int j = 0; j < 30; ++j) c[j] = bf2f(ct[(j + 2) * 512 + ch]);
    WG_SYNC();
    for (int p = 0; p < 4; ++p) {
        CV_GLU_TO_LDS();
        CV_LOAD(s0 + 32 * (p < 3 ? p + 1 : p));
        WG_SYNC();
#pragma unroll
        for (int j = 0; j < 32; ++j) c[30 + j] = bf2f(ct[j * 512 + ch]);
        float o[32];
#pragma unroll
        for (int i = 0; i < 32; ++i) { float acc = bias;
#pragma unroll
            for (int k = 0; k < 31; ++k) acc = __builtin_fmaf(wk[k], c[i + k], acc);
            o[i] = acc; }
#pragma unroll
        for (int i = 0; i < 32; ++i) cv[i * 512 + ch] = o[i];
#pragma unroll
        for (int j = 0; j < 30; ++j) c[j] = c[j + 32];
        WG_SYNC();
#pragma unroll
        for (int x = 0; x < 4; ++x) { const int i = 4 * F.wave + x; const LAS f32x4* r = (const LAS f32x4*)(cv + i * 512 + 8 * F.lane);
            f32x4 v0 = r[0], v1 = r[1]; float s = (v0[0] + v0[1]) + (v0[2] + v0[3]) + (v1[0] + v1[1]) + (v1[2] + v1[3]);
            const float mu = wave_sum(s) * (1.f / 512.f); v0 = v0 - mu; v1 = v1 - mu;
            float q = (v0[0] * v0[0] + v0[1] * v0[1]) + (v0[2] * v0[2] + v0[3] * v0[3]) + (v1[0] * v1[0] + v1[1] * v1[1]) + (v1[2] * v1[2] + v1[3] * v1[3]);
            const float rstd = 1.0f / sqrtf(wave_sum(q) * (1.f / 512.f) + EPS);
            float y[8];
#pragma unroll
            for (int k = 0; k < 4; ++k) { y[k] = silu_f(v0[k] * rstd * g0[k] + b0[k]); y[4 + k] = silu_f(v1[k] * rstd * g1[k] + b1[k]); }
            *(u32x4*)(Y + (size_t)(b * SEQ + s0 + 32 * p + i) * D + 512 + 8 * F.lane) = pack8(y); }
        WG_SYNC();
    }
#undef CV_LOAD
#undef CV_GLU_TO_LDS
}

constexpr int M1_VS = 0, M1_WS = 34816, M1_ST = 69632, M1_SP = 70656, M1_LD = 272, M1_LDS = 132;
__device__ __forceinline__ void mixer1_unit(Frame& F, const PT& a, unsigned char* ws, int unit) {
    const int t0 = unit * 128, s0 = (unit & 127) * 128;
    const int tid = F.tid, lane = F.lane, w = F.wave;
    const bf16* Z = (const bf16*)(ws + WS_Z); bf16* Y = (bf16*)(ws + WS_Y);
    LAS unsigned char* L = F.lds; LAS f32x2* stt = (LAS f32x2*)(L + M1_ST); LAS float* SP = (LAS float*)(L + M1_SP);
    const float* p_lng = a.in(I_O_SG_LN_G); const float* p_lnb = a.in(I_O_SG_LN_B); const float* p_sgb = a.in(I_O_SG_B); const float* p_scw = a.in(I_O_SC_W);
    LAS float* GL = (LAS float*)(L + 139264);
    { GL[tid] = p_lng[tid]; GL[512 + tid] = p_lnb[tid]; GL[1024 + tid] = p_sgb[tid]; }
#pragma unroll
    for (int b8 = 0; b8 < 2; ++b8) { u32x4 raw[8];
#pragma unroll
        for (int x = 0; x < 8; ++x) raw[x] = *(const u32x4*)(Z + (size_t)(t0 + 16 * w + 8 * b8 + x) * ODD_IN + 512 + 8 * lane);
#pragma unroll
        for (int x = 0; x < 8; ++x) { float v[8]; unpack8(raw[x], v); float s = 0.f;
#pragma unroll
            for (int j = 0; j < 8; ++j) { v[j] = gelu_tanh(v[j]); s += v[j]; }
            const float mu = wave_sum(s) * (1.f / 512.f); float q = 0.f;
#pragma unroll
            for (int j = 0; j < 8; ++j) { const float d = v[j] - mu; q += d * d; }
            const float rstd = 1.0f / sqrtf(wave_sum(q) * (1.f / 512.f) + EPS);
            if (lane == 0) stt[16 * w + 8 * b8 + x] = (f32x2){mu, rstd}; } }
    WG_SYNC();
    const int q4 = lane >> 4, r16 = lane & 15;
    const int tk = tid >> 2, part = tid & 3;
    u32x4 raw[4], wr4[4], uraw[4];
#define M1_LOAD_FILL(g_) do { const bf16* _zr = Z + (size_t)(t0 + tk) * ODD_IN + 512 + 128 * (g_) + 32 * part; const bf16* _ws = (const bf16*)(ws + WS_SGW) + (size_t)((g_) * 128 + tk) * 128 + 32 * part; \
        _Pragma("unroll") for (int j = 0; j < 4; ++j) { raw[j] = *(const u32x4*)(_zr + 8 * j); wr4[j] = *(const u32x4*)(_ws + 8 * j); } } while (0)
    M1_LOAD_FILL(0);
#pragma unroll
    for (int g = 0; g < 4; ++g) {
        { const bf16* zu = Z + (size_t)(t0 + tk) * ODD_IN + 128 * g + 32 * part;
#pragma unroll
          for (int j = 0; j < 4; ++j) uraw[j] = *(const u32x4*)(zu + 8 * j); }
        { f32x4 lg[8], lb[8];
#pragma unroll
          for (int j = 0; j < 8; ++j) { lg[j] = *(const LAS f32x4*)(GL + 128 * g + 32 * part + 4 * j); lb[j] = *(const LAS f32x4*)(GL + 512 + 128 * g + 32 * part + 4 * j); }
          const f32x2 ms = stt[tk];
#pragma unroll
          for (int j = 0; j < 4; ++j) { float v[8]; unpack8(raw[j], v);
#pragma unroll
              for (int k = 0; k < 8; ++k) v[k] = (gelu_tanh(v[k]) - ms[0]) * ms[1] * lg[2 * j + (k >> 2)][k & 3] + lb[2 * j + (k >> 2)][k & 3];
              *(LAS u32x4*)(L + M1_VS + tk * M1_LD + (32 * part + 8 * j) * 2) = pack8(v);
              *(LAS u32x4*)(L + M1_WS + tk * M1_LD + (32 * part + 8 * j) * 2) = wr4[j]; } }
        if (g < 3) M1_LOAD_FILL(g + 1);
        WG_SYNC();
        { f32x4 acc[8];
#pragma unroll
          for (int ct = 0; ct < 8; ++ct) acc[ct] = (f32x4){0.f, 0.f, 0.f, 0.f};
#pragma unroll
          for (int ks = 0; ks < 4; ++ks) { const bf16x8 af = frag_row(L + M1_WS, M1_LD, 16 * w, 32 * ks, lane);
#pragma unroll
              for (int ct = 0; ct < 8; ++ct) acc[ct] = mma16(af, frag_tr(L + M1_VS, M1_LD, 32 * ks, 16 * ct, lane), acc[ct]); }
#pragma unroll
          for (int jj = 0; jj < 4; ++jj) { const int p = 16 * w + 4 * q4 + jj; const float sb = GL[1024 + g * 128 + p];
#pragma unroll
              for (int ct = 0; ct < 8; ++ct) SP[p * M1_LDS + 16 * ct + r16] = acc[ct][jj] + sb; } }
        WG_SYNC();
        { bf16* yo = Y + (size_t)(t0 + tk) * D + 128 * g + 32 * part;
#pragma unroll
          for (int j = 0; j < 4; ++j) { float v[8]; unpack8(uraw[j], v); const f32x4 s0v = *(const LAS f32x4*)(SP + tk * M1_LDS + 32 * part + 8 * j), s1v = *(const LAS f32x4*)(SP + tk * M1_LDS + 32 * part + 8 * j + 4);
#pragma unroll
              for (int k = 0; k < 4; ++k) { v[k] = gelu_tanh(v[k]) * s0v[k]; v[4 + k] = gelu_tanh(v[4 + k]) * s1v[k]; }
              *(u32x4*)(yo + 8 * j) = pack8(v); } }
    }
#undef M1_LOAD_FILL
    { const int ch0 = 8 * lane; float w0[8], w1[8], w2[8];
#pragma unroll
      for (int j = 0; j < 2; ++j) { const f32x4 a0 = *(const f32x4*)(p_scw + ch0 + 4 * j), a1 = *(const f32x4*)(p_scw + 512 + ch0 + 4 * j), a2 = *(const f32x4*)(p_scw + 1024 + ch0 + 4 * j);
#pragma unroll
          for (int k = 0; k < 4; ++k) { w0[4 * j + k] = a0[k]; w1[4 * j + k] = a1[k]; w2[4 * j + k] = a2[k]; } }
#pragma unroll
      for (int b8 = 0; b8 < 2; ++b8) { const int tb = 16 * w + 8 * b8;
          u32x4 cg[10], hv[10], bg[8];
#pragma unroll
          for (int x = 0; x < 10; ++x) { const int tt = tb - 2 + x; const bool ok = (s0 + tt) >= 0; const bf16* zr = Z + (size_t)(t0 + (ok ? tt : 0)) * ODD_IN + ch0;
              cg[x] = *(const u32x4*)(zr + 1536); hv[x] = *(const u32x4*)(zr + 2048); }
#pragma unroll
          for (int x = 0; x < 8; ++x) bg[x] = *(const u32x4*)(Z + (size_t)(t0 + tb + x) * ODD_IN + 1024 + ch0);
          __builtin_amdgcn_sched_barrier(0);
#pragma unroll
          for (int x = 0; x < 2; ++x) { if ((s0 + tb - 2 + x) < 0) cg[x] = (u32x4){0u, 0u, 0u, 0u}; }
          float pr[10][8];
#pragma unroll
          for (int x = 0; x < 10; ++x) { float c8[8], h8[8]; unpack8(cg[x], c8); unpack8(hv[x], h8);
#pragma unroll
              for (int k = 0; k < 8; ++k) pr[x][k] = c8[k] * h8[k]; }
#pragma unroll
          for (int x = 0; x < 8; ++x) { float b8v[8], y[8]; unpack8(bg[x], b8v);
#pragma unroll
              for (int k = 0; k < 8; ++k) y[k] = b8v[k] * (w0[k] * pr[x][k] + w1[k] * pr[x + 1][k] + w2[k] * pr[x + 2][k]);
              *(u32x4*)(Y + (size_t)(t0 + tb + x) * D + 512 + ch0) = pack8(y); } }
    }
    WG_SYNC();
}

__device__ __forceinline__ void route_phase(Frame& F, const PT& a, unsigned char* ws, const float* hres) {
    LAS float* rt = (LAS float*)F.lds;
    LAS int* lcnt = (LAS int*)(F.lds + 32768); LAS int* lbase = lcnt + 8;
    LAS int* te = (LAS int*)(F.lds + 33024); LAS int* tr = te + 256; LAS float* tg = (LAS float*)(tr + 256);
    unsigned* gcnt = (unsigned*)(ws + WS_CTL) + CW_CNT;
    int* row_tok = (int*)(ws + WS_ROWTOK); u32x2* tokinfo = (u32x2*)(ws + WS_TOKINFO);
    const float* p_rt = a.in(I_O_ROUTER); const float* p_ng = a.in(I_O_NORM_FFN);
    for (int i = F.tid; i < 8192; i += NTHR) { const int d = i >> 3, e = i & 7; rt[e * 1024 + d] = p_rt[i]; }
    if (F.tid < 8) lcnt[F.tid] = 0;
    __syncthreads();
    f32x4 gnr[4];
    { const f32x4* gr0 = (const f32x4*)p_ng + F.lane;
#pragma unroll
      for (int j = 0; j < 4; ++j) gnr[j] = gr0[64 * j]; }
    for (int base = F.vcu * 128; base < T; base += F.G * 128) {
        u32x2 va[4], ma[4], vb[4], mb[4];
        { const u32x2* xr = (const u32x2*)(hres + (size_t)(base + 16 * F.wave) * D) + F.lane;
#pragma unroll
          for (int j = 0; j < 4; ++j) { va[j] = xr[64 * j]; ma[j] = xr[256 + 64 * j]; vb[j] = xr[512 + 64 * j]; mb[j] = xr[768 + 64 * j]; } }
        auto one_token = [&](u32x2 (&vn)[4], u32x2 (&mn)[4], const int x) __attribute__((always_inline)) { const int tl = 16 * F.wave + x, t = base + tl;
            f32x4 v[4]; float s = 0.f;
#pragma unroll
            for (int j = 0; j < 4; ++j) { v[j][0] = bf2f(vn[j][0] & 0xffffu) + bf2f(mn[j][0] & 0xffffu); v[j][1] = bf2f(vn[j][0] >> 16) + bf2f(mn[j][0] >> 16);
                                          v[j][2] = bf2f(vn[j][1] & 0xffffu) + bf2f(mn[j][1] & 0xffffu); v[j][3] = bf2f(vn[j][1] >> 16) + bf2f(mn[j][1] >> 16); }
            { const u32x2* xr = (const u32x2*)(hres + (size_t)(t + (x < 14 ? 2 : 0)) * D) + F.lane;
#pragma unroll
              for (int j = 0; j < 4; ++j) { vn[j] = xr[64 * j]; mn[j] = xr[256 + 64 * j]; } }
#pragma unroll
            for (int j = 0; j < 4; ++j) s += (v[j][0] * v[j][0] + v[j][1] * v[j][1]) + (v[j][2] * v[j][2] + v[j][3] * v[j][3]);
            const float r = __builtin_amdgcn_rsqf(wave_sum(s) * (1.f / D) + EPS);
            unsigned* o4 = (unsigned*)(ws + WS_XN8 + (size_t)t * D) + F.lane;
            float lg[8];
#pragma unroll
            for (int e = 0; e < 8; ++e) lg[e] = 0.f;
#pragma unroll
            for (int j = 0; j < 4; ++j) { const f32x4 g = gnr[j]; f32x4 xn; xn[0] = v[j][0] * r * g[0]; xn[1] = v[j][1] * r * g[1]; xn[2] = v[j][2] * r * g[2]; xn[3] = v[j][3] * r * g[3];
                o4[64 * j] = pk4_fp8(xn[0], xn[1], xn[2], xn[3]);
#pragma unroll
                for (int e = 0; e < 8; ++e) { const f32x4 rw = *(const LAS f32x4*)(rt + e * 1024 + 256 * j + 4 * F.lane); lg[e] += (xn[0] * rw[0] + xn[1] * rw[1]) + (xn[2] * rw[2] + xn[3] * rw[3]); } }
#pragma unroll
            for (int e = 0; e < 8; ++e) lg[e] = wave_sum(lg[e]);
            int e1 = 0; float m1 = lg[0];
#pragma unroll
            for (int e = 1; e < 8; ++e) if (lg[e] > m1) { m1 = lg[e]; e1 = e; }
            int e2 = -1; float m2 = 0.f;
#pragma unroll
            for (int e = 0; e < 8; ++e) if (e != e1 && (e2 < 0 || lg[e] > m2)) { m2 = lg[e]; e2 = e; }
            const float p2 = __expf(m2 - m1), g1 = __builtin_amdgcn_rcpf(1.0f + p2), g2 = p2 * g1;
            if (F.lane == 0) { te[2 * tl] = e1; te[2 * tl + 1] = e2; tg[2 * tl] = g1; tg[2 * tl + 1] = g2;
                tr[2 * tl] = __hip_atomic_fetch_add(lcnt + e1, 1, __ATOMIC_RELAXED, __HIP_MEMORY_SCOPE_WORKGROUP); tr[2 * tl + 1] = __hip_atomic_fetch_add(lcnt + e2, 1, __ATOMIC_RELAXED, __HIP_MEMORY_SCOPE_WORKGROUP); } };
        for (int x = 0; x < 16; x += 2) { one_token(va, ma, x); one_token(vb, mb, x + 1); }
        __syncthreads();
        if (F.tid < 8) { lbase[F.tid] = (int)__hip_atomic_fetch_add(gcnt + 64 * F.tid, (unsigned)lcnt[F.tid], RLX_AGENT); }
        __syncthreads();
        if (F.tid < 256) { const int e = te[F.tid], idx = lbase[e] + tr[F.tid], t = base + (F.tid >> 1);
            row_tok[e * 32768 + idx] = t;
            tokinfo[(size_t)t * 2 + (F.tid & 1)] = (u32x2){((unsigned)e << 24) | (unsigned)idx, __float_as_uint(tg[F.tid])}; }
        __syncthreads();
        if (F.tid < 8) lcnt[F.tid] = 0;
        __syncthreads();
    }
}
__device__ __forceinline__ void combine_phase(Frame& F, const PT& a, unsigned char* ws, const LAS int* bstart, float* out) {
    const int gw = F.vcu * NWAVES + F.wave, NGW = F.G * NWAVES;
    const u32x2* tokinfo = (const u32x2*)(ws + WS_TOKINFO); const bf16* YM = (const bf16*)(ws + WS_YMOE); const bf16* SL = (const bf16*)(ws + WS_SLAB); const float* p_fn = a.in(I_FINAL_NORM);
    const f32x4* gr = (const f32x4*)p_fn + F.lane; f32x4 gn[4];
#pragma unroll
    for (int j = 0; j < 4; ++j) gn[j] = gr[64 * j];
    for (int tb = gw; tb < T; tb += 16 * NGW) {
        u32x2 inf0 = {0u, 0u}, inf1 = {0u, 0u};
        { const int tl = tb + (F.lane & 15) * NGW; if (tl < T) { inf0 = tokinfo[(size_t)tl * 2]; inf1 = tokinfo[(size_t)tl * 2 + 1]; } }
        u32x2 hn[4], mn[4], y0n[4], y1n[4]; size_t p0n = 0, p1n = 0;
#define CMB_ISSUE(k) do { const int _t = tb + (k) * NGW; const unsigned _a0 = __builtin_amdgcn_readlane(inf0[0], (k)), _a1 = __builtin_amdgcn_readlane(inf1[0], (k)); \
        p0n = (size_t)bstart[_a0 >> 24] * 256 + (_a0 & 0xffffffu); p1n = (size_t)bstart[_a1 >> 24] * 256 + (_a1 & 0xffffffu); \
        const u32x2* _xr = (const u32x2*)(out + (size_t)_t * D) + F.lane; \
        const u32x2* _y0 = (const u32x2*)(YM + (p0n < 65536 ? p0n : 0) * D) + F.lane; const u32x2* _y1 = (const u32x2*)(YM + (p1n < 65536 ? p1n : 0) * D) + F.lane; \
        _Pragma("unroll") for (int j = 0; j < 4; ++j) { hn[j] = _xr[64 * j]; mn[j] = _xr[256 + 64 * j]; y0n[j] = _y0[64 * j]; y1n[j] = _y1[64 * j]; } } while (0)
        CMB_ISSUE(0);
#pragma unroll
        for (int k = 0; k < 16; ++k) { const int t = tb + k * NGW; if (t >= T) break;
            f32x4 v[4]; u32x2 ya[4], yb[4]; const size_t p0 = p0n, p1 = p1n;
#pragma unroll
            for (int j = 0; j < 4; ++j) { v[j][0] = bf2f(hn[j][0] & 0xffffu) + bf2f(mn[j][0] & 0xffffu); v[j][1] = bf2f(hn[j][0] >> 16) + bf2f(mn[j][0] >> 16);
                                          v[j][2] = bf2f(hn[j][1] & 0xffffu) + bf2f(mn[j][1] & 0xffffu); v[j][3] = bf2f(hn[j][1] >> 16) + bf2f(mn[j][1] >> 16); ya[j] = y0n[j]; yb[j] = y1n[j]; }
            const float g0 = __uint_as_float(__builtin_amdgcn_readlane(inf0[1], k)), g1 = __uint_as_float(__builtin_amdgcn_readlane(inf1[1], k));
            if (k < 15 && t + NGW < T) CMB_ISSUE(k + 1);
#pragma unroll
            for (int kk = 0; kk < 2; ++kk) { const size_t p = kk ? p1 : p0; const float g = kk ? g1 : g0;
                if (p < (size_t)65536) {
#pragma unroll
                    for (int j = 0; j < 4; ++j) { const u32x2 a0 = kk ? yb[j] : ya[j]; v[j][0] += g * bf2f(a0[0] & 0xffffu); v[j][1] += g * bf2f(a0[0] >> 16); v[j][2] += g * bf2f(a0[1] & 0xffffu); v[j][3] += g * bf2f(a0[1] >> 16); } }
                else { f32x4 acc[4];
#pragma unroll
                    for (int j = 0; j < 4; ++j) acc[j] = (f32x4){0.f, 0.f, 0.f, 0.f};
                    for (int ks = 0; ks < 7; ++ks) { const u32x2* y = (const u32x2*)(SL + ((size_t)ks * 2048 + (p - 65536)) * D) + F.lane;
#pragma unroll
                        for (int j = 0; j < 4; ++j) { const u32x2 a0 = y[64 * j]; acc[j][0] += bf2f(a0[0] & 0xffffu); acc[j][1] += bf2f(a0[0] >> 16); acc[j][2] += bf2f(a0[1] & 0xffffu); acc[j][3] += bf2f(a0[1] >> 16); } }
#pragma unroll
                    for (int j = 0; j < 4; ++j) v[j] = v[j] + acc[j] * g; } }
            float s = 0.f;
#pragma unroll
            for (int j = 0; j < 4; ++j) s += (v[j][0] * v[j][0] + v[j][1] * v[j][1]) + (v[j][2] * v[j][2] + v[j][3] * v[j][3]);
            const float r = 1.0f / sqrtf(wave_sum(s) * (1.f / D) + EPS);
            f32x4* xr = (f32x4*)(out + (size_t)t * D) + F.lane;
#pragma unroll
            for (int j = 0; j < 4; ++j) { f32x4 o; o[0] = v[j][0] * r * gn[j][0]; o[1] = v[j][1] * r * gn[j][1]; o[2] = v[j][2] * r * gn[j][2]; o[3] = v[j][3] * r * gn[j][3]; xr[64 * j] = o; }
        }
#undef CMB_ISSUE
    }
}

__global__ void __launch_bounds__(NTHR, 2) mega_fwd(Args args) {
    extern __shared__ __attribute__((aligned(16))) unsigned char lds[];
    Frame F;
    F.lds = (LAS unsigned char*)lds;
    volatile LAS unsigned* MISC = (volatile LAS unsigned*)(F.lds + MISC_OFF);
    F.tid = threadIdx.x; F.lane = F.tid & 63; F.wave = __builtin_amdgcn_readfirstlane(F.tid >> 6);
    F.G = gridDim.x; { const int bx = blockIdx.x; F.vcu = (F.G % 8 == 0) ? (bx % 8) * (F.G / 8) + bx / 8 : bx; }
    for (int u = F.tid; u < 256; u += NTHR) MISC[u] = 0u;
    __syncthreads();
    if (F.tid == 0) {
#pragma unroll
        for (int i = 0; i < 29; ++i) { const unsigned long long v = (i < 27) ? (unsigned long long)args.in[i < 27 ? i : 0] : (i == 27 ? (unsigned long long)args.out : (unsigned long long)args.ws);
            MISC[128 + 2 * i] = (unsigned)v; MISC[128 + 2 * i + 1] = (unsigned)(v >> 32); } }
    __syncthreads();
    const PT pt{MISC + 128};
    unsigned char* const ws = (unsigned char*)pt.p(28);
    unsigned* ctl = (unsigned*)(ws + WS_CTL);
    XcdBarrier bar = xcd_barrier_post(ctl + CW_BAR, MISC + 8);
#define GRID_BAR() xcd_barrier(bar)
    const int bx = (int)blockIdx.x;
    float* const hres = (float*)pt.p(27);
    bf16* const HM = (bf16*)hres;
    bf16* const XN = (bf16*)(ws + WS_XN);
    LAS unsigned char* const ring = F.lds;
    const LAS unsigned short* const rowoff = (const LAS unsigned short*)(F.lds + ROWOFF_OFF);

    RopeJob rj; rope_init(rj, F);
    refresh(F); convert_weights(F, pt, ws, 0, CV_TOTAL, rj);
    refresh(F); misc_tables(F, pt, ws, rj);
    refresh(F); norm_phase(F, pt.in(I_X), pt.in(I_E_NORM_MIX), XN);
    GRID_BAR();
    { pg8::PlainSched S; S.o.init(T / 256, EVEN_IN / 256, F.G, bx); S.Abase = (const char*)XN; S.Bbase = (const char*)(ws + WS_W_EIN); S.tstep = 256u * D * 2u; S.tstepA = 0u;
      pg8::EpiZ0 E{(bf16*)(ws + WS_Z), (const float*)(ws + WS_ROPE), (const float*)(ws + WS_ROPE) + (size_t)SEQ * 64};
      pg8::gemm_phase<pg8::EpiZ0, pg8::PlainSched, false, true, true>(ring, rowoff, D, S, E); }
    GRID_BAR();
    for (int u = F.vcu; u < 256; u += F.G) { refresh(F); ret_unit<false>(F, pt, ws, u); refresh(F); conv_unit(F, pt, ws, u); }
    GRID_BAR();
    refresh(F); ret_scan(F, ws);
    GRID_BAR();
    for (int u = F.vcu; u < 256; u += F.G) { refresh(F); ret_unit<true>(F, pt, ws, u); }
    GRID_BAR();
    { pg8::PlainSched S; S.o.init(T / 256, D / 256, F.G, bx); S.Abase = (const char*)(ws + WS_Y); S.Bbase = (const char*)(ws + WS_W_EOUT); S.tstep = 256u * D * 2u; S.tstepA = 0u;
      pg8::EpiResB<0> E{pt.in(I_X), nullptr, 0, XN, D, (float*)(ws + WS_SSP), (LAS float*)(F.lds + ROWOFF_OFF)};
      pg8::gemm_phase<pg8::EpiResB<0>, pg8::PlainSched, false, true, true>(ring, rowoff, D, S, E); }
    GRID_BAR();
    { pg8::PlainSched S; S.o.init(T / 256, 2 * DFF / 256, F.G, bx); S.Abase = (const char*)XN; S.Bbase = (const char*)(ws + WS_W_FGU); S.tstep = 256u * D * 2u; S.tstepA = 0u;
      pg8::EpiSwiGLU E{(bf16*)(ws + WS_HFFN), DFF, (const float*)(ws + WS_SSP)};
      pg8::gemm_phase<pg8::EpiSwiGLU, pg8::PlainSched, false, true, true>(ring, rowoff, D, S, E); }
    GRID_BAR();
    { pg8::PlainSched S; S.o.init(T / 256, D / 256, F.G, bx); S.Abase = (const char*)(ws + WS_HFFN); S.Bbase = (const char*)(ws + WS_W_FDN); S.tstep = 256u * DFF * 2u; S.tstepA = 0u;
      pg8::EpiResB<1> E{nullptr, XN, D, HM, 2 * D, (float*)(ws + WS_SSP), (LAS float*)(F.lds + ROWOFF_OFF)};
      pg8::gemm_phase<pg8::EpiResB<1>, pg8::PlainSched, false, true, true>(ring, rowoff, DFF, S, E); }
    GRID_BAR();
    { pg8::PlainSched S; S.o.init(T / 256, ODD_IN / 256, F.G, bx); S.Abase = (const char*)HM; S.Bbase = (const char*)(ws + WS_W_OIN); S.tstep = 256u * D * 2u; S.tstepA = 256u * D * 4u;
      pg8::EpiBf16 E{(bf16*)(ws + WS_Z), ODD_IN, (const float*)(ws + WS_SSP)};
      pg8::gemm_phase<pg8::EpiBf16, pg8::PlainSched, false, true, true>(ring, rowoff, D, S, E, 0, D * 4); }
    GRID_BAR();
    for (int u = F.vcu; u < 256; u += F.G) { refresh(F); mixer1_unit(F, pt, ws, u); }
    GRID_BAR();
    { pg8::PlainSched S; S.o.init(T / 256, D / 256, F.G, bx); S.Abase = (const char*)(ws + WS_Y); S.Bbase = (const char*)(ws + WS_W_OOUT); S.tstep = 256u * D * 2u; S.tstepA = 0u;
      pg8::EpiBf16S E{HM + D, 2 * D, 1.0f};
      pg8::gemm_phase<pg8::EpiBf16S, pg8::PlainSched, false, true, true>(ring, rowoff, D, S, E); }
    GRID_BAR();
    refresh(F); route_phase(F, pt, ws, hres);
    GRID_BAR();
    LAS int* mcnt = (LAS int*)(F.lds + MISC_OFF + 64 * 4); LAS int* mbst = mcnt + 8;
    refresh(F);
    if (F.tid < 8) mcnt[F.tid] = (int)__hip_atomic_load(ctl + CW_CNT + 64 * F.tid, RLX_AGENT);
    __syncthreads();
    if (F.tid == 0) { int run = 0;
        for (int e = 0; e < 8; ++e) { mbst[e] = run; run += (mcnt[e] + 255) >> 8; }
        mbst[8] = run; }
    __syncthreads();
    const int RB = mbst[8];
    const LAS unsigned short* const rowtok = (const LAS unsigned short*)(F.lds + ROWOFF_OFF);
    { pg8::MoeGuSched S; S.o.init(RB, 2 * DEXP / 256, F.G, bx); S.rb0 = 0; S.bstart = mbst; S.Abase = (const char*)(ws + WS_XN8); S.Bbase = (const char*)(ws + WS_WGU8);
      { refresh(F); LAS unsigned short* rt16 = (LAS unsigned short*)(F.lds + ROWOFF_OFF); const int* row_tok = (const int*)(ws + WS_ROWTOK);
        int tokv[32];
#pragma unroll
        for (int ui = 0; ui < 32; ++ui) { pg8::Unit u; u.pm = 0; u.pn = 0; u.orow = 0; u.ao = 0u; u.bo = 0u; const bool ok = S.next(ui, u);
            const int e = pg8::expert_of(mbst, u.pm), j = u.pm - mbst[e], idx = 256 * j + (F.tid & 255); const bool live = ok && idx < mcnt[e];
            const int ld = row_tok[e * 32768 + (live ? idx : 0)]; tokv[ui] = live ? ld : 0; }
        if (F.tid < 256) {
#pragma unroll
            for (int ui = 0; ui < 32; ++ui) rt16[ui * 256 + F.tid] = (unsigned short)tokv[ui]; }
        __syncthreads(); }
      pg8::EpiSwiGLU8 E{ws + WS_HMOE8, DEXP};
      pg8::gemm_phase<pg8::EpiSwiGLU8, pg8::MoeGuSched, true, true, true, true>(ring, rowtok, D, S, E); }
    GRID_BAR();
    { pg8::MoeDnSched S; S.o.init(RB < 256 ? RB : 256, D / 256, F.G, bx); S.rb0 = 0; S.bstart = mbst; S.Abase = (const char*)(ws + WS_HMOE8); S.Bbase = (const char*)(ws + WS_WDN8);
      pg8::EpiBf16S E{(bf16*)(ws + WS_YMOE), D, 1.0f};
      pg8::gemm_phase<pg8::EpiBf16S, pg8::MoeDnSched, false, true, true, true>(ring, rowtok, DEXP, S, E); }
    if (RB > 256) {
      pg8::MoeDnSplitSched S; S.n = (RB - 256) * 28; S.G = F.G; S.c = bx; S.bstart = mbst; S.Abase = (const char*)(ws + WS_HMOE8); S.Bbase = (const char*)(ws + WS_WDN8);
      pg8::EpiBf16S E{(bf16*)(ws + WS_SLAB), D, 1.0f};
      pg8::gemm_phase<pg8::EpiBf16S, pg8::MoeDnSplitSched, false, true, true, true>(ring, rowtok, DEXP, S, E, 4); }
    GRID_BAR();
    refresh(F); combine_phase(F, pt, ws, mbst, hres);
}

extern "C" void kernel_launch(void* const* d_in, const int* in_sizes, int n_in, void* d_out, int out_size, void* d_ws, size_t ws_size, hipStream_t stream) {
    static int grid = 0;
    if (grid == 0) {
        if (n_in != 27 || in_sizes[0] != T * D || out_size != T * D || ws_size < WS_END) { fprintf(stderr, "kernel_launch: unexpected shapes (n_in %d, in0 %d, out %d, ws %zu); nothing launched\n", n_in, n_in > 0 ? in_sizes[0] : -1, out_size, ws_size); grid = -1; return; }
        int dev = 0, cus = 0, per_cu = 0;
        if (hipGetDevice(&dev) != hipSuccess || hipDeviceGetAttribute(&cus, hipDeviceAttributeMultiprocessorCount, dev) != hipSuccess) { grid = -1; return; }
        if (hipFuncSetAttribute((const void*)mega_fwd, hipFuncAttributeMaxDynamicSharedMemorySize, LDS_BYTES) != hipSuccess) { fprintf(stderr, "kernel_launch: hipFuncSetAttribute failed\n"); grid = -1; return; }
        if (hipOccupancyMaxActiveBlocksPerMultiprocessor(&per_cu, (const void*)mega_fwd, NTHR, LDS_BYTES) != hipSuccess || per_cu < 1) fprintf(stderr, "kernel_launch: occupancy query reports %d\n", per_cu);
        (void)hipGetLastError();
        if (cus != 256) { fprintf(stderr, "kernel_launch: built for a 256-CU device (unit lists of at most 32 units per workgroup and phase); found %d CUs; nothing launched\n", cus); grid = -1; return; }
        grid = cus;
    }
    if (grid < 0) return;
    if (hipMemsetAsync((char*)d_ws + WS_CTL, 0, CTL_ZERO_BYTES, stream) != hipSuccess) return;
    Args a{};
    for (int i = 0; i < 27; ++i) a.in[i] = (const float*)d_in[i];
    a.out = (float*)d_out; a.ws = (unsigned char*)d_ws;
    hipLaunchKernelGGL(mega_fwd, dim3(grid), dim3(NTHR), LDS_BYTES, stream, a);
}
```

```cpp
#include <hip/hip_runtime.h>
#include <cstdio>

#define GAS __attribute__((address_space(1)))
#define LAS __attribute__((address_space(3)))
typedef unsigned short bf16;
typedef short bf16x8 __attribute__((ext_vector_type(8)));
typedef short s16x4 __attribute__((ext_vector_type(4)));
typedef float f32x4 __attribute__((ext_vector_type(4)));
typedef float f32x2 __attribute__((ext_vector_type(2)));
typedef unsigned u32x4 __attribute__((ext_vector_type(4)));
typedef unsigned u32x2 __attribute__((ext_vector_type(2)));
typedef int i32x4 __attribute__((ext_vector_type(4)));
typedef int i32x8 __attribute__((ext_vector_type(8)));

constexpr int BATCH = 2, SEQ = 16384, T = BATCH * SEQ, D = 1024;
constexpr int EVEN_IN = 3072, ODD_IN = 2560, DFF = 2816, NEXP = 8, DEXP = 3584;
constexpr float EPS = 1e-6f;
constexpr int NWAVES = 8, NTHR = 512;

constexpr size_t MiB = 1u << 20;
constexpr size_t WS_CTL = 0, CTL_ZERO_BYTES = 64 * 1024;
constexpr size_t WS_ROWTOK = 1 * MiB;
constexpr size_t WS_TOKINFO = 2 * MiB;
constexpr size_t WS_SSP = 2 * MiB + 512 * 1024;
constexpr size_t WS_WGU8 = 3 * MiB;
constexpr size_t WS_WDN8 = 59 * MiB;
constexpr size_t WS_XN = 87 * MiB;
constexpr size_t WS_Y = 151 * MiB;
constexpr size_t WS_YMOE = 87 * MiB;
constexpr size_t WS_Z = 219 * MiB;
constexpr size_t WS_HFFN = 219 * MiB;
constexpr size_t WS_HMOE8 = 219 * MiB;
constexpr size_t WS_H18 = 411 * MiB;
constexpr size_t WS_RETL = 411 * MiB;
constexpr size_t WS_RETS = 427 * MiB;
constexpr size_t WS_W_EIN = 443 * MiB;
constexpr size_t WS_W_EOUT = 449 * MiB;
constexpr size_t WS_W_FGU = 451 * MiB;
constexpr size_t WS_W_FDN = 462 * MiB;
constexpr size_t WS_W_OIN = 468 * MiB;
constexpr size_t WS_W_OOUT = 473 * MiB;
constexpr size_t WS_ROPE = 475 * MiB;
constexpr size_t WS_SGW = 483 * MiB;
constexpr size_t WS_XN8 = 450 * MiB;
constexpr size_t WS_SLAB = 482 * MiB;
constexpr size_t WS_END = 510 * MiB;
constexpr size_t EXP_GU_BYTES = (size_t)2 * DEXP * D, EXP_DN_BYTES = (size_t)D * DEXP;
constexpr float W8_SCALE = 64.0f, W8_INV = 1.0f / 64.0f;
constexpr int CW_BAR = 4096, CW_CNT = 8192;

constexpr int LDS_BYTES = 159744;
constexpr int ROWOFF_OFF = 131072;
constexpr int MISC_OFF = LDS_BYTES - 1024;

#define RLX_AGENT __ATOMIC_RELAXED, __HIP_MEMORY_SCOPE_AGENT
#define LDS_WAIT() asm volatile("s_waitcnt lgkmcnt(0)" ::: "memory")
#define VM_WAIT() asm volatile("s_waitcnt vmcnt(0)" ::: "memory")
#define WG_SYNC() do { asm volatile("s_waitcnt lgkmcnt(0)" ::: "memory"); __builtin_amdgcn_s_barrier(); asm volatile("" ::: "memory"); } while (0)

__device__ __forceinline__ float bf2f(unsigned b) { return __uint_as_float(b << 16); }
typedef __bf16 bf16x2_t __attribute__((ext_vector_type(2)));
__device__ __forceinline__ unsigned pk2(float lo, float hi) { const bf16x2_t v = __builtin_convertvector((f32x2){lo, hi}, bf16x2_t); return __builtin_bit_cast(unsigned, v); }
__device__ __forceinline__ unsigned f2bf(float f) { return pk2(f, 0.f) & 0xffffu; }
__device__ __forceinline__ unsigned pk4_fp8(float a, float b, float c, float d) { int r = __builtin_amdgcn_cvt_pk_fp8_f32(a, b, 0, false); r = __builtin_amdgcn_cvt_pk_fp8_f32(c, d, r, true); return (unsigned)r; }
__device__ __forceinline__ float clamp8(float x) { return __builtin_fminf(__builtin_fmaxf(x, -448.0f), 448.0f); }
template <int CTRL, int RMASK> __device__ __forceinline__ float dpp_take(float v) {
    return __builtin_bit_cast(float, __builtin_amdgcn_update_dpp(0, __builtin_bit_cast(int, v), CTRL, RMASK, 0xf, true)); }
__device__ __forceinline__ float wave_sum(float v) {
    v += dpp_take<0x111, 0xf>(v); v += dpp_take<0x112, 0xf>(v); v += dpp_take<0x114, 0xf>(v); v += dpp_take<0x118, 0xf>(v);
    v += dpp_take<0x142, 0xa>(v); v += dpp_take<0x143, 0xc>(v);
    return __builtin_bit_cast(float, __builtin_amdgcn_readlane(__builtin_bit_cast(int, v), 63));
}
template <int CTRL> __device__ __forceinline__ float dpp_all(float v) { return __builtin_bit_cast(float, __builtin_amdgcn_update_dpp(0, __builtin_bit_cast(int, v), CTRL, 0xf, 0xf, false)); }
__device__ __forceinline__ float sum8(float v) { v += dpp_all<0xB1>(v); v += dpp_all<0x4E>(v); v += dpp_all<0x141>(v); return v; }
__device__ __forceinline__ float fast_sigmoid(float x) { return __builtin_amdgcn_rcpf(1.0f + __builtin_amdgcn_exp2f(-1.4426950408889634f * x)); }
__device__ __forceinline__ float silu_f(float x) { return x * fast_sigmoid(x); }
__device__ __forceinline__ f32x2 swiglu2(f32x2 g, f32x2 u) {
    f32x2 e; e.x = __builtin_amdgcn_exp2f(g.x); e.y = __builtin_amdgcn_exp2f(g.y);
    const f32x2 d = e + 1.0f; f32x2 r; r.x = __builtin_amdgcn_rcpf(d.x); r.y = __builtin_amdgcn_rcpf(d.y);
    return (g * u) * r; }
__device__ __forceinline__ float gelu_tanh(float x) {
    const float u = 0.7978845608028654f * (x + 0.044715f * x * x * x);
    return x * fast_sigmoid(2.0f * u);
}

namespace pg8 {
constexpr int BM = 256, BK = 64, HALF = 128, HTB = HALF * BK * 2, STAGE_BYTES = 8 * HTB, NXCD = 8, WGM = 8;
__device__ __forceinline__ int lds_byte(int r, int c) { const int st = (r >> 4) * 2 + (c >> 5), rr = r & 15, cc = c & 31, ob = rr * 64 + cc * 2; return st * 1024 + (ob ^ (((ob >> 9) & 1) << 5)); }
__device__ __forceinline__ void stage_rc(int b, int& R, int& C) { const int st = b / 1024, sb = b % 1024, swz = sb ^ (((sb >> 9) & 1) << 5); R = (st >> 1) * 16 + swz / 64; C = (st & 1) * 32 + (swz % 64) / 2; }
__device__ __forceinline__ int perm32(int rho) { const int n = rho >> 4, i = rho & 15; return 8 * (i >> 2) + 4 * n + (i & 3); }

struct Unit { int pm, pn, orow; unsigned ao, bo; };
struct TileOrder {
    int nM, nN, nwg, G, c;
    __device__ __forceinline__ void init(int nM_, int nN_, int G_, int c_) { nM = nM_; nN = nN_; nwg = nM * nN; G = G_; c = c_; }
    __device__ __forceinline__ bool next(int i, int& pm, int& pn) const {
        const long L = (long)i * G + c; if (L >= nwg) return false;
        int wgid = (int)L; { const int q = nwg / NXCD, r = nwg % NXCD, xcd = wgid % NXCD, off = wgid / NXCD; wgid = (xcd < r ? xcd * (q + 1) : r * (q + 1) + (xcd - r) * q) + off; }
        if (nM == 16 * NXCD && (nN & 1) == 0) {
            const int q = nwg / NXCD, x = wgid / q, p = wgid - x * q, nfull = nN >> 2;
            if (p < nfull * 64) { const int rr = p >> 5, slot = p & 31; pm = x * 16 + (rr & 1) * 8 + (slot & 7); pn = (rr >> 1) * 4 + (slot >> 3); }
            else { const int p2 = p - nfull * 64; pm = x * 16 + (p2 & 15); pn = nfull * 4 + (p2 >> 4); }
            return true; }
        const int nig = WGM * nN, gid = wgid / nig, fm = gid * WGM, gsz = (nM - fm) < WGM ? (nM - fm) : WGM;
        pm = fm + ((wgid % nig) % gsz); pn = (wgid % nig) / gsz; return true;
    }
};
struct PlainSched {
    TileOrder o; const char* Abase; const char* Bbase; unsigned tstep, tstepA;
    __device__ __forceinline__ bool next(int i, Unit& u) const { int pm, pn; if (!o.next(i, pm, pn)) return false; u.pm = pm; u.pn = pn; u.orow = pm; u.ao = (unsigned)pm * (tstepA ? tstepA : tstep); u.bo = (unsigned)pn * tstep; return true; }
};
__device__ __forceinline__ int expert_of(const LAS int* bstart, int rb) { int e = 0;
#pragma unroll
    for (int j = 1; j < 8; ++j) e += (rb >= bstart[j]) ? 1 : 0;
    return e; }
struct MoeGuSched {
    TileOrder o; int rb0; const LAS int* bstart; const char* Abase; const char* Bbase;
    __device__ __forceinline__ bool next(int i, Unit& u) const { int pm, pn; if (!o.next(i, pm, pn)) return false; const int rb = rb0 + pm, e = expert_of(bstart, rb);
        u.pm = rb; u.pn = pn; u.orow = rb; u.ao = 0u; u.bo = (unsigned)e * (unsigned)EXP_GU_BYTES + (unsigned)pn * (unsigned)(256 * D); return true; }
};
struct MoeDnSched {
    TileOrder o; int rb0; const LAS int* bstart; const char* Abase; const char* Bbase;
    __device__ __forceinline__ bool next(int i, Unit& u) const { int pm, pn; if (!o.next(i, pm, pn)) return false; const int rb = rb0 + pm, e = expert_of(bstart, rb);
        u.pm = rb; u.pn = pn; u.orow = rb; u.ao = (unsigned)rb * (unsigned)(256 * DEXP); u.bo = (unsigned)e * (unsigned)EXP_DN_BYTES + (unsigned)pn * (unsigned)(256 * DEXP); return true; }
};
struct MoeDnSplitSched {
    int n, G, c; const LAS int* bstart; const char* Abase; const char* Bbase;
    __device__ __forceinline__ bool next(int i, Unit& u) const { const int L = i * G + c; if (L >= n) return false; const int ks = L % 7, t = L / 7, pn = t & 3, pm = t >> 2, rb = 256 + pm, e = expert_of(bstart, rb);
        u.pm = rb; u.pn = pn; u.orow = ks * 8 + pm; u.ao = (unsigned)rb * (unsigned)(256 * DEXP) + ks * 512u; u.bo = (unsigned)e * (unsigned)EXP_DN_BYTES + (unsigned)pn * (unsigned)(256 * DEXP) + ks * 512u; return true; }
};

__device__ __forceinline__ float row_rstd(const float* ssp, int row) { const f32x4 p = *(const f32x4*)(ssp + (size_t)row * 4); return 1.0f / sqrtf(((p[0] + p[1]) + (p[2] + p[3])) * (1.0f / D) + EPS); }
__device__ __forceinline__ void row_rstd8(const float* ssp, int row0, float (&rs)[2][4]) {
    f32x4 p[2][4];
#pragma unroll
    for (int ai = 0; ai < 2; ++ai)
#pragma unroll
        for (int m = 0; m < 4; ++m) p[ai][m] = *(const f32x4*)(ssp + (size_t)(row0 + ai * 128 + m * 16) * 4);
#pragma unroll
    for (int ai = 0; ai < 2; ++ai)
#pragma unroll
        for (int m = 0; m < 4; ++m) rs[ai][m] = 1.0f / sqrtf(((p[ai][m][0] + p[ai][m][1]) + (p[ai][m][2] + p[ai][m][3])) * (1.0f / D) + EPS);
}
struct StoreMap { int src4, srow, sgrp; };
__device__ __forceinline__ StoreMap store_map(int fr, int fq) { StoreMap sm; sm.src4 = ((((fr & 3) << 4) | (fq << 2) | (fr >> 2)) << 2); sm.srow = (fq << 2) | (fr >> 2); sm.sgrp = fr & 3; return sm; }
__device__ __forceinline__ u32x4 perm_q(const StoreMap& sm, u32x4 w) { u32x4 r;
    r.x = (unsigned)__builtin_amdgcn_ds_bpermute(sm.src4, (int)w.x); r.y = (unsigned)__builtin_amdgcn_ds_bpermute(sm.src4, (int)w.y);
    r.z = (unsigned)__builtin_amdgcn_ds_bpermute(sm.src4, (int)w.z); r.w = (unsigned)__builtin_amdgcn_ds_bpermute(sm.src4, (int)w.w); return r; }
__device__ __forceinline__ u32x2 perm_q(const StoreMap& sm, u32x2 w) { u32x2 r;
    r.x = (unsigned)__builtin_amdgcn_ds_bpermute(sm.src4, (int)w.x); r.y = (unsigned)__builtin_amdgcn_ds_bpermute(sm.src4, (int)w.y); return r; }
struct EpiBf16 {
    static constexpr bool PERM = true;
    bf16* O; int ldc; const float* ssp;
    __device__ __forceinline__ void operator()(const f32x4 (&acc)[2][2][4][2], const Unit& u, int wr, int wc, int fr, int fq) const {
        const int row0 = u.orow * BM + wr * 64 + fr; const StoreMap sm = store_map(fr, fq);
        bf16* const Os = O + (size_t)(u.orow * BM + wr * 64 + sm.srow) * ldc + u.pn * BM + wc * 32 + 8 * sm.sgrp;
        float rsv[2][4]; row_rstd8(ssp, row0, rsv);
#pragma unroll
        for (int ai = 0; ai < 2; ++ai)
#pragma unroll
            for (int m = 0; m < 4; ++m) { bf16* rowp = Os + (size_t)(ai * HALF + m * 16) * ldc;
                const float rs = rsv[ai][m];
#pragma unroll
                for (int bj = 0; bj < 2; ++bj) { const f32x4 v0 = acc[ai][bj][m][0] * rs, v1 = acc[ai][bj][m][1] * rs;
                    u32x4 w; w.x = pk2(v0[0], v0[1]); w.y = pk2(v0[2], v0[3]); w.z = pk2(v1[0], v1[1]); w.w = pk2(v1[2], v1[3]);
                    *(u32x4*)(rowp + bj * HALF) = perm_q(sm, w); } }
    }
};
struct EpiZ0 {
    static constexpr bool PERM = true;
    bf16* O; const float* ropeC; const float* ropeS;
    __device__ __forceinline__ void operator()(const f32x4 (&acc)[2][2][4][2], const Unit& u, int wr, int wc, int fr, int fq) const {
        const int row0 = u.orow * BM + wr * 64 + fr, col0 = u.pn * BM + wc * 32 + 8 * fq;
        const bool rot = u.pn < 4; const float qs = (u.pn < 2) ? 0.08838834764831845f : 1.0f;
        const int i0 = 16 * wc + 4 * fq; const StoreMap sm = store_map(fr, fq);
        bf16* const Os = O + (size_t)(u.orow * BM + wr * 64 + sm.srow) * EVEN_IN + u.pn * BM + wc * 32 + 8 * sm.sgrp;
        f32x4 csv[2][4], snv[2][4];
        if (rot) {
#pragma unroll
            for (int ai = 0; ai < 2; ++ai)
#pragma unroll
                for (int m = 0; m < 4; ++m) { const int pos = (row0 + ai * HALF + m * 16) & (SEQ - 1); csv[ai][m] = *(const f32x4*)(ropeC + (size_t)pos * 64 + i0); snv[ai][m] = *(const f32x4*)(ropeS + (size_t)pos * 64 + i0); } }
#pragma unroll
        for (int ai = 0; ai < 2; ++ai)
#pragma unroll
            for (int m = 0; m < 4; ++m) { bf16* rowp = Os + (size_t)(ai * HALF + m * 16) * EVEN_IN;
                f32x4 cs = {1.f, 1.f, 1.f, 1.f}, sn = {0.f, 0.f, 0.f, 0.f};
                if (rot) { cs = csv[ai][m]; sn = snv[ai][m]; }
#pragma unroll
                for (int bj = 0; bj < 2; ++bj) { f32x4 v0 = acc[ai][bj][m][0], v1 = acc[ai][bj][m][1];
                    if (rot) { f32x4 r0, r1;
                        r0[0] = (v0[0] * cs[0] - v0[1] * sn[0]) * qs; r0[1] = (v0[1] * cs[0] + v0[0] * sn[0]) * qs;
                        r0[2] = (v0[2] * cs[1] - v0[3] * sn[1]) * qs; r0[3] = (v0[3] * cs[1] + v0[2] * sn[1]) * qs;
                        r1[0] = (v1[0] * cs[2] - v1[1] * sn[2]) * qs; r1[1] = (v1[1] * cs[2] + v1[0] * sn[2]) * qs;
                        r1[2] = (v1[2] * cs[3] - v1[3] * sn[3]) * qs; r1[3] = (v1[3] * cs[3] + v1[2] * sn[3]) * qs;
                        v0 = r0; v1 = r1; }
                    u32x4 w; w.x = pk2(v0[0], v0[1]); w.y = pk2(v0[2], v0[3]); w.z = pk2(v1[0], v1[1]); w.w = pk2(v1[2], v1[3]);
                    *(u32x4*)(rowp + bj * HALF) = perm_q(sm, w); } }
    }
};
struct EpiSwiGLU {
    static constexpr bool PERM = true;
    bf16* O; int ldc; const float* ssp;
    __device__ __forceinline__ void operator()(const f32x4 (&acc)[2][2][4][2], const Unit& u, int wr, int wc, int fr, int fq) const {
        const int row0 = u.orow * BM + wr * 64 + fr; const StoreMap sm = store_map(fr, fq);
        bf16* const Os = O + (size_t)(u.orow * BM + wr * 64 + sm.srow) * ldc + u.pn * HALF + wc * 32 + 8 * sm.sgrp;
        float rsv[2][4]; row_rstd8(ssp, row0, rsv);
        u32x4 pprev = {0u, 0u, 0u, 0u}; bf16* rprev = Os;
#pragma unroll
        for (int ai = 0; ai < 2; ++ai)
#pragma unroll
            for (int m = 0; m < 4; ++m) { bf16* rowp = Os + (size_t)(ai * HALF + m * 16) * ldc;
                const float rs = rsv[ai][m];
                const f32x4 g0 = acc[ai][0][m][0] * rs, g1 = acc[ai][0][m][1] * rs, u0 = acc[ai][1][m][0] * rs, u1 = acc[ai][1][m][1] * rs;
                const f32x2 y0 = swiglu2((f32x2){g0[0], g0[1]}, (f32x2){u0[0], u0[1]}), y1 = swiglu2((f32x2){g0[2], g0[3]}, (f32x2){u0[2], u0[3]});
                const f32x2 y2 = swiglu2((f32x2){g1[0], g1[1]}, (f32x2){u1[0], u1[1]}), y3 = swiglu2((f32x2){g1[2], g1[3]}, (f32x2){u1[2], u1[3]});
                u32x4 w; w.x = pk2(y0.x, y0.y); w.y = pk2(y1.x, y1.y); w.z = pk2(y2.x, y2.y); w.w = pk2(y3.x, y3.y);
                const u32x4 pw = perm_q(sm, w);
                if (ai + m > 0) *(u32x4*)rprev = pprev;
                pprev = pw; rprev = rowp; }
        *(u32x4*)rprev = pprev;
    }
};
template <bool RS> struct EpiSwiGLU8 {
    static constexpr bool PERM = true;
    unsigned char* O; int ldc; const float* ssp;
    __device__ __forceinline__ void operator()(const f32x4 (&acc)[2][2][4][2], const Unit& u, int wr, int wc, int fr, int fq) const {
        const StoreMap sm = store_map(fr, fq);
        unsigned char* const Os = O + (size_t)(u.orow * BM + wr * 64 + sm.srow) * ldc + u.pn * HALF + wc * 32 + 8 * sm.sgrp;
        float rsv[2][4]; if constexpr (RS) row_rstd8(ssp, u.orow * BM + wr * 64 + fr, rsv);
        u32x2 pprev = {0u, 0u}; unsigned char* rprev = Os;
#pragma unroll
        for (int ai = 0; ai < 2; ++ai)
#pragma unroll
            for (int m = 0; m < 4; ++m) { unsigned char* rowp = Os + (size_t)(ai * HALF + m * 16) * ldc;
                f32x4 g0 = acc[ai][0][m][0], g1 = acc[ai][0][m][1], u0 = acc[ai][1][m][0], u1 = acc[ai][1][m][1];
                if constexpr (RS) { const float rs = rsv[ai][m]; g0 = g0 * rs; g1 = g1 * rs; u0 = u0 * rs; u1 = u1 * rs; }
                const f32x2 y0 = swiglu2((f32x2){g0[0], g0[1]}, (f32x2){u0[0], u0[1]}), y1 = swiglu2((f32x2){g0[2], g0[3]}, (f32x2){u0[2], u0[3]});
                const f32x2 y2 = swiglu2((f32x2){g1[0], g1[1]}, (f32x2){u1[0], u1[1]}), y3 = swiglu2((f32x2){g1[2], g1[3]}, (f32x2){u1[2], u1[3]});
                u32x2 w; w.x = pk4_fp8(y0.x, y0.y, y1.x, y1.y); w.y = pk4_fp8(y2.x, y2.y, y3.x, y3.y);
                const u32x2 pw = perm_q(sm, w);
                if (ai + m > 0) *(u32x2*)rprev = pprev;
                pprev = pw; rprev = rowp; }
        *(u32x2*)rprev = pprev;
    }
};
struct EpiBf16S {
    static constexpr bool PERM = true;
    bf16* O; int ldc; float scale;
    __device__ __forceinline__ void operator()(const f32x4 (&acc)[2][2][4][2], const Unit& u, int wr, int wc, int fr, int fq) const {
        const StoreMap sm = store_map(fr, fq);
        bf16* const Os = O + (size_t)(u.orow * BM + wr * 64 + sm.srow) * ldc + u.pn * BM + wc * 32 + 8 * sm.sgrp;
#pragma unroll
        for (int ai = 0; ai < 2; ++ai)
#pragma unroll
            for (int m = 0; m < 4; ++m) { bf16* rowp = Os + (size_t)(ai * HALF + m * 16) * ldc;
#pragma unroll
                for (int bj = 0; bj < 2; ++bj) { const f32x4 v0 = acc[ai][bj][m][0] * scale, v1 = acc[ai][bj][m][1] * scale;
                    u32x4 w; w.x = pk2(v0[0], v0[1]); w.y = pk2(v0[2], v0[3]); w.z = pk2(v1[0], v1[1]); w.w = pk2(v1[2], v1[3]);
                    *(u32x4*)(rowp + bj * HALF) = perm_q(sm, w); } }
    }
};
struct EpiRes {
    static constexpr bool PERM = false;
    const float* base; float* out;
    __device__ __forceinline__ void operator()(const f32x4 (&acc)[2][2][4][2], const Unit& u, int wr, int wc, int fr, int fq) const {
        const int row0 = u.orow * BM + wr * 64 + fr, col0 = u.pn * BM + wc * 32 + 4 * fq;
#pragma unroll
        for (int ai = 0; ai < 2; ++ai)
#pragma unroll
            for (int m = 0; m < 4; ++m) { const size_t off = (size_t)(row0 + ai * HALF + m * 16) * D + col0;
#pragma unroll
                for (int bj = 0; bj < 2; ++bj)
#pragma unroll
                    for (int n = 0; n < 2; ++n) { const f32x4 bs = *(const f32x4*)(base + off + bj * HALF + n * 16); *(f32x4*)(out + off + bj * HALF + n * 16) = bs + acc[ai][bj][m][n]; } }
    }
};
template <int MODE> struct EpiResB {
    static constexpr bool PERM = true;
    const float* base; const bf16* xi; int ldi; bf16* xo; int ldo; float* ssp; LAS float* P; unsigned char* x8;
    __device__ __forceinline__ void load_half(int ai, int row0, int col0, f32x4 (&xf)[4][2][2], u32x4 (&xb)[4][2]) const {
#pragma unroll
        for (int m = 0; m < 4; ++m) { const int row = row0 + ai * HALF + m * 16;
#pragma unroll
            for (int bj = 0; bj < 2; ++bj) {
                if (MODE == 0) { const float* p = base + (size_t)row * D + col0 + bj * HALF; xf[m][bj][0] = *(const f32x4*)p; xf[m][bj][1] = *(const f32x4*)(p + 4); }
                else xb[m][bj] = *(const u32x4*)(xi + (size_t)row * ldi + col0 + bj * HALF); } }
    }
    __device__ __forceinline__ void make_half(const f32x4 (&acc)[2][2][4][2], int ai, const f32x4 (&xf)[4][2][2], const u32x4 (&xb)[4][2], u32x4 (&w)[4][2], float (&sq)[4]) const {
#pragma unroll
        for (int m = 0; m < 4; ++m) { float q = 0.f;
#pragma unroll
            for (int bj = 0; bj < 2; ++bj) { f32x4 h0, h1;
                if (MODE == 0) { h0 = xf[m][bj][0]; h1 = xf[m][bj][1]; }
                else { const u32x4 b = xb[m][bj]; h0 = (f32x4){bf2f(b.x & 0xffffu), bf2f(b.x >> 16), bf2f(b.y & 0xffffu), bf2f(b.y >> 16)}; h1 = (f32x4){bf2f(b.z & 0xffffu), bf2f(b.z >> 16), bf2f(b.w & 0xffffu), bf2f(b.w >> 16)}; }
                h0 = h0 + acc[ai][bj][m][0]; h1 = h1 + acc[ai][bj][m][1];
                u32x4 v; v.x = pk2(h0[0], h0[1]); v.y = pk2(h0[2], h0[3]); v.z = pk2(h1[0], h1[1]); v.w = pk2(h1[2], h1[3]); w[m][bj] = v;
                const float r0 = bf2f(v.x & 0xffffu), r1 = bf2f(v.x >> 16), r2 = bf2f(v.y & 0xffffu), r3 = bf2f(v.y >> 16), r4 = bf2f(v.z & 0xffffu), r5 = bf2f(v.z >> 16), r6 = bf2f(v.w & 0xffffu), r7 = bf2f(v.w >> 16);
                q += ((r0 * r0 + r1 * r1) + (r2 * r2 + r3 * r3)) + ((r4 * r4 + r5 * r5) + (r6 * r6 + r7 * r7)); }
            q += __shfl_xor(q, 16); q += __shfl_xor(q, 32); sq[m] = q; }
    }
    __device__ __forceinline__ void store_half(int ai, int row0, int col0, int wr, int wc, int fr, int fq, const u32x4 (&w)[4][2], const float (&sq)[4]) const {
        const StoreMap sm = store_map(fr, fq); const int srow0 = row0 - fr + sm.srow, scol0 = col0 - 8 * fq + 8 * sm.sgrp;
#pragma unroll
        for (int m = 0; m < 4; ++m) { const int row = srow0 + ai * HALF + m * 16;
#pragma unroll
            for (int bj = 0; bj < 2; ++bj) { const u32x4 v = perm_q(sm, w[m][bj]); *(u32x4*)(xo + (size_t)row * ldo + scol0 + bj * HALF) = v;
                if constexpr (MODE == 0) { u32x2 e; e.x = pk4_fp8(bf2f(v.x & 0xffffu), bf2f(v.x >> 16), bf2f(v.y & 0xffffu), bf2f(v.y >> 16)); e.y = pk4_fp8(bf2f(v.z & 0xffffu), bf2f(v.z >> 16), bf2f(v.w & 0xffffu), bf2f(v.w >> 16));
                    *(u32x2*)(x8 + (size_t)row * D + scol0 + bj * HALF) = e; } }
            if (fq == 0) P[(ai * HALF + wr * 64 + m * 16 + fr) * 4 + wc] = sq[m]; }
    }
    __device__ __forceinline__ void operator()(const f32x4 (&acc)[2][2][4][2], const Unit& u, int wr, int wc, int fr, int fq) const {
        const int row0 = u.orow * BM + wr * 64 + fr, col0 = u.pn * BM + wc * 32 + 8 * fq;
        f32x4 xf[4][2][2]; u32x4 xb0[4][2], xb1[4][2], w[4][2]; float sq[4];
        if (MODE == 1) { load_half(0, row0, col0, xf, xb0); load_half(1, row0, col0, xf, xb1);
            make_half(acc, 0, xf, xb0, w, sq); store_half(0, row0, col0, wr, wc, fr, fq, w, sq);
            make_half(acc, 1, xf, xb1, w, sq); store_half(1, row0, col0, wr, wc, fr, fq, w, sq); }
        else { u32x4 w1[4][2]; float sq1[4];
            load_half(0, row0, col0, xf, xb0); make_half(acc, 0, xf, xb0, w, sq);
            load_half(1, row0, col0, xf, xb0); store_half(0, row0, col0, wr, wc, fr, fq, w, sq);
            make_half(acc, 1, xf, xb0, w1, sq1); store_half(1, row0, col0, wr, wc, fr, fq, w1, sq1); }
        asm volatile("s_waitcnt lgkmcnt(0)" ::: "memory"); __builtin_amdgcn_s_barrier(); asm volatile("" ::: "memory");
        if (wr == 0) { const int r = wc * 64 + fq * 16 + fr; const f32x4 p = *(const LAS f32x4*)(P + r * 4); ssp[(size_t)(u.orow * BM + r) * 4 + u.pn] = (p[0] + p[1]) + (p[2] + p[3]); }
    }
};

template <class Epi, class Sched, bool GATHER, bool ALIGN_EPI, bool SP2, bool FP8 = false>
__device__ __forceinline__ void gemm_phase(LAS unsigned char* lds, const LAS unsigned short* rowtok, const int K, const Sched& S, const Epi& E, const int nt_unit = 0, const int lda = 0) {
    int tid = threadIdx.x; asm volatile("" : "+v"(tid));
    const int wid = __builtin_amdgcn_readfirstlane(tid >> 6), lane = tid & 63, wr = wid >> 2, wc = wid & 3, fr = lane & 15, fq = lane >> 4;
    const int KB = FP8 ? K : 2 * K;
    const int nt = nt_unit ? nt_unit : KB / (BK * 2);
    unsigned voffA[2], voffB[2]; int gR[2], gC[2];
#pragma unroll
    for (int i = 0; i < 2; ++i) { int R, C; stage_rc(tid * 16 + i * 8192, R, C); const int Rb = Epi::PERM ? ((R & ~31) + perm32(R & 31)) : R;
        voffA[i] = (unsigned)(R * (lda ? lda : KB) + C * 2); voffB[i] = (unsigned)(Rb * KB + C * 2); gR[i] = R; gC[i] = C * 2; }
    const unsigned kstep = (unsigned)(BK * 2);
    const unsigned hstep = (unsigned)(HALF * KB), hstepA = (unsigned)(HALF * (lda ? lda : KB));
    const __amdgpu_buffer_rsrc_t rA = __builtin_amdgcn_make_buffer_rsrc((void*)S.Abase, 0, 0xFFFFFFF0u, 0x00020000), rB = __builtin_amdgcn_make_buffer_rsrc((void*)S.Bbase, 0, 0xFFFFFFF0u, 0x00020000);
    const unsigned ldsw = (unsigned)wid * 1024u;
    const int aoff = lds_byte(wr * 64 + fr, fq * 8), boff = lds_byte(wc * 32 + fr, fq * 8);
    unsigned gcur[2][2], gnxt[2][2];
#define PG8_SA(b, h) (((b) * 2 + (h)) * HTB)
#define PG8_SB(b, h) ((4 + (b) * 2 + (h)) * HTB)
#define PG8_STAGE(bufoff, soff, voff) do { _Pragma("unroll") for (int _i = 0; _i < 2; ++_i) \
        __builtin_amdgcn_raw_ptr_buffer_load_lds(rB, (LAS void*)(lds + (bufoff) + ldsw + _i * 8192), 16, (voff)[_i], (soff), 0, 0); } while (0)
#define PG8_STAGE_A(bufoff, soff, h, GV) do { _Pragma("unroll") for (int _i = 0; _i < 2; ++_i) { \
        if constexpr (GATHER) __builtin_amdgcn_raw_ptr_buffer_load_lds(rA, (LAS void*)(lds + (bufoff) + ldsw + _i * 8192), 16, (GV)[h][_i], (soff), 0, 0); \
        else __builtin_amdgcn_raw_ptr_buffer_load_lds(rA, (LAS void*)(lds + (bufoff) + ldsw + _i * 8192), 16, voffA[_i], (soff) + (h) * hstepA, 0, 0); } } while (0)
#define PG8_LDA(dst, b, h) do { _Pragma("unroll") for (int m = 0; m < 4; ++m) { if constexpr (FP8) { const LAS unsigned char* _p = lds + PG8_SA(b, h) + aoff + m * 2048; \
            dst##8[m] = __builtin_shufflevector(*(const LAS i32x4*)_p, *(const LAS i32x4*)(_p + 1024), 0, 1, 2, 3, 4, 5, 6, 7); } \
        else { _Pragma("unroll") for (int k = 0; k < 2; ++k) dst[m][k] = *(const LAS bf16x8*)(lds + PG8_SA(b, h) + aoff + m * 2048 + k * 1024); } } } while (0)
#define PG8_LDB(dst, b, h) do { _Pragma("unroll") for (int n = 0; n < 2; ++n) { if constexpr (FP8) { const LAS unsigned char* _p = lds + PG8_SB(b, h) + boff + n * 2048; \
            dst##8[n] = __builtin_shufflevector(*(const LAS i32x4*)_p, *(const LAS i32x4*)(_p + 1024), 0, 1, 2, 3, 4, 5, 6, 7); } \
        else { _Pragma("unroll") for (int k = 0; k < 2; ++k) dst[n][k] = *(const LAS bf16x8*)(lds + PG8_SB(b, h) + boff + n * 2048 + k * 1024); } } } while (0)
#define PG8_MMA(ai, bj, At, Bt) do { __builtin_amdgcn_s_setprio(1); _Pragma("unroll") for (int m = 0; m < 4; ++m) _Pragma("unroll") for (int n = 0; n < 2; ++n) { \
        if constexpr (FP8) { asm volatile("v_mfma_scale_f32_16x16x128_f8f6f4 %0, %1, %2, %0, %3, %4 op_sel_hi:[0,0,0]" : "+v"(acc[ai][bj][m][n]) : "v"(Bt##8[n]), "v"(At##8[m]), "v"(scw), "v"(sc1)); } \
        else { _Pragma("unroll") for (int k = 0; k < 2; ++k) acc[ai][bj][m][n] = __builtin_amdgcn_mfma_f32_16x16x32_bf16(Bt[n][k], At[m][k], acc[ai][bj][m][n], 0, 0, 0); } } \
        __builtin_amdgcn_s_setprio(0); } while (0)
#define PG8_WAIT_V(n) asm volatile("s_waitcnt vmcnt(" #n ")" ::: "memory")
#define PG8_WAIT_L(n) asm volatile("s_waitcnt lgkmcnt(" #n ")" ::: "memory")
#define PG8_BAR __builtin_amdgcn_s_barrier()
#define PG8_SCHED __builtin_amdgcn_sched_barrier(0)
#define PG8_GLOAD(G, ord) do { if constexpr (GATHER) { _Pragma("unroll") for (int _h = 0; _h < 2; ++_h) _Pragma("unroll") for (int _i = 0; _i < 2; ++_i) \
        G[_h][_i] = (unsigned)rowtok[(ord) * 256 + _h * HALF + gR[_i]] * (unsigned)KB + (unsigned)gC[_i]; } } while (0)
    LAS int* const ucache = (LAS int*)(lds + 147456);
    if (tid < 32) { Unit u; u.pm = 0; u.pn = 0; u.orow = 0; u.ao = 0u; u.bo = 0u; const bool ok = S.next(tid, u);
        *(LAS i32x4*)(ucache + 8 * tid) = (i32x4){ok ? 1 : 0, u.pm, u.pn, u.orow}; *(LAS i32x4*)(ucache + 8 * tid + 4) = (i32x4){(int)u.ao, (int)u.bo, 0, 0}; }
    asm volatile("s_waitcnt lgkmcnt(0)" ::: "memory"); __builtin_amdgcn_s_barrier(); asm volatile("" ::: "memory");
#define PG8_NEXT(k, U) ([&]() -> bool { if ((k) >= 32) return false; const i32x4 _a = *(const LAS i32x4*)(ucache + 8 * (k)), _b = *(const LAS i32x4*)(ucache + 8 * (k) + 4); \
        (U).pm = __builtin_amdgcn_readfirstlane(_a[1]); (U).pn = __builtin_amdgcn_readfirstlane(_a[2]); (U).orow = __builtin_amdgcn_readfirstlane(_a[3]); \
        (U).ao = (unsigned)__builtin_amdgcn_readfirstlane(_b[0]); (U).bo = (unsigned)__builtin_amdgcn_readfirstlane(_b[1]); return __builtin_amdgcn_readfirstlane(_a[0]) != 0; }())
    Unit cur, nxt; int ui = 0;
    if (!PG8_NEXT(0, cur)) return;
    f32x4 acc[2][2][4][2];
#pragma unroll
    for (int a = 0; a < 2; ++a)
#pragma unroll
        for (int b = 0; b < 2; ++b)
#pragma unroll
            for (int m = 0; m < 4; ++m)
#pragma unroll
                for (int n = 0; n < 2; ++n) { acc[a][b][m][n] = (f32x4){0.f, 0.f, 0.f, 0.f}; if constexpr (FP8) asm volatile("" : "+v"(acc[a][b][m][n])); }
    bf16x8 At[4][2], B0[2][2], B1[2][2]; i32x8 At8[4], B08[2], B18[2];
    int sc1 = 0x7f7f7f7f, scw = 0x79797979; asm volatile("" : "+v"(sc1), "+v"(scw));
    unsigned cA = cur.ao, cB = cur.bo;
#pragma unroll
    for (int h = 0; h < 2; ++h)
#pragma unroll
        for (int i = 0; i < 2; ++i) { gcur[h][i] = 0u; gnxt[h][i] = 0u; }
    PG8_GLOAD(gcur, 0);
    if constexpr (SP2) {
        PG8_STAGE(PG8_SB(0, 0), cB, voffB); PG8_STAGE(PG8_SB(0, 1), cB + hstep, voffB); PG8_STAGE_A(PG8_SA(0, 0), cA, 0, gcur); PG8_STAGE_A(PG8_SA(0, 1), cA, 1, gcur);
        if (wr == 1) PG8_BAR;
        PG8_WAIT_V(2); PG8_BAR;
        PG8_STAGE(PG8_SB(1, 0), cB + kstep, voffB); PG8_STAGE_A(PG8_SA(1, 0), cA + kstep, 0, gcur); PG8_STAGE(PG8_SB(1, 1), cB + hstep + kstep, voffB);
        PG8_WAIT_V(6); PG8_BAR;
    } else {
        PG8_STAGE(PG8_SB(0, 0), cB, voffB); PG8_STAGE_A(PG8_SA(0, 0), cA, 0, gcur); PG8_STAGE(PG8_SB(0, 1), cB + hstep, voffB); PG8_STAGE_A(PG8_SA(0, 1), cA, 1, gcur);
        if (wr == 1) PG8_BAR;
        PG8_WAIT_V(4); PG8_BAR;
        PG8_STAGE(PG8_SB(1, 0), cB + kstep, voffB); PG8_STAGE_A(PG8_SA(1, 0), cA + kstep, 0, gcur); PG8_STAGE(PG8_SB(1, 1), cB + hstep + kstep, voffB);
        PG8_WAIT_V(6); PG8_BAR;
    }
    for (;;) {
        const bool has_next = PG8_NEXT(ui + 1, nxt);
        const unsigned nA = has_next ? nxt.ao : cA, nB = has_next ? nxt.bo : cB;
#pragma nounroll
        for (int t = 0; t < nt; t += 2) {
            const bool last = (t == nt - 2);
            const unsigned a1 = cA + (unsigned)(t + 1) * kstep;
            const unsigned a2 = last ? nA : cA + (unsigned)(t + 2) * kstep, b2 = last ? nB : cB + (unsigned)(t + 2) * kstep;
            const unsigned a3 = a2 + kstep, b3 = b2 + kstep;
            unsigned g2[2][2];
            if constexpr (GATHER) {
                if (last && has_next) { PG8_GLOAD(gnxt, ui + 1); }
#pragma unroll
                for (int h = 0; h < 2; ++h)
#pragma unroll
                    for (int i = 0; i < 2; ++i) g2[h][i] = (last && has_next) ? gnxt[h][i] : gcur[h][i];
            }
            if constexpr (SP2) {
            PG8_LDB(B0, 0, 0); PG8_LDB(B1, 0, 1); PG8_SCHED; PG8_LDA(At, 0, 0); PG8_STAGE_A(PG8_SA(1, 1), a1, 1, gcur);
            PG8_BAR; PG8_MMA(0, 0, At, B0); PG8_MMA(0, 1, At, B1); PG8_WAIT_V(8); PG8_BAR; PG8_SCHED;
            PG8_LDA(At, 0, 1); PG8_STAGE(PG8_SB(0, 0), b2, voffB); PG8_STAGE(PG8_SB(0, 1), b2 + hstep, voffB); PG8_STAGE_A(PG8_SA(0, 0), a2, 0, g2);
            PG8_BAR; PG8_MMA(1, 0, At, B0); PG8_MMA(1, 1, At, B1); PG8_WAIT_V(8); PG8_BAR; PG8_SCHED;
            PG8_LDB(B0, 1, 0); PG8_LDB(B1, 1, 1); PG8_SCHED; PG8_LDA(At, 1, 0); PG8_STAGE_A(PG8_SA(0, 1), a2, 1, g2);
            PG8_BAR; PG8_MMA(0, 0, At, B0); PG8_MMA(0, 1, At, B1); PG8_WAIT_V(8); PG8_BAR; PG8_SCHED;
            PG8_LDA(At, 1, 1); PG8_STAGE(PG8_SB(1, 0), b3, voffB); PG8_STAGE(PG8_SB(1, 1), b3 + hstep, voffB); PG8_STAGE_A(PG8_SA(1, 0), a3, 0, g2);
            PG8_BAR; PG8_MMA(1, 0, At, B0); PG8_MMA(1, 1, At, B1); PG8_WAIT_V(8); PG8_BAR; PG8_SCHED;
            } else {
            PG8_LDB(B0, 0, 0); PG8_SCHED; PG8_LDA(At, 0, 0); PG8_STAGE_A(PG8_SA(1, 1), a1, 1, gcur);
            PG8_WAIT_L(8); PG8_BAR; PG8_WAIT_L(0); PG8_MMA(0, 0, At, B0); PG8_BAR; PG8_SCHED;
            PG8_LDB(B1, 0, 1); PG8_STAGE(PG8_SB(0, 0), b2, voffB);
            PG8_BAR; PG8_WAIT_L(0); PG8_MMA(0, 1, At, B1); PG8_BAR;
            PG8_LDA(At, 0, 1); PG8_STAGE_A(PG8_SA(0, 0), a2, 0, g2);
            PG8_BAR; PG8_WAIT_L(0); PG8_MMA(1, 0, At, B0); PG8_BAR; PG8_SCHED;
            PG8_STAGE(PG8_SB(0, 1), b2 + hstep, voffB);
            PG8_WAIT_V(6); PG8_BAR; PG8_MMA(1, 1, At, B1); PG8_BAR;
            PG8_LDB(B0, 1, 0); PG8_SCHED; PG8_LDA(At, 1, 0); PG8_STAGE_A(PG8_SA(0, 1), a2, 1, g2);
            PG8_WAIT_L(8); PG8_BAR; PG8_WAIT_L(0); PG8_MMA(0, 0, At, B0); PG8_BAR; PG8_SCHED;
            PG8_LDB(B1, 1, 1); PG8_STAGE(PG8_SB(1, 0), b3, voffB);
            PG8_BAR; PG8_WAIT_L(0); PG8_MMA(0, 1, At, B1); PG8_BAR;
            PG8_LDA(At, 1, 1); PG8_STAGE_A(PG8_SA(1, 0), a3, 0, g2);
            PG8_BAR; PG8_WAIT_L(0); PG8_MMA(1, 0, At, B0); PG8_BAR; PG8_SCHED;
            PG8_STAGE(PG8_SB(1, 1), b3 + hstep, voffB);
            PG8_WAIT_V(6); PG8_BAR; PG8_MMA(1, 1, At, B1); PG8_BAR;
            }
        }
        if constexpr (ALIGN_EPI) { if (wr == 0) PG8_BAR; }
        if constexpr (FP8) asm volatile("s_nop 15\n\ts_nop 15" ::: "memory");
        E(acc, cur, wr, wc, fr, fq);
        if (!has_next) break;
#pragma unroll
        for (int a = 0; a < 2; ++a)
#pragma unroll
            for (int b = 0; b < 2; ++b)
#pragma unroll
                for (int m = 0; m < 4; ++m)
#pragma unroll
                    for (int n = 0; n < 2; ++n) { acc[a][b][m][n] = (f32x4){0.f, 0.f, 0.f, 0.f}; if constexpr (FP8) asm volatile("" : "+v"(acc[a][b][m][n])); }
        cur = nxt; cA = nA; cB = nB; ++ui;
        if constexpr (GATHER) {
#pragma unroll
            for (int h = 0; h < 2; ++h)
#pragma unroll
                for (int i = 0; i < 2; ++i) gcur[h][i] = gnxt[h][i];
        }
        if constexpr (ALIGN_EPI) { if (wr == 1) PG8_BAR; }
    }
    PG8_WAIT_V(0);
    if constexpr (!ALIGN_EPI) { if (wr == 0) PG8_BAR; }
    PG8_BAR;
#undef PG8_SA
#undef PG8_SB
#undef PG8_STAGE
#undef PG8_STAGE_A
#undef PG8_LDA
#undef PG8_LDB
#undef PG8_MMA
#undef PG8_WAIT_V
#undef PG8_WAIT_L
#undef PG8_BAR
#undef PG8_SCHED
#undef PG8_GLOAD
#undef PG8_NEXT
}
}

#define XB_TMO      128
#define XB_XCNT(j)  (256  + 64 * (j))
#define XB_XSUB(j)  (1280 + 64 * (j))
#define XB_XGEN(j)  (2304 + 64 * (j))
#define XB_TOP      3328
#define XB_TOPGEN   3392
#define XCD_BAR_WORDS 3456
#define XB_SPIN_CAP (1u << 22)

__device__ __forceinline__ unsigned xb_ld(unsigned* p)              { return __hip_atomic_load(p, __ATOMIC_RELAXED, __HIP_MEMORY_SCOPE_AGENT); }
__device__ __forceinline__ unsigned xb_add(unsigned* p, unsigned v) { return __hip_atomic_fetch_add(p, v, __ATOMIC_RELAXED, __HIP_MEMORY_SCOPE_AGENT); }
__device__ __forceinline__ unsigned xb_xcc_id() { return (unsigned)__builtin_amdgcn_s_getreg((3 << 11) | 20) & 0xFu; }
#define XB_SPIN(cond, bar) do { unsigned _sp = 0; while (cond) { __builtin_amdgcn_s_sleep(1); \
    if ((++_sp & 255u) == 0u) { if (xb_ld(&(bar)[XB_TMO])) break; if (_sp > XB_SPIN_CAP) { atomicAdd(&(bar)[XB_TMO], 1u); break; } } } } while (0)

struct XcdBarrier { unsigned* bar; unsigned x; volatile LAS unsigned* st; };

__device__ __forceinline__ XcdBarrier xcd_barrier_post(unsigned* bar, volatile LAS unsigned* st) {
    XcdBarrier b; b.bar = bar; b.x = xb_xcc_id(); b.st = st;
    if (threadIdx.x == 0) (void)xb_add(&bar[XB_XCNT(b.x)], 1u);
    return b;
}
__device__ __forceinline__ void xcd_barrier_complete(unsigned* bar, unsigned x, unsigned& nloc, unsigned& nx) {
    const unsigned G = gridDim.x * gridDim.y * gridDim.z;
    unsigned sum, cnt, mine, sp = 0u;
    for (;;) {
        sum = 0u; cnt = 0u; mine = 0u;
#pragma unroll
        for (unsigned j = 0; j < 16; ++j) { const unsigned c = xb_ld(&bar[XB_XCNT(j)]); sum += c; cnt += (c > 0u) ? 1u : 0u; mine = (j == x) ? c : mine; }
        if (sum == G) break;
        __builtin_amdgcn_s_sleep(1);
        if ((++sp & 255u) == 0u) { if (xb_ld(&bar[XB_TMO])) break; if (sp > XB_SPIN_CAP) { atomicAdd(&bar[XB_TMO], 1u); break; } }
    }
    nloc = mine > 0u ? mine : 1u; nx = cnt > 0u ? cnt : 1u;
}
__device__ __forceinline__ void xcd_barrier(const XcdBarrier& b) {
    asm volatile("s_waitcnt vmcnt(0)" ::: "memory");
    __syncthreads();
    if (threadIdx.x == 0) {
        unsigned* bar = b.bar;
        __builtin_amdgcn_s_waitcnt(0);
        unsigned nloc = b.st[0], nx = b.st[1];
        if (nloc == 0u) { xcd_barrier_complete(bar, b.x, nloc, nx); b.st[0] = nloc; b.st[1] = nx; }
        const unsigned old = xb_add(&bar[XB_XSUB(b.x)], 1u);
        const unsigned gen = old / nloc;
        if (old + 1u == (gen + 1u) * nloc) {
            __builtin_amdgcn_fence(__ATOMIC_RELEASE, "agent");
            asm volatile("s_waitcnt vmcnt(0)" ::: "memory");
            const unsigned og = xb_add(&bar[XB_TOP], 1u);
            const unsigned tg = og / nx;
            if (og + 1u == (tg + 1u) * nx) xb_add(&bar[XB_TOPGEN], 1u);
            else XB_SPIN(xb_ld(&bar[XB_TOPGEN]) == tg, bar);
            __builtin_amdgcn_fence(__ATOMIC_ACQUIRE, "agent");
            asm volatile("s_waitcnt vmcnt(0)" ::: "memory");
        } else {
            XB_SPIN(xb_ld(&bar[XB_TOPGEN]) == gen, bar);
            __builtin_amdgcn_fence(__ATOMIC_ACQUIRE, "agent");
            asm volatile("s_waitcnt vmcnt(0)" ::: "memory");
        }
    }
    __syncthreads();
}

struct Args { const float* in[27]; float* out; unsigned char* ws; };
enum { I_X = 0, I_E_NORM_MIX, I_E_W_IN, I_E_RET_GN, I_E_DW_W, I_E_DW_B, I_E_CV_LN_G, I_E_CV_LN_B, I_E_W_OUT, I_E_NORM_FFN, I_E_FFN_GATE, I_E_FFN_UP, I_E_FFN_DOWN,
       I_O_NORM_MIX, I_O_W_IN, I_O_SG_LN_G, I_O_SG_LN_B, I_O_SG_W, I_O_SG_B, I_O_SC_W, I_O_W_OUT, I_O_NORM_FFN, I_O_ROUTER, I_O_EXP_GATE, I_O_EXP_UP, I_O_EXP_DOWN, I_FINAL_NORM };

struct Frame {
    LAS unsigned char* lds;
    int tid, lane, wave, vcu, G;
};
__device__ __forceinline__ void refresh(Frame& F) { int t = threadIdx.x; asm volatile("" : "+v"(t)); F.tid = t; F.lane = t & 63; F.wave = __builtin_amdgcn_readfirstlane(t >> 6); }
struct PT {
    volatile LAS unsigned* tab;
    __device__ __forceinline__ const void* p(int i) const { const unsigned lo = __builtin_amdgcn_readfirstlane(tab[2 * i]), hi = __builtin_amdgcn_readfirstlane(tab[2 * i + 1]); return (const void*)(const GAS char*)(((unsigned long long)hi << 32) | lo); }
    __device__ __forceinline__ const float* in(int i) const { return (const float*)p(i); }
};

struct CvtItem { const float* src; int N; unsigned char* dst; int Kb; int f8; int perm; int goff; float scale; };
__device__ __forceinline__ void cvt_make(CvtItem& d, const float* W, const float* W2, int K, int N, int mode, unsigned char* WT, int f8, int item, int gsel = -1) {
    const int nout = (mode == 2) ? 2 * N : N, KT = 128;
    const int nblk = nout / 128, kb = item / nblk, nb = item % nblk, k0 = KT * kb, n0 = 128 * nb;
    const float* src = W; int col0 = n0;
    d.scale = 1.0f;
    if (mode == 2) { src = (nb & 1) ? W2 : W; col0 = 128 * (nb >> 1); d.scale = (nb & 1) ? -0.6931471805599453f : -1.4426950408889634f; }
    d.src = src + (size_t)k0 * N + col0; d.N = N; d.f8 = f8; d.Kb = f8 ? K : 2 * K; d.perm = (mode == 1 && n0 < 1024) ? 1 : 0;
    d.dst = WT + (size_t)n0 * d.Kb + (size_t)k0 * (f8 ? 1 : 2); d.goff = gsel >= 0 ? gsel * 1024 + k0 : -1;
}
struct CvtPtrs { const float *ein, *eout, *fg, *fu, *fd, *oin, *oout, *xg, *xu, *xd, *g_ffn, *g_omix; };
constexpr int CV_I0 = (D / 128) * (EVEN_IN / 128), CV_I1 = (D / 128) * (D / 128), CV_I2 = (D / 128) * (2 * DFF / 128), CV_I3 = (DFF / 128) * (D / 128), CV_I4 = (D / 128) * (ODD_IN / 128), CV_I5 = CV_I1;
constexpr int CV_SMALL = CV_I0 + CV_I1 + CV_I2 + CV_I3 + CV_I4 + CV_I5;
constexpr int CV_IG = (D / 128) * (2 * DEXP / 128), CV_ID = (DEXP / 128) * (D / 128), CV_IE = CV_IG + CV_ID;
constexpr int CV_TOTAL = CV_SMALL + NEXP * CV_IE;
__device__ __forceinline__ void cvt_decode(CvtItem& d, const CvtPtrs& P, unsigned char* ws, int it) {
    int r = it;
    if (r < NEXP * CV_IE) {
        const int e = r / CV_IE; r -= e * CV_IE;
        if (r < CV_IG) cvt_make(d, P.xg + (size_t)e * D * DEXP, P.xu + (size_t)e * D * DEXP, D, DEXP, 2, ws + WS_WGU8 + (size_t)e * EXP_GU_BYTES, 1, r);
        else cvt_make(d, P.xd + (size_t)e * DEXP * D, nullptr, DEXP, D, 0, ws + WS_WDN8 + (size_t)e * EXP_DN_BYTES, 1, r - CV_IG);
        return; }
    r -= NEXP * CV_IE;
    if (r < CV_I0) { cvt_make(d, P.ein, nullptr, D, EVEN_IN, 1, ws + WS_W_EIN, 0, r); return; } r -= CV_I0;
    if (r < CV_I1) { cvt_make(d, P.eout, nullptr, D, D, 0, ws + WS_W_EOUT, 0, r); return; } r -= CV_I1;
    if (r < CV_I2) { cvt_make(d, P.fg, P.fu, D, DFF, 2, ws + WS_W_FGU, 1, r, 0); return; } r -= CV_I2;
    if (r < CV_I3) { cvt_make(d, P.fd, nullptr, DFF, D, 0, ws + WS_W_FDN, 1, r); return; } r -= CV_I3;
    if (r < CV_I4) { cvt_make(d, P.oin, nullptr, D, ODD_IN, 0, ws + WS_W_OIN, 0, r, 1); return; } r -= CV_I4;
    cvt_make(d, P.oout, nullptr, D, D, 0, ws + WS_W_OOUT, 0, r);
}
constexpr int CV_LD = 132;
constexpr int CV_GT = 69632;
__device__ __forceinline__ void cvt_load(const CvtItem& d, f32x4 (&v)[8], int tid) {
    const int c4 = tid & 31, kr = tid >> 5;
#pragma unroll
    for (int i = 0; i < 8; ++i) v[i] = __builtin_nontemporal_load((const f32x4*)(d.src + (size_t)(kr + 16 * i) * d.N + 4 * c4));
}
__device__ __forceinline__ void cvt_store(const CvtItem& d, const f32x4 (&v)[8], LAS float* tile, const LAS float* gt, int tid) {
    const int c4 = tid & 31, kr = tid >> 5;
#pragma unroll
    for (int i = 0; i < 8; ++i) { const float g = (d.goff >= 0 ? gt[d.goff + kr + 16 * i] : 1.0f) * d.scale; *(LAS f32x4*)(tile + (kr + 16 * i) * CV_LD + 4 * c4) = v[i] * g; }
    WG_SYNC();
    const int nl = tid & 127, q = tid >> 7; const int c = d.perm ? ((nl >> 1) + 64 * (nl & 1)) : nl;
    if (d.f8) { const LAS float* s = tile + (32 * q) * CV_LD + c; u32x4 o0, o1;
#pragma unroll
        for (int j = 0; j < 4; ++j) { o0[j] = pk4_fp8(s[(4 * j) * CV_LD] * W8_SCALE, s[(4 * j + 1) * CV_LD] * W8_SCALE, s[(4 * j + 2) * CV_LD] * W8_SCALE, s[(4 * j + 3) * CV_LD] * W8_SCALE);
            o1[j] = pk4_fp8(s[(16 + 4 * j) * CV_LD] * W8_SCALE, s[(16 + 4 * j + 1) * CV_LD] * W8_SCALE, s[(16 + 4 * j + 2) * CV_LD] * W8_SCALE, s[(16 + 4 * j + 3) * CV_LD] * W8_SCALE); }
        unsigned char* o = d.dst + (size_t)nl * d.Kb + 32 * q; *(u32x4*)o = o0; *(u32x4*)(o + 16) = o1; }
    else { const LAS float* s = tile + (32 * q) * CV_LD + c; unsigned char* o = d.dst + (size_t)nl * d.Kb + 64 * q;
#pragma unroll
        for (int h = 0; h < 4; ++h) {
            u32x4 w; w.x = pk2(s[(8 * h) * CV_LD], s[(8 * h + 1) * CV_LD]); w.y = pk2(s[(8 * h + 2) * CV_LD], s[(8 * h + 3) * CV_LD]);
            w.z = pk2(s[(8 * h + 4) * CV_LD], s[(8 * h + 5) * CV_LD]); w.w = pk2(s[(8 * h + 6) * CV_LD], s[(8 * h + 7) * CV_LD]);
            *(u32x4*)(o + 16 * h) = w; } }
    WG_SYNC();
}
__device__ __forceinline__ void sincos_d(double a, float& s, float& c) {
    const double k = __builtin_rint(a * 0.63661977236758134308);
    double r = __builtin_fma(-k, 1.57079632679489655800e+00, a); r = __builtin_fma(-k, 6.12323399573676603587e-17, r);
    const double r2 = r * r;
    double sp = 1.0 / 6227020800.0; sp = sp * r2 - 1.0 / 39916800.0; sp = sp * r2 + 1.0 / 362880.0; sp = sp * r2 - 1.0 / 5040.0; sp = sp * r2 + 1.0 / 120.0; sp = sp * r2 - 1.0 / 6.0; sp = sp * r2 + 1.0; sp = sp * r;
    double cp = 1.0 / 87178291200.0; cp = cp * r2 - 1.0 / 479001600.0; cp = cp * r2 + 1.0 / 3628800.0; cp = cp * r2 - 1.0 / 40320.0; cp = cp * r2 + 1.0 / 720.0; cp = cp * r2 - 1.0 / 24.0; cp = cp * r2 + 0.5; cp = 1.0 - cp * r2;
    const int q = (int)((long long)k & 3);
    const double ss = (q == 0) ? sp : (q == 1) ? cp : (q == 2) ? -sp : -cp;
    const double cc = (q == 0) ? cp : (q == 1) ? -sp : (q == 2) ? -cp : sp;
    s = (float)ss; c = (float)cc;
}

struct RopeJob { double f; int gt, NGT, done; };
__device__ __forceinline__ void rope_init(RopeJob& r, const Frame& F) { r.gt = F.vcu * NTHR + F.tid; r.NGT = F.G * NTHR; r.done = 0;
    double f = 1.0; const int i = r.gt & 63; for (int j = 0; j < i; ++j) f *= 0.8659643233600653; r.f = f; }
__device__ __forceinline__ void rope_step(RopeJob& r, unsigned char* ws) {
    const int idx = r.gt + r.done * r.NGT; ++r.done; if (idx >= SEQ * 64) return;
    float* rc = (float*)(ws + WS_ROPE); float* rs = rc + (size_t)SEQ * 64;
    float s, c; sincos_d((double)(idx >> 6) * r.f, s, c); rc[idx] = c; rs[idx] = s; }
__device__ __forceinline__ void misc_tables(Frame& F, const PT& a, unsigned char* ws, RopeJob& rj) {
    const int gt = F.vcu * NTHR + F.tid, NGT = F.G * NTHR;
    while (rj.gt + rj.done * rj.NGT < SEQ * 64) rope_step(rj, ws);
    bf16* sg = (bf16*)(ws + WS_SGW); const float* sw = a.in(I_O_SG_W);
    for (int idx = gt; idx < 4 * 128 * 128; idx += NGT) { const int p = (idx >> 7) & 127, q = idx & 127; sg[idx] = (bf16)f2bf(((p >> 6) >= (q >> 6)) ? sw[idx] : 0.0f); }
}

__device__ __forceinline__ void convert_weights(Frame& F, const PT& a, unsigned char* ws, int it0, int it1, RopeJob& rj) {
    LAS float* tile = (LAS float*)F.lds; LAS float* gt = (LAS float*)(F.lds + CV_GT);
    CvtPtrs P; P.ein = a.in(I_E_W_IN); P.eout = a.in(I_E_W_OUT); P.fg = a.in(I_E_FFN_GATE); P.fu = a.in(I_E_FFN_UP); P.fd = a.in(I_E_FFN_DOWN); P.oin = a.in(I_O_W_IN); P.oout = a.in(I_O_W_OUT);
    P.xg = a.in(I_O_EXP_GATE); P.xu = a.in(I_O_EXP_UP); P.xd = a.in(I_O_EXP_DOWN); P.g_ffn = a.in(I_E_NORM_FFN); P.g_omix = a.in(I_O_NORM_MIX);
    for (int i = F.tid; i < 2048; i += NTHR) gt[i] = (i < 1024) ? P.g_ffn[i] : P.g_omix[i - 1024];
    __syncthreads();
    const int per = (it1 - it0 + F.G - 1) / F.G; const int itb = it0 + F.vcu * per; const int ite = (itb + per < it1) ? itb + per : it1; const int last = ite - 1;
    if (itb >= ite) return;
#define CV_MIN(a, b) ((a) < (b) ? (a) : (b))
    CvtItem dA0, dA1, dB0, dB1; f32x4 vA0[8], vA1[8], vB0[8], vB1[8];
#define CV_LOAD2(d0, d1, v0, v1, k) do { cvt_decode(d0, P, ws, CV_MIN((k), last)); cvt_decode(d1, P, ws, CV_MIN((k) + 1, last)); cvt_load(d0, v0, F.tid); cvt_load(d1, v1, F.tid); } while (0)
#define CV_STORE2(d0, d1, v0, v1, k) do { cvt_store(d0, v0, tile, gt, F.tid); if ((k) + 1 < ite) cvt_store(d1, v1, tile, gt, F.tid); } while (0)
    CV_LOAD2(dA0, dA1, vA0, vA1, itb);
    for (int k = itb;; k += 4) {
        CV_LOAD2(dB0, dB1, vB0, vB1, k + 2);
        rope_step(rj, ws);
        CV_STORE2(dA0, dA1, vA0, vA1, k);
        if (k + 2 >= ite) break;
        CV_LOAD2(dA0, dA1, vA0, vA1, k + 4);
        rope_step(rj, ws);
        CV_STORE2(dB0, dB1, vB0, vB1, k + 2);
        if (k + 4 >= ite) break;
    }
#undef CV_MIN
#undef CV_LOAD2
#undef CV_STORE2
}
__device__ __forceinline__ void rms_row_to_bf16(const float* xrow, const float* gain, bf16* orow, int lane) {
    const f32x4* xr = (const f32x4*)xrow + lane; const f32x4* gr = (const f32x4*)gain + lane;
    f32x4 v[4]; float s = 0.f;
#pragma unroll
    for (int j = 0; j < 4; ++j) { v[j] = xr[64 * j]; s += (v[j][0] * v[j][0] + v[j][1] * v[j][1]) + (v[j][2] * v[j][2] + v[j][3] * v[j][3]); }
    const float r = 1.0f / sqrtf(wave_sum(s) * (1.f / D) + EPS);
    unsigned long long* o8 = (unsigned long long*)orow + lane;
#pragma unroll
    for (int j = 0; j < 4; ++j) { const f32x4 g = gr[64 * j];
        o8[64 * j] = (unsigned long long)pk2(v[j][0] * r * g[0], v[j][1] * r * g[1]) | ((unsigned long long)pk2(v[j][2] * r * g[2], v[j][3] * r * g[3]) << 32); }
}
__device__ __forceinline__ void norm_phase(Frame& F, const float* x, const float* gain, bf16* XN) {
    const int gw = F.vcu * NWAVES + F.wave, NGW = F.G * NWAVES;
    const f32x4* gr = (const f32x4*)gain + F.lane; f32x4 g[4];
#pragma unroll
    for (int j = 0; j < 4; ++j) g[j] = gr[64 * j];
    for (int m0 = gw; m0 < T; m0 += 4 * NGW) {
        f32x4 v[4][4];
#pragma unroll
        for (int k = 0; k < 4; ++k) { const int m = (m0 + k * NGW < T) ? m0 + k * NGW : m0; const f32x4* xr = (const f32x4*)(x + (size_t)m * D) + F.lane;
#pragma unroll
            for (int j = 0; j < 4; ++j) v[k][j] = xr[64 * j]; }
#pragma unroll
        for (int k = 0; k < 4; ++k) { if (m0 + k * NGW >= T) break; float s = 0.f;
#pragma unroll
            for (int j = 0; j < 4; ++j) s += (v[k][j][0] * v[k][j][0] + v[k][j][1] * v[k][j][1]) + (v[k][j][2] * v[k][j][2] + v[k][j][3] * v[k][j][3]);
            const float r = 1.0f / sqrtf(wave_sum(s) * (1.f / D) + EPS);
            unsigned long long* o8 = (unsigned long long*)(XN + (size_t)(m0 + k * NGW) * D) + F.lane;
#pragma unroll
            for (int j = 0; j < 4; ++j) o8[64 * j] = (unsigned long long)pk2(v[k][j][0] * r * g[j][0], v[k][j][1] * r * g[j][1]) | ((unsigned long long)pk2(v[k][j][2] * r * g[j][2], v[k][j][3] * r * g[j][3]) << 32); }
    }
}
__device__ __forceinline__ bf16x8 frag_row(const LAS unsigned char* base, int ldb, int row0, int k0, int lane) {
    return *(const LAS bf16x8*)(base + (row0 + (lane & 15)) * ldb + (k0 + 8 * (lane >> 4)) * 2);
}
__device__ __forceinline__ bf16x8 frag_tr(const LAS unsigned char* base, int ldb, int k0, int n0, int lane) {
    const int g = lane >> 4, q = (lane & 15) >> 2, p = lane & 3;
    const LAS unsigned char* a0 = base + (k0 + 8 * g + q) * ldb + (n0 + 4 * p) * 2;
    const s16x4 lo = __builtin_amdgcn_ds_read_tr16_b64_v4i16((LAS s16x4*)a0);
    const s16x4 hi = __builtin_amdgcn_ds_read_tr16_b64_v4i16((LAS s16x4*)(a0 + 4 * ldb));
    return (bf16x8){lo[0], lo[1], lo[2], lo[3], hi[0], hi[1], hi[2], hi[3]};
}
__device__ __forceinline__ f32x4 mma16(bf16x8 a, bf16x8 b, f32x4 c) { return __builtin_amdgcn_mfma_f32_16x16x32_bf16(a, b, c, 0, 0, 0); }

constexpr int RT_LDQ = 272, RT_LDP = 144, RT_LDO = 528;
constexpr int RT_QS = 0, RT_KS = 17408, RT_KD = 34816, RT_VS = 52224, RT_PS = 69632, RT_SB = 78848, RT_OS = 113664, RT_PW = 147456;
template <bool MAIN>
__device__ __forceinline__ void ret_unit(Frame& F, const PT& a, unsigned char* ws, int unit) {
    const int b = unit >> 7, h = (unit >> 5) & 3, sc = unit & 31;
    const int tid = F.tid, lane = F.lane, w = F.wave;
    const float* p_gn = MAIN ? a.in(I_E_RET_GN) : nullptr;
    const bf16* Z = (const bf16*)(ws + WS_Z);
    LAS unsigned char* L = F.lds;
    LAS float* pw = (LAS float*)(L + RT_PW);
    if (tid <= 64) { const double g = 1.0 - 1.0 / (double)(32 << h); double p = 1.0; for (int j = 0; j < tid; ++j) p *= g; pw[tid] = (float)p; }
    f32x4 st[8];
    if (MAIN) { const f32x4* sp = (const f32x4*)(ws + WS_RETS) + (size_t)unit * 4096;
#pragma unroll
        for (int td = 0; td < 8; ++td) st[td] = sp[(w * 8 + td) * 64 + lane];
    } else {
#pragma unroll
        for (int td = 0; td < 8; ++td) st[td] = (f32x4){0.f, 0.f, 0.f, 0.f};
    }
    WG_SYNC();
    const float c64 = pw[64];
    const int q4 = lane >> 4, r16 = lane & 15;
    if (MAIN) {
#pragma unroll
        for (int td = 0; td < 8; ++td)
#pragma unroll
            for (int jj = 0; jj < 4; ++jj) *(LAS bf16*)(L + RT_SB + (16 * w + 4 * q4 + jj) * RT_LDQ + (16 * td + r16) * 2) = (bf16)f2bf(st[td][jj]);
    }
    const int lrow = tid >> 3, lseg = tid & 7;
    struct RowBuf { u32x4 k0, k1, v0, v1, q0, q1, g0, g1; };
    RowBuf bufA, bufB; bufA.q0 = bufA.q1 = bufA.g0 = bufA.g1 = bufB.q0 = bufB.q1 = bufB.g0 = bufB.g1 = (u32x4){0u, 0u, 0u, 0u};
    f32x4 gnv[4];
    if (MAIN) {
#pragma unroll
        for (int j = 0; j < 4; ++j) gnv[j] = *(const f32x4*)(p_gn + 128 * h + 16 * (tid & 7) + 4 * j); }
#define RT_LOAD(B_, cc_) do { const bf16* _zr = Z + (size_t)(b * SEQ + (sc * 8 + (cc_)) * 64 + lrow) * EVEN_IN + 128 * h + 16 * lseg; \
        (B_).k0 = *(const u32x4*)(_zr + 512); (B_).k1 = *(const u32x4*)(_zr + 512 + 8); (B_).v0 = *(const u32x4*)(_zr + 1024); (B_).v1 = *(const u32x4*)(_zr + 1024 + 8); \
        if (MAIN) { (B_).q0 = *(const u32x4*)_zr; (B_).q1 = *(const u32x4*)(_zr + 8); (B_).g0 = *(const u32x4*)(_zr + 1536); (B_).g1 = *(const u32x4*)(_zr + 1536 + 8); } } while (0)
    RT_LOAD(bufA, 0); RT_LOAD(bufB, 1);
    auto one_chunk = [&](RowBuf& nb, const int cc) __attribute__((always_inline)) {
        const int t0 = b * SEQ + (sc * 8 + cc) * 64;
        const u32x4 gz0 = nb.g0, gz1 = nb.g1;
        { const u32x4 k0 = nb.k0, k1 = nb.k1, v0 = nb.v0, v1 = nb.v1, q0 = nb.q0, q1 = nb.q1;
          RT_LOAD(nb, cc < 6 ? cc + 2 : cc);
          LAS unsigned char* dst = L + lrow * RT_LDQ + 32 * lseg;
          *(LAS u32x4*)(dst + RT_VS) = v0; *(LAS u32x4*)(dst + RT_VS + 16) = v1;
          if (MAIN) { *(LAS u32x4*)(dst + RT_QS) = q0; *(LAS u32x4*)(dst + RT_QS + 16) = q1;
                      *(LAS u32x4*)(dst + RT_KS) = k0; *(LAS u32x4*)(dst + RT_KS + 16) = k1; }
          const float kd = pw[63 - lrow]; u32x4 d0, d1;
#pragma unroll
          for (int j = 0; j < 4; ++j) { d0[j] = pk2(bf2f(k0[j] & 0xffffu) * kd, bf2f(k0[j] >> 16) * kd); d1[j] = pk2(bf2f(k1[j] & 0xffffu) * kd, bf2f(k1[j] >> 16) * kd); }
          *(LAS u32x4*)(dst + RT_KD) = d0; *(LAS u32x4*)(dst + RT_KD + 16) = d1; }
        WG_SYNC();
        f32x4 oacc[4];
        const int ti = w >> 1, te0 = 4 * (w & 1);
        if (MAIN) {
            bf16x8 qa[4], kb[2][4];
#pragma unroll
            for (int ks = 0; ks < 4; ++ks) { qa[ks] = frag_row(L + RT_QS, RT_LDQ, 16 * ti, 32 * ks, lane);
#pragma unroll
                for (int x = 0; x < 2; ++x) kb[x][ks] = frag_row(L + RT_KS, RT_LDQ, 16 * (2 * (w & 1) + x), 32 * ks, lane); }
            __builtin_amdgcn_sched_barrier(0);
#pragma unroll
            for (int x = 0; x < 2; ++x) { const int tj = 2 * (w & 1) + x; f32x4 p = {0.f, 0.f, 0.f, 0.f};
#pragma unroll
                for (int ks = 0; ks < 4; ++ks) p = mma16(qa[ks], kb[x][ks], p);
#pragma unroll
                for (int jj = 0; jj < 4; ++jj) { const int i = 16 * ti + 4 * q4 + jj, j = 16 * tj + r16; const int dd = i > j ? i - j : j - i;
                    *(LAS bf16*)(L + RT_PS + i * RT_LDP + j * 2) = (bf16)f2bf(p[jj] * pw[dd]); } }
#pragma unroll
            for (int x = 0; x < 4; ++x) oacc[x] = (f32x4){0.f, 0.f, 0.f, 0.f};
#pragma unroll
            for (int kh = 0; kh < 2; ++kh) { bf16x8 sbf[2][4];
#pragma unroll
              for (int ks = 0; ks < 2; ++ks)
#pragma unroll
                  for (int x = 0; x < 4; ++x) sbf[ks][x] = frag_row(L + RT_SB, RT_LDQ, 16 * (te0 + x), 32 * (2 * kh + ks), lane);
              __builtin_amdgcn_sched_barrier(0);
#pragma unroll
              for (int ks = 0; ks < 2; ++ks)
#pragma unroll
                  for (int x = 0; x < 4; ++x) oacc[x] = mma16(qa[2 * kh + ks], sbf[ks][x], oacc[x]); }
#pragma unroll
            for (int x = 0; x < 4; ++x)
#pragma unroll
                for (int jj = 0; jj < 4; ++jj) oacc[x][jj] *= pw[16 * ti + 4 * q4 + jj + 1];
            WG_SYNC();
            { bf16x8 pa[2], vb[2][4];
#pragma unroll
              for (int ks = 0; ks < 2; ++ks) { pa[ks] = frag_row(L + RT_PS, RT_LDP, 16 * ti, 32 * ks, lane);
#pragma unroll
                  for (int x = 0; x < 4; ++x) vb[ks][x] = frag_tr(L + RT_VS, RT_LDQ, 32 * ks, 16 * (te0 + x), lane); }
              __builtin_amdgcn_sched_barrier(0);
#pragma unroll
              for (int ks = 0; ks < 2; ++ks)
#pragma unroll
                  for (int x = 0; x < 4; ++x) oacc[x] = mma16(pa[ks], vb[ks][x], oacc[x]); }
#pragma unroll
            for (int x = 0; x < 4; ++x)
#pragma unroll
                for (int jj = 0; jj < 4; ++jj) *(LAS float*)(L + RT_OS + (16 * ti + 4 * q4 + jj) * RT_LDO + (16 * (te0 + x) + r16) * 4) = oacc[x][jj];
        }
#pragma unroll
        for (int td = 0; td < 8; ++td) st[td] = st[td] * c64;
#pragma unroll
        for (int ks = 0; ks < 2; ++ks) { bf16x8 kd[8]; const bf16x8 va = frag_tr(L + RT_VS, RT_LDQ, 32 * ks, 16 * w, lane);
#pragma unroll
          for (int td = 0; td < 8; ++td) kd[td] = frag_tr(L + RT_KD, RT_LDQ, 32 * ks, 16 * td, lane);
          __builtin_amdgcn_sched_barrier(0);
#pragma unroll
          for (int td = 0; td < 8; ++td) st[td] = mma16(va, kd[td], st[td]); }
        WG_SYNC();
        if (MAIN) {
#pragma unroll
            for (int td = 0; td < 8; ++td)
#pragma unroll
                for (int jj = 0; jj < 4; ++jj) *(LAS bf16*)(L + RT_SB + (16 * w + 4 * q4 + jj) * RT_LDQ + (16 * td + r16) * 2) = (bf16)f2bf(st[td][jj]);
            const int i = lrow, e0 = 16 * lseg;
            f32x4 ov[4]; float s = 0.f;
#pragma unroll
            for (int j = 0; j < 4; ++j) { ov[j] = *(const LAS f32x4*)(L + RT_OS + i * RT_LDO + (e0 + 4 * j) * 4); s += (ov[j][0] + ov[j][1]) + (ov[j][2] + ov[j][3]); }
            s = sum8(s);
            const float mu = s * (1.f / 128.f); float q = 0.f;
#pragma unroll
            for (int j = 0; j < 4; ++j) { ov[j] = ov[j] - mu; q += (ov[j][0] * ov[j][0] + ov[j][1] * ov[j][1]) + (ov[j][2] * ov[j][2] + ov[j][3] * ov[j][3]); }
            q = sum8(q);
            const float rstd = 1.0f / sqrtf(q * (1.f / 128.f) + EPS);
            const u32x4 g0 = gz0, g1 = gz1;
            float y[16];
#pragma unroll
            for (int j = 0; j < 4; ++j) { const f32x4 gg = gnv[j];
#pragma unroll
                for (int k = 0; k < 4; ++k) { const int idx = 4 * j + k; const unsigned gw = (idx < 8) ? g0[idx >> 1] : g1[(idx - 8) >> 1]; const float gv = bf2f((idx & 1) ? (gw >> 16) : (gw & 0xffffu));
                    y[idx] = silu_f(gv) * (ov[j][k] * rstd * gg[k]); } }
            u32x4 o0, o1;
#pragma unroll
            for (int j = 0; j < 4; ++j) { o0[j] = pk2(y[2 * j], y[2 * j + 1]); o1[j] = pk2(y[8 + 2 * j], y[8 + 2 * j + 1]); }
            bf16* yp = (bf16*)(ws + WS_Y) + (size_t)(t0 + i) * D + 128 * h + e0;
            *(u32x4*)yp = o0; *(u32x4*)(yp + 8) = o1;
        }
    };
    for (int cc = 0; cc < 8; cc += 2) { one_chunk(bufA, cc); one_chunk(bufB, cc + 1); }
#undef RT_LOAD
    if (!MAIN) { f32x4* lp = (f32x4*)(ws + WS_RETL) + (size_t)unit * 4096;
#pragma unroll
        for (int td = 0; td < 8; ++td) lp[(w * 8 + td) * 64 + lane] = st[td]; }
    WG_SYNC();
}
__device__ __forceinline__ void ret_scan(Frame& F, unsigned char* ws) {
    const float* Lb = (const float*)(ws + WS_RETL); float* Sb = (float*)(ws + WS_RETS);
    const int gt = F.vcu * NTHR + F.tid, NGT = F.G * NTHR;
    for (int idx = gt; idx < 8 * 16384; idx += NGT) { const int bh = idx >> 14, el = idx & 16383, h = bh & 3;
        const double g = 1.0 - 1.0 / (double)(32 << h); double p = g; for (int j = 0; j < 9; ++j) p *= p;
        const float c8 = (float)p; float run = 0.f;
        float lv[32];
#pragma unroll
        for (int s = 0; s < 32; ++s) lv[s] = Lb[((size_t)(bh * 32 + s) << 14) + el];
#pragma unroll
        for (int s = 0; s < 32; ++s) { Sb[((size_t)(bh * 32 + s) << 14) + el] = run; run = c8 * run + lv[s]; } }
}

__device__ __forceinline__ void unpack8(const u32x4 r, float (&v)[8]) {
#pragma unroll
    for (int j = 0; j < 4; ++j) { v[2 * j] = bf2f(r[j] & 0xffffu); v[2 * j + 1] = bf2f(r[j] >> 16); } }
__device__ __forceinline__ u32x4 pack8(const float (&v)[8]) { u32x4 o; o.x = pk2(v[0], v[1]); o.y = pk2(v[2], v[3]); o.z = pk2(v[4], v[5]); o.w = pk2(v[6], v[7]); return o; }
__device__ __forceinline__ void conv_unit(Frame& F, const PT& a, unsigned char* ws, int unit) {
    const int b = unit >> 7, s0 = (unit & 127) * 128, ch = F.tid, tid = F.tid;
    const bf16* Z = (const bf16*)(ws + WS_Z); bf16* Y = (bf16*)(ws + WS_Y);
    LAS float* cv = (LAS float*)F.lds;
    LAS bf16* ct = (LAS bf16*)(F.lds + 65536);
    const float* p_dw = a.in(I_E_DW_W); const float* p_lg = a.in(I_E_CV_LN_G); const float* p_lb = a.in(I_E_CV_LN_B);
    float wk[31];
#pragma unroll
    for (int k = 0; k < 31; ++k) wk[k] = p_dw[k * 512 + ch];
    const float bias = a.in(I_E_DW_B)[ch];
    const int ltok = tid >> 4, lseg = tid & 15;
    u32x4 ra[4], rb[4];
#define CV_LOAD(sfirst) do { const int _s = (sfirst) + ltok; const bf16* _zr = Z + (size_t)(b * SEQ + (_s >= 0 ? _s : 0)) * EVEN_IN + 2048 + 32 * lseg; \
        _Pragma("unroll") for (int j = 0; j < 4; ++j) { ra[j] = *(const u32x4*)(_zr + 8 * j); rb[j] = *(const u32x4*)(_zr + 512 + 8 * j); } } while (0)
#define CV_GLU_TO_LDS() do { _Pragma("unroll") for (int j = 0; j < 4; ++j) { float av[8], bv[8]; unpack8(ra[j], av); unpack8(rb[j], bv); \
        _Pragma("unroll") for (int k = 0; k < 8; ++k) av[k] = av[k] * fast_sigmoid(bv[k]); \
        *(LAS u32x4*)(ct + ltok * 512 + 32 * lseg + 8 * j) = pack8(av); } } while (0)
    float c[62];
    const f32x4 g0 = *(const f32x4*)(p_lg + 8 * F.lane), g1 = *(const f32x4*)(p_lg + 8 * F.lane + 4);
    const f32x4 b0 = *(const f32x4*)(p_lb + 8 * F.lane), b1 = *(const f32x4*)(p_lb + 8 * F.lane + 4);
    CV_LOAD(s0 - 32);
    if (s0 - 32 + ltok < 0) {
#pragma unroll
        for (int j = 0; j < 4; ++j) ra[j] = (u32x4){0u, 0u, 0u, 0u}; }
    CV_GLU_TO_LDS();
    CV_LOAD(s0);
    WG_SYNC();
#pragma unroll
    for (int j = 0; j < 30; ++j) c[j] = bf2f(ct[(j + 2) * 512 + ch]);
    WG_SYNC();
    for (int p = 0; p < 4; ++p) {
        CV_GLU_TO_LDS();
        CV_LOAD(s0 + 32 * (p < 3 ? p + 1 : p));
        WG_SYNC();
#pragma unroll
        for (int j = 0; j < 32; ++j) c[30 + j] = bf2f(ct[j * 512 + ch]);
        float o[32];
#pragma unroll
        for (int i = 0; i < 32; ++i) { float acc = bias;
#pragma unroll
            for (int k = 0; k < 31; ++k) acc = __builtin_fmaf(wk[k], c[i + k], acc);
            o[i] = acc; }
#pragma unroll
        for (int i = 0; i < 32; ++i) cv[i * 512 + ch] = o[i];
#pragma unroll
        for (int j = 0; j < 30; ++j) c[j] = c[j + 32];
        WG_SYNC();
#pragma unroll
        for (int x = 0; x < 4; ++x) { const int i = 4 * F.wave + x; const LAS f32x4* r = (const LAS f32x4*)(cv + i * 512 + 8 * F.lane);
            f32x4 v0 = r[0], v1 = r[1]; float s = (v0[0] + v0[1]) + (v0[2] + v0[3]) + (v1[0] + v1[1]) + (v1[2] + v1[3]);
            const float mu = wave_sum(s) * (1.f / 512.f); v0 = v0 - mu; v1 = v1 - mu;
            float q = (v0[0] * v0[0] + v0[1] * v0[1]) + (v0[2] * v0[2] + v0[3] * v0[3]) + (v1[0] * v1[0] + v1[1] * v1[1]) + (v1[2] * v1[2] + v1[3] * v1[3]);
            const float rstd = 1.0f / sqrtf(wave_sum(q) * (1.f / 512.f) + EPS);
            float y[8];
#pragma unroll
            for (int k = 0; k < 4; ++k) { y[k] = silu_f(v0[k] * rstd * g0[k] + b0[k]); y[4 + k] = silu_f(v1[k] * rstd * g1[k] + b1[k]); }
            *(u32x4*)(Y + (size_t)(b * SEQ + s0 + 32 * p + i) * D + 512 + 8 * F.lane) = pack8(y); }
        WG_SYNC();
    }
#undef CV_LOAD
#undef CV_GLU_TO_LDS
}

constexpr int M1_VS = 0, M1_WS = 34816, M1_ST = 69632, M1_SP = 70656, M1_LD = 272, M1_LDS = 132;
__device__ __forceinline__ void mixer1_unit(Frame& F, const PT& a, unsigned char* ws, int unit) {
    const int t0 = unit * 128, s0 = (unit & 127) * 128;
    const int tid = F.tid, lane = F.lane, w = F.wave;
    const bf16* Z = (const bf16*)(ws + WS_Z); bf16* Y = (bf16*)(ws + WS_Y);
    LAS unsigned char* L = F.lds; LAS f32x2* stt = (LAS f32x2*)(L + M1_ST); LAS float* SP = (LAS float*)(L + M1_SP);
    const float* p_lng = a.in(I_O_SG_LN_G); const float* p_lnb = a.in(I_O_SG_LN_B); const float* p_sgb = a.in(I_O_SG_B); const float* p_scw = a.in(I_O_SC_W);
    LAS float* GL = (LAS float*)(L + 139264);
    { GL[tid] = p_lng[tid]; GL[512 + tid] = p_lnb[tid]; GL[1024 + tid] = p_sgb[tid]; }
#pragma unroll
    for (int b8 = 0; b8 < 2; ++b8) { u32x4 raw[8];
#pragma unroll
        for (int x = 0; x < 8; ++x) raw[x] = *(const u32x4*)(Z + (size_t)(t0 + 16 * w + 8 * b8 + x) * ODD_IN + 512 + 8 * lane);
#pragma unroll
        for (int x = 0; x < 8; ++x) { float v[8]; unpack8(raw[x], v); float s = 0.f;
#pragma unroll
            for (int j = 0; j < 8; ++j) { v[j] = gelu_tanh(v[j]); s += v[j]; }
            const float mu = wave_sum(s) * (1.f / 512.f); float q = 0.f;
#pragma unroll
            for (int j = 0; j < 8; ++j) { const float d = v[j] - mu; q += d * d; }
            const float rstd = 1.0f / sqrtf(wave_sum(q) * (1.f / 512.f) + EPS);
            if (lane == 0) stt[16 * w + 8 * b8 + x] = (f32x2){mu, rstd}; } }
    WG_SYNC();
    const int q4 = lane >> 4, r16 = lane & 15;
    const int tk = tid >> 2, part = tid & 3;
    u32x4 raw[4], wr4[4], uraw[4];
#define M1_LOAD_FILL(g_) do { const bf16* _zr = Z + (size_t)(t0 + tk) * ODD_IN + 512 + 128 * (g_) + 32 * part; const bf16* _ws = (const bf16*)(ws + WS_SGW) + (size_t)((g_) * 128 + tk) * 128 + 32 * part; \
        _Pragma("unroll") for (int j = 0; j < 4; ++j) { raw[j] = *(const u32x4*)(_zr + 8 * j); wr4[j] = *(const u32x4*)(_ws + 8 * j); } } while (0)
    M1_LOAD_FILL(0);
#pragma unroll
    for (int g = 0; g < 4; ++g) {
        { const bf16* zu = Z + (size_t)(t0 + tk) * ODD_IN + 128 * g + 32 * part;
#pragma unroll
          for (int j = 0; j < 4; ++j) uraw[j] = *(const u32x4*)(zu + 8 * j); }
        { f32x4 lg[8], lb[8];
#pragma unroll
          for (int j = 0; j < 8; ++j) { lg[j] = *(const LAS f32x4*)(GL + 128 * g + 32 * part + 4 * j); lb[j] = *(const LAS f32x4*)(GL + 512 + 128 * g + 32 * part + 4 * j); }
          const f32x2 ms = stt[tk];
#pragma unroll
          for (int j = 0; j < 4; ++j) { float v[8]; unpack8(raw[j], v);
#pragma unroll
              for (int k = 0; k < 8; ++k) v[k] = (gelu_tanh(v[k]) - ms[0]) * ms[1] * lg[2 * j + (k >> 2)][k & 3] + lb[2 * j + (k >> 2)][k & 3];
              *(LAS u32x4*)(L + M1_VS + tk * M1_LD + (32 * part + 8 * j) * 2) = pack8(v);
              *(LAS u32x4*)(L + M1_WS + tk * M1_LD + (32 * part + 8 * j) * 2) = wr4[j]; } }
        if (g < 3) M1_LOAD_FILL(g + 1);
        WG_SYNC();
        { f32x4 acc[8];
#pragma unroll
          for (int ct = 0; ct < 8; ++ct) acc[ct] = (f32x4){0.f, 0.f, 0.f, 0.f};
#pragma unroll
          for (int ks = 0; ks < 4; ++ks) { const bf16x8 af = frag_row(L + M1_WS, M1_LD, 16 * w, 32 * ks, lane);
#pragma unroll
              for (int ct = 0; ct < 8; ++ct) acc[ct] = mma16(af, frag_tr(L + M1_VS, M1_LD, 32 * ks, 16 * ct, lane), acc[ct]); }
#pragma unroll
          for (int jj = 0; jj < 4; ++jj) { const int p = 16 * w + 4 * q4 + jj; const float sb = GL[1024 + g * 128 + p];
#pragma unroll
              for (int ct = 0; ct < 8; ++ct) SP[p * M1_LDS + 16 * ct + r16] = acc[ct][jj] + sb; } }
        WG_SYNC();
        { bf16* yo = Y + (size_t)(t0 + tk) * D + 128 * g + 32 * part;
#pragma unroll
          for (int j = 0; j < 4; ++j) { float v[8]; unpack8(uraw[j], v); const f32x4 s0v = *(const LAS f32x4*)(SP + tk * M1_LDS + 32 * part + 8 * j), s1v = *(const LAS f32x4*)(SP + tk * M1_LDS + 32 * part + 8 * j + 4);
#pragma unroll
              for (int k = 0; k < 4; ++k) { v[k] = gelu_tanh(v[k]) * s0v[k]; v[4 + k] = gelu_tanh(v[4 + k]) * s1v[k]; }
              *(u32x4*)(yo + 8 * j) = pack8(v); } }
    }
#undef M1_LOAD_FILL
    { const int ch0 = 8 * lane; float w0[8], w1[8], w2[8];
#pragma unroll
      for (int j = 0; j < 2; ++j) { const f32x4 a0 = *(const f32x4*)(p_scw + ch0 + 4 * j), a1 = *(const f32x4*)(p_scw + 512 + ch0 + 4 * j), a2 = *(const f32x4*)(p_scw + 1024 + ch0 + 4 * j);
#pragma unroll
          for (int k = 0; k < 4; ++k) { w0[4 * j + k] = a0[k]; w1[4 * j + k] = a1[k]; w2[4 * j + k] = a2[k]; } }
#pragma unroll
      for (int b8 = 0; b8 < 2; ++b8) { const int tb = 16 * w + 8 * b8;
          u32x4 cg[10], hv[10], bg[8];
#pragma unroll
          for (int x = 0; x < 10; ++x) { const int tt = tb - 2 + x; const bool ok = (s0 + tt) >= 0; const bf16* zr = Z + (size_t)(t0 + (ok ? tt : 0)) * ODD_IN + ch0;
              cg[x] = *(const u32x4*)(zr + 1536); hv[x] = *(const u32x4*)(zr + 2048); }
#pragma unroll
          for (int x = 0; x < 8; ++x) bg[x] = *(const u32x4*)(Z + (size_t)(t0 + tb + x) * ODD_IN + 1024 + ch0);
          __builtin_amdgcn_sched_barrier(0);
#pragma unroll
          for (int x = 0; x < 2; ++x) { if ((s0 + tb - 2 + x) < 0) cg[x] = (u32x4){0u, 0u, 0u, 0u}; }
          float pr[10][8];
#pragma unroll
          for (int x = 0; x < 10; ++x) { float c8[8], h8[8]; unpack8(cg[x], c8); unpack8(hv[x], h8);
#pragma unroll
              for (int k = 0; k < 8; ++k) pr[x][k] = c8[k] * h8[k]; }
#pragma unroll
          for (int x = 0; x < 8; ++x) { float b8v[8], y[8]; unpack8(bg[x], b8v);
#pragma unroll
              for (int k = 0; k < 8; ++k) y[k] = b8v[k] * (w0[k] * pr[x][k] + w1[k] * pr[x + 1][k] + w2[k] * pr[x + 2][k]);
              *(u32x4*)(Y + (size_t)(t0 + tb + x) * D + 512 + ch0) = pack8(y); } }
    }
    WG_SYNC();
}

__device__ __forceinline__ void route_phase(Frame& F, const PT& a, unsigned char* ws, const float* hres) {
    LAS float* rt = (LAS float*)F.lds;
    LAS int* lcnt = (LAS int*)(F.lds + 32768); LAS int* lbase = lcnt + 8;
    LAS int* te = (LAS int*)(F.lds + 33024); LAS int* tr = te + 256; LAS float* tg = (LAS float*)(tr + 256);
    unsigned* gcnt = (unsigned*)(ws + WS_CTL) + CW_CNT;
    int* row_tok = (int*)(ws + WS_ROWTOK); u32x2* tokinfo = (u32x2*)(ws + WS_TOKINFO);
    const float* p_rt = a.in(I_O_ROUTER); const float* p_ng = a.in(I_O_NORM_FFN);
    for (int i = F.tid; i < 8192; i += NTHR) { const int d = i >> 3, e = i & 7; rt[e * 1024 + d] = p_rt[i]; }
    if (F.tid < 8) lcnt[F.tid] = 0;
    __syncthreads();
    f32x4 gnr[4];
    { const f32x4* gr0 = (const f32x4*)p_ng + F.lane;
#pragma unroll
      for (int j = 0; j < 4; ++j) gnr[j] = gr0[64 * j]; }
    for (int base = F.vcu * 128; base < T; base += F.G * 128) {
        u32x2 va[4], ma[4], vb[4], mb[4];
        { const u32x2* xr = (const u32x2*)(hres + (size_t)(base + 16 * F.wave) * D) + F.lane;
#pragma unroll
          for (int j = 0; j < 4; ++j) { va[j] = xr[64 * j]; ma[j] = xr[256 + 64 * j]; vb[j] = xr[512 + 64 * j]; mb[j] = xr[768 + 64 * j]; } }
        auto one_token = [&](u32x2 (&vn)[4], u32x2 (&mn)[4], const int x) __attribute__((always_inline)) { const int tl = 16 * F.wave + x, t = base + tl;
            f32x4 v[4]; float s = 0.f;
#pragma unroll
            for (int j = 0; j < 4; ++j) { v[j][0] = bf2f(vn[j][0] & 0xffffu) + bf2f(mn[j][0] & 0xffffu); v[j][1] = bf2f(vn[j][0] >> 16) + bf2f(mn[j][0] >> 16);
                                          v[j][2] = bf2f(vn[j][1] & 0xffffu) + bf2f(mn[j][1] & 0xffffu); v[j][3] = bf2f(vn[j][1] >> 16) + bf2f(mn[j][1] >> 16); }
            { const u32x2* xr = (const u32x2*)(hres + (size_t)(t + (x < 14 ? 2 : 0)) * D) + F.lane;
#pragma unroll
              for (int j = 0; j < 4; ++j) { vn[j] = xr[64 * j]; mn[j] = xr[256 + 64 * j]; } }
#pragma unroll
            for (int j = 0; j < 4; ++j) s += (v[j][0] * v[j][0] + v[j][1] * v[j][1]) + (v[j][2] * v[j][2] + v[j][3] * v[j][3]);
            const float r = __builtin_amdgcn_rsqf(wave_sum(s) * (1.f / D) + EPS);
            unsigned* o4 = (unsigned*)(ws + WS_XN8 + (size_t)t * D) + F.lane;
            float lg[8];
#pragma unroll
            for (int e = 0; e < 8; ++e) lg[e] = 0.f;
#pragma unroll
            for (int j = 0; j < 4; ++j) { const f32x4 g = gnr[j]; f32x4 xn; xn[0] = v[j][0] * r * g[0]; xn[1] = v[j][1] * r * g[1]; xn[2] = v[j][2] * r * g[2]; xn[3] = v[j][3] * r * g[3];
                o4[64 * j] = pk4_fp8(xn[0], xn[1], xn[2], xn[3]);
#pragma unroll
                for (int e = 0; e < 8; ++e) { const f32x4 rw = *(const LAS f32x4*)(rt + e * 1024 + 256 * j + 4 * F.lane); lg[e] += (xn[0] * rw[0] + xn[1] * rw[1]) + (xn[2] * rw[2] + xn[3] * rw[3]); } }
#pragma unroll
            for (int e = 0; e < 8; ++e) lg[e] = wave_sum(lg[e]);
            int e1 = 0; float m1 = lg[0];
#pragma unroll
            for (int e = 1; e < 8; ++e) if (lg[e] > m1) { m1 = lg[e]; e1 = e; }
            int e2 = -1; float m2 = 0.f;
#pragma unroll
            for (int e = 0; e < 8; ++e) if (e != e1 && (e2 < 0 || lg[e] > m2)) { m2 = lg[e]; e2 = e; }
            const float p2 = __expf(m2 - m1), g1 = __builtin_amdgcn_rcpf(1.0f + p2), g2 = p2 * g1;
            if (F.lane == 0) { te[2 * tl] = e1; te[2 * tl + 1] = e2; tg[2 * tl] = g1; tg[2 * tl + 1] = g2;
                tr[2 * tl] = __hip_atomic_fetch_add(lcnt + e1, 1, __ATOMIC_RELAXED, __HIP_MEMORY_SCOPE_WORKGROUP); tr[2 * tl + 1] = __hip_atomic_fetch_add(lcnt + e2, 1, __ATOMIC_RELAXED, __HIP_MEMORY_SCOPE_WORKGROUP); } };
        for (int x = 0; x < 16; x += 2) { one_token(va, ma, x); one_token(vb, mb, x + 1); }
        __syncthreads();
        if (F.tid < 8) { lbase[F.tid] = (int)__hip_atomic_fetch_add(gcnt + 64 * F.tid, (unsigned)lcnt[F.tid], RLX_AGENT); }
        __syncthreads();
        if (F.tid < 256) { const int e = te[F.tid], idx = lbase[e] + tr[F.tid], t = base + (F.tid >> 1);
            row_tok[e * 32768 + idx] = t;
            tokinfo[(size_t)t * 2 + (F.tid & 1)] = (u32x2){((unsigned)e << 24) | (unsigned)idx, __float_as_uint(tg[F.tid])}; }
        __syncthreads();
        if (F.tid < 8) lcnt[F.tid] = 0;
        __syncthreads();
    }
}
__device__ __forceinline__ void combine_phase(Frame& F, const PT& a, unsigned char* ws, const LAS int* bstart, float* out) {
    const int gw = F.vcu * NWAVES + F.wave, NGW = F.G * NWAVES;
    const u32x2* tokinfo = (const u32x2*)(ws + WS_TOKINFO); const bf16* YM = (const bf16*)(ws + WS_YMOE); const bf16* SL = (const bf16*)(ws + WS_SLAB); const float* p_fn = a.in(I_FINAL_NORM);
    const f32x4* gr = (const f32x4*)p_fn + F.lane; f32x4 gn[4];
#pragma unroll
    for (int j = 0; j < 4; ++j) gn[j] = gr[64 * j];
    for (int tb = gw; tb < T; tb += 16 * NGW) {
        u32x2 inf0 = {0u, 0u}, inf1 = {0u, 0u};
        { const int tl = tb + (F.lane & 15) * NGW; if (tl < T) { inf0 = tokinfo[(size_t)tl * 2]; inf1 = tokinfo[(size_t)tl * 2 + 1]; } }
        u32x2 hn[4], mn[4], y0n[4], y1n[4]; size_t p0n = 0, p1n = 0;
#define CMB_ISSUE(k) do { const int _t = tb + (k) * NGW; const unsigned _a0 = __builtin_amdgcn_readlane(inf0[0], (k)), _a1 = __builtin_amdgcn_readlane(inf1[0], (k)); \
        p0n = (size_t)bstart[_a0 >> 24] * 256 + (_a0 & 0xffffffu); p1n = (size_t)bstart[_a1 >> 24] * 256 + (_a1 & 0xffffffu); \
        const u32x2* _xr = (const u32x2*)(out + (size_t)_t * D) + F.lane; \
        const u32x2* _y0 = (const u32x2*)(YM + (p0n < 65536 ? p0n : 0) * D) + F.lane; const u32x2* _y1 = (const u32x2*)(YM + (p1n < 65536 ? p1n : 0) * D) + F.lane; \
        _Pragma("unroll") for (int j = 0; j < 4; ++j) { hn[j] = _xr[64 * j]; mn[j] = _xr[256 + 64 * j]; y0n[j] = _y0[64 * j]; y1n[j] = _y1[64 * j]; } } while (0)
        CMB_ISSUE(0);
#pragma unroll
        for (int k = 0; k < 16; ++k) { const int t = tb + k * NGW; if (t >= T) break;
            f32x4 v[4]; u32x2 ya[4], yb[4]; const size_t p0 = p0n, p1 = p1n;
#pragma unroll
            for (int j = 0; j < 4; ++j) { v[j][0] = bf2f(hn[j][0] & 0xffffu) + bf2f(mn[j][0] & 0xffffu); v[j][1] = bf2f(hn[j][0] >> 16) + bf2f(mn[j][0] >> 16);
                                          v[j][2] = bf2f(hn[j][1] & 0xffffu) + bf2f(mn[j][1] & 0xffffu); v[j][3] = bf2f(hn[j][1] >> 16) + bf2f(mn[j][1] >> 16); ya[j] = y0n[j]; yb[j] = y1n[j]; }
            const float g0 = __uint_as_float(__builtin_amdgcn_readlane(inf0[1], k)), g1 = __uint_as_float(__builtin_amdgcn_readlane(inf1[1], k));
            if (k < 15 && t + NGW < T) CMB_ISSUE(k + 1);
#pragma unroll
            for (int kk = 0; kk < 2; ++kk) { const size_t p = kk ? p1 : p0; const float g = kk ? g1 : g0;
                if (p < (size_t)65536) {
#pragma unroll
                    for (int j = 0; j < 4; ++j) { const u32x2 a0 = kk ? yb[j] : ya[j]; v[j][0] += g * bf2f(a0[0] & 0xffffu); v[j][1] += g * bf2f(a0[0] >> 16); v[j][2] += g * bf2f(a0[1] & 0xffffu); v[j][3] += g * bf2f(a0[1] >> 16); } }
                else { f32x4 acc[4];
#pragma unroll
                    for (int j = 0; j < 4; ++j) acc[j] = (f32x4){0.f, 0.f, 0.f, 0.f};
                    for (int ks = 0; ks < 7; ++ks) { const u32x2* y = (const u32x2*)(SL + ((size_t)ks * 2048 + (p - 65536)) * D) + F.lane;
#pragma unroll
                        for (int j = 0; j < 4; ++j) { const u32x2 a0 = y[64 * j]; acc[j][0] += bf2f(a0[0] & 0xffffu); acc[j][1] += bf2f(a0[0] >> 16); acc[j][2] += bf2f(a0[1] & 0xffffu); acc[j][3] += bf2f(a0[1] >> 16); } }
#pragma unroll
                    for (int j = 0; j < 4; ++j) v[j] = v[j] + acc[j] * g; } }
            float s = 0.f;
#pragma unroll
            for (int j = 0; j < 4; ++j) s += (v[j][0] * v[j][0] + v[j][1] * v[j][1]) + (v[j][2] * v[j][2] + v[j][3] * v[j][3]);
            const float r = 1.0f / sqrtf(wave_sum(s) * (1.f / D) + EPS);
            f32x4* xr = (f32x4*)(out + (size_t)t * D) + F.lane;
#pragma unroll
            for (int j = 0; j < 4; ++j) { f32x4 o; o[0] = v[j][0] * r * gn[j][0]; o[1] = v[j][1] * r * gn[j][1]; o[2] = v[j][2] * r * gn[j][2]; o[3] = v[j][3] * r * gn[j][3]; xr[64 * j] = o; }
        }
#undef CMB_ISSUE
    }
}

__global__ void __launch_bounds__(NTHR, 2) mega_fwd(Args args) {
    extern __shared__ __attribute__((aligned(16))) unsigned char lds[];
    Frame F;
    F.lds = (LAS unsigned char*)lds;
    volatile LAS unsigned* MISC = (volatile LAS unsigned*)(F.lds + MISC_OFF);
    F.tid = threadIdx.x; F.lane = F.tid & 63; F.wave = __builtin_amdgcn_readfirstlane(F.tid >> 6);
    F.G = gridDim.x; { const int bx = blockIdx.x; F.vcu = (F.G % 8 == 0) ? (bx % 8) * (F.G / 8) + bx / 8 : bx; }
    for (int u = F.tid; u < 256; u += NTHR) MISC[u] = 0u;
    __syncthreads();
    if (F.tid == 0) {
#pragma unroll
        for (int i = 0; i < 29; ++i) { const unsigned long long v = (i < 27) ? (unsigned long long)args.in[i < 27 ? i : 0] : (i == 27 ? (unsigned long long)args.out : (unsigned long long)args.ws);
            MISC[128 + 2 * i] = (unsigned)v; MISC[128 + 2 * i + 1] = (unsigned)(v >> 32); } }
    __syncthreads();
    const PT pt{MISC + 128};
    unsigned char* const ws = (unsigned char*)pt.p(28);
    unsigned* ctl = (unsigned*)(ws + WS_CTL);
    XcdBarrier bar = xcd_barrier_post(ctl + CW_BAR, MISC + 8);
#define GRID_BAR() xcd_barrier(bar)
    const int bx = (int)blockIdx.x;
    float* const hres = (float*)pt.p(27);
    bf16* const HM = (bf16*)hres;
    bf16* const XN = (bf16*)(ws + WS_XN);
    LAS unsigned char* const ring = F.lds;
    const LAS unsigned short* const rowoff = (const LAS unsigned short*)(F.lds + ROWOFF_OFF);

    RopeJob rj; rope_init(rj, F);
    refresh(F); convert_weights(F, pt, ws, 0, CV_TOTAL, rj);
    refresh(F); misc_tables(F, pt, ws, rj);
    refresh(F); norm_phase(F, pt.in(I_X), pt.in(I_E_NORM_MIX), XN);
    GRID_BAR();
    { pg8::PlainSched S; S.o.init(T / 256, EVEN_IN / 256, F.G, bx); S.Abase = (const char*)XN; S.Bbase = (const char*)(ws + WS_W_EIN); S.tstep = 256u * D * 2u; S.tstepA = 0u;
      pg8::EpiZ0 E{(bf16*)(ws + WS_Z), (const float*)(ws + WS_ROPE), (const float*)(ws + WS_ROPE) + (size_t)SEQ * 64};
      pg8::gemm_phase<pg8::EpiZ0, pg8::PlainSched, false, true, true>(ring, rowoff, D, S, E); }
    GRID_BAR();
    for (int u = F.vcu; u < 256; u += F.G) { refresh(F); ret_unit<false>(F, pt, ws, u); refresh(F); conv_unit(F, pt, ws, u); }
    GRID_BAR();
    refresh(F); ret_scan(F, ws);
    GRID_BAR();
    for (int u = F.vcu; u < 256; u += F.G) { refresh(F); ret_unit<true>(F, pt, ws, u); }
    GRID_BAR();
    { pg8::PlainSched S; S.o.init(T / 256, D / 256, F.G, bx); S.Abase = (const char*)(ws + WS_Y); S.Bbase = (const char*)(ws + WS_W_EOUT); S.tstep = 256u * D * 2u; S.tstepA = 0u;
      pg8::EpiResB<0> E{pt.in(I_X), nullptr, 0, XN, D, (float*)(ws + WS_SSP), (LAS float*)(F.lds + ROWOFF_OFF), ws + WS_H18};
      pg8::gemm_phase<pg8::EpiResB<0>, pg8::PlainSched, false, true, true>(ring, rowoff, D, S, E); }
    GRID_BAR();
    { pg8::PlainSched S; S.o.init(T / 256, 2 * DFF / 256, F.G, bx); S.Abase = (const char*)(ws + WS_H18); S.Bbase = (const char*)(ws + WS_W_FGU); S.tstep = 256u * D; S.tstepA = 0u;
      pg8::EpiSwiGLU8<true> E{ws + WS_HFFN, DFF, (const float*)(ws + WS_SSP)};
      pg8::gemm_phase<pg8::EpiSwiGLU8<true>, pg8::PlainSched, false, true, true, true>(ring, rowoff, D, S, E); }
    GRID_BAR();
    { pg8::PlainSched S; S.o.init(T / 256, D / 256, F.G, bx); S.Abase = (const char*)(ws + WS_HFFN); S.Bbase = (const char*)(ws + WS_W_FDN); S.tstep = 256u * DFF; S.tstepA = 0u;
      pg8::EpiResB<1> E{nullptr, XN, D, HM, 2 * D, (float*)(ws + WS_SSP), (LAS float*)(F.lds + ROWOFF_OFF)};
      pg8::gemm_phase<pg8::EpiResB<1>, pg8::PlainSched, false, true, true, true>(ring, rowoff, DFF, S, E); }
    GRID_BAR();
    { pg8::PlainSched S; S.o.init(T / 256, ODD_IN / 256, F.G, bx); S.Abase = (const char*)HM; S.Bbase = (const char*)(ws + WS_W_OIN); S.tstep = 256u * D * 2u; S.tstepA = 256u * D * 4u;
      pg8::EpiBf16 E{(bf16*)(ws + WS_Z), ODD_IN, (const float*)(ws + WS_SSP)};
      pg8::gemm_phase<pg8::EpiBf16, pg8::PlainSched, false, true, true>(ring, rowoff, D, S, E, 0, D * 4); }
    GRID_BAR();
    for (int u = F.vcu; u < 256; u += F.G) { refresh(F); mixer1_unit(F, pt, ws, u); }
    GRID_BAR();
    { pg8::PlainSched S; S.o.init(T / 256, D / 256, F.G, bx); S.Abase = (const char*)(ws + WS_Y); S.Bbase = (const char*)(ws + WS_W_OOUT); S.tstep = 256u * D * 2u; S.tstepA = 0u;
      pg8::EpiBf16S E{HM + D, 2 * D, 1.0f};
      pg8::gemm_phase<pg8::EpiBf16S, pg8::PlainSched, false, true, true>(ring, rowoff, D, S, E); }
    GRID_BAR();
    refresh(F); route_phase(F, pt, ws, hres);
    GRID_BAR();
    LAS int* mcnt = (LAS int*)(F.lds + MISC_OFF + 64 * 4); LAS int* mbst = mcnt + 8;
    refresh(F);
    if (F.tid < 8) mcnt[F.tid] = (int)__hip_atomic_load(ctl + CW_CNT + 64 * F.tid, RLX_AGENT);
    __syncthreads();
    if (F.tid == 0) { int run = 0;
        for (int e = 0; e < 8; ++e) { mbst[e] = run; run += (mcnt[e] + 255) >> 8; }
        mbst[8] = run; }
    __syncthreads();
    const int RB = mbst[8];
    const LAS unsigned short* const rowtok = (const LAS unsigned short*)(F.lds + ROWOFF_OFF);
    { pg8::MoeGuSched S; S.o.init(RB, 2 * DEXP / 256, F.G, bx); S.rb0 = 0; S.bstart = mbst; S.Abase = (const char*)(ws + WS_XN8); S.Bbase = (const char*)(ws + WS_WGU8);
      { refresh(F); LAS unsigned short* rt16 = (LAS unsigned short*)(F.lds + ROWOFF_OFF); const int* row_tok = (const int*)(ws + WS_ROWTOK);
        int tokv[32];
#pragma unroll
        for (int ui = 0; ui < 32; ++ui) { pg8::Unit u; u.pm = 0; u.pn = 0; u.orow = 0; u.ao = 0u; u.bo = 0u; const bool ok = S.next(ui, u);
            const int e = pg8::expert_of(mbst, u.pm), j = u.pm - mbst[e], idx = 256 * j + (F.tid & 255); const bool live = ok && idx < mcnt[e];
            const int ld = row_tok[e * 32768 + (live ? idx : 0)]; tokv[ui] = live ? ld : 0; }
        if (F.tid < 256) {
#pragma unroll
            for (int ui = 0; ui < 32; ++ui) rt16[ui * 256 + F.tid] = (unsigned short)tokv[ui]; }
        __syncthreads(); }
      pg8::EpiSwiGLU8<false> E{ws + WS_HMOE8, DEXP, nullptr};
      pg8::gemm_phase<pg8::EpiSwiGLU8<false>, pg8::MoeGuSched, true, true, true, true>(ring, rowtok, D, S, E); }
    GRID_BAR();
    { pg8::MoeDnSched S; S.o.init(RB < 256 ? RB : 256, D / 256, F.G, bx); S.rb0 = 0; S.bstart = mbst; S.Abase = (const char*)(ws + WS_HMOE8); S.Bbase = (const char*)(ws + WS_WDN8);
      pg8::EpiBf16S E{(bf16*)(ws + WS_YMOE), D, 1.0f};
      pg8::gemm_phase<pg8::EpiBf16S, pg8::MoeDnSched, false, true, true, true>(ring, rowtok, DEXP, S, E); }
    if (RB > 256) {
      pg8::MoeDnSplitSched S; S.n = (RB - 256) * 28; S.G = F.G; S.c = bx; S.bstart = mbst; S.Abase = (const char*)(ws + WS_HMOE8); S.Bbase = (const char*)(ws + WS_WDN8);
      pg8::EpiBf16S E{(bf16*)(ws + WS_SLAB), D, 1.0f};
      pg8::gemm_phase<pg8::EpiBf16S, pg8::MoeDnSplitSched, false, true, true, true>(ring, rowtok, DEXP, S, E, 4); }
    GRID_BAR();
    refresh(F); combine_phase(F, pt, ws, mbst, hres);
}

extern "C" void kernel_launch(void* const* d_in, const int* in_sizes, int n_in, void* d_out, int out_size, void* d_ws, size_t ws_size, hipStream_t stream) {
    static int grid = 0;
    if (grid == 0) {
        if (n_in != 27 || in_sizes[0] != T * D || out_size != T * D || ws_size < WS_END) { fprintf(stderr, "kernel_launch: unexpected shapes (n_in %d, in0 %d, out %d, ws %zu); nothing launched\n", n_in, n_in > 0 ? in_sizes[0] : -1, out_size, ws_size); grid = -1; return; }
        int dev = 0, cus = 0, per_cu = 0;
        if (hipGetDevice(&dev) != hipSuccess || hipDeviceGetAttribute(&cus, hipDeviceAttributeMultiprocessorCount, dev) != hipSuccess) { grid = -1; return; }
        if (hipFuncSetAttribute((const void*)mega_fwd, hipFuncAttributeMaxDynamicSharedMemorySize, LDS_BYTES) != hipSuccess) { fprintf(stderr, "kernel_launch: hipFuncSetAttribute failed\n"); grid = -1; return; }
        if (hipOccupancyMaxActiveBlocksPerMultiprocessor(&per_cu, (const void*)mega_fwd, NTHR, LDS_BYTES) != hipSuccess || per_cu < 1) fprintf(stderr, "kernel_launch: occupancy query reports %d\n", per_cu);
        (void)hipGetLastError();
        if (cus != 256) { fprintf(stderr, "kernel_launch: built for a 256-CU device (unit lists of at most 32 units per workgroup and phase); found %d CUs; nothing launched\n", cus); grid = -1; return; }
        grid = cus;
    }
    if (grid < 0) return;
    if (hipMemsetAsync((char*)d_ws + WS_CTL, 0, CTL_ZERO_BYTES, stream) != hipSuccess) return;
    Args a{};
    for (int i = 0; i < 27; ++i) a.in[i] = (const float*)d_in[i];
    a.out = (float*)d_out; a.ws = (unsigned char*)d_ws;
    hipLaunchKernelGGL(mega_fwd, dim3(grid), dim3(NTHR), LDS_BYTES, stream, a);
}
```
